# Optimizing an MI355X kernel written in HIP

```python
import jax
import jax.numpy as jnp
from jax import lax
import numpy as np

D_MODEL = 1024
BATCH = 16
SEQ = 2048
DEPTH = 2

HEAD_DIM = 64
NSA_HEADS = 6
NSA_KV_HEADS = 2
NSA_GROUP = NSA_HEADS // NSA_KV_HEADS
CMP_BLOCK = 32
CMP_STRIDE = 16
CMP_HIDDEN = 256
SLC_BLOCK = 64
SLC_TOPN = 8
WIN = 512
NSA_QB = 64
FORCE_SCORE = 1e9
DIL_PAIRS = ((128, 1), (512, 4), (2048, 16))
DIL_HPG = 2
DIL_HEADS = DIL_HPG * len(DIL_PAIRS)
DIL_QB = 128
HG_HEADS = 4
HG_DIM = 64
HG_CHUNK = 64
LB_TINY = 1e-30
D_FF = 4 * D_MODEL
PLE_DIM = 256
EPS = 1e-6
NEG = -1e30
NSA_Q_W = NSA_HEADS * HEAD_DIM
NSA_KV_W = NSA_KV_HEADS * HEAD_DIM
DIL_W = DIL_HEADS * HEAD_DIM
HG_W = HG_HEADS * HG_DIM
IN_WIDTHS = (NSA_Q_W,) + (NSA_KV_W,) * 6 + (3 * NSA_HEADS,) + (DIL_W,) * 3 + (HG_W,) * 4
IN_TOTAL = sum(IN_WIDTHS)
MIX_W = NSA_Q_W + DIL_W + HG_W

kernel_name = 'hybrid_nsa_dilated_hgrn2_parallel'


def _rmsnorm(x, g):
    xf = x.astype(jnp.float32)
    y = xf * lax.rsqrt(jnp.mean(xf * xf, axis=-1, keepdims=True) + EPS)
    return (y * g.astype(jnp.float32)).astype(x.dtype)


def _softmax_masked(s, mask):
    s = jnp.where(mask, s, NEG)
    m = jnp.max(s, axis=-1, keepdims=True)
    e = jnp.where(mask, jnp.exp(s - m), 0.0)
    den = jnp.maximum(jnp.sum(e, axis=-1, keepdims=True), 1e-30)
    return e / den, (m + jnp.log(den))[..., 0]


def _alibi_slopes():
    n = NSA_HEADS + DIL_HEADS
    s = 2.0 ** (-8.0 * np.arange(1, n + 1) / n)
    quads = s.reshape(-1, 4)
    nsa = quads[:, 2:].reshape(-1)
    dil = quads[:, :2].reshape(-1)
    return jnp.asarray(nsa, jnp.float32), jnp.asarray(dil, jnp.float32)


def _compress(x, pos, w1, w2):
    B, Hk, S, Dh = x.shape
    n_cmp = (S - CMP_BLOCK) // CMP_STRIDE + 1
    idx = np.arange(n_cmp)[:, None] * CMP_STRIDE + np.arange(CMP_BLOCK)[None, :]
    blocks = jnp.take(x, jnp.asarray(idx.reshape(-1)), axis=2).reshape(B, Hk, n_cmp, CMP_BLOCK, Dh) + pos
    flat = blocks.reshape(B, Hk, n_cmp, CMP_BLOCK * Dh)
    return jax.nn.silu(flat @ w1) @ w2


def _nsa(q, kc, vc, ks, vs, kw, vw, gate_logits, cmp_pos, cmp_w1, cmp_w2, slopes):
    f32 = jnp.float32
    B, S, _ = q.shape
    dt = q.dtype
    qh = q.reshape(B, S, NSA_KV_HEADS, NSA_GROUP, HEAD_DIM).transpose(0, 2, 3, 1, 4) * (HEAD_DIM ** -0.5)

    def kvh(t):
        return t.reshape(B, S, NSA_KV_HEADS, HEAD_DIM).transpose(0, 2, 1, 3)

    gates = jax.nn.sigmoid(gate_logits.astype(f32)).reshape(B, S, NSA_KV_HEADS, NSA_GROUP, 3).transpose(0, 2, 3, 1, 4)
    k_cmp = _compress(kvh(kc), cmp_pos[0], cmp_w1[0], cmp_w2[0])
    v_cmp = _compress(kvh(vc), cmp_pos[1], cmp_w1[1], cmp_w2[1])
    n_cmp = k_cmp.shape[2]
    n_slc = S // SLC_BLOCK
    k_top = min(SLC_TOPN, n_slc)
    cmp_start = np.arange(n_cmp) * CMP_STRIDE
    cmp_end = jnp.asarray(cmp_start + CMP_BLOCK - 1)
    cmp_ctr = jnp.asarray(cmp_start + 0.5 * (CMP_BLOCK - 1), f32)
    slc_start = np.arange(n_slc) * SLC_BLOCK
    overlap = jnp.asarray(((cmp_start[:, None] < slc_start[None, :] + SLC_BLOCK)
                           & (cmp_start[:, None] + CMP_BLOCK > slc_start[None, :])).astype(np.float32))
    ks_blk = kvh(ks).reshape(B, NSA_KV_HEADS, n_slc, SLC_BLOCK, HEAD_DIM)
    vs_blk = kvh(vs).reshape(B, NSA_KV_HEADS, n_slc, SLC_BLOCK, HEAD_DIM)
    kw_pad = jnp.pad(kvh(kw), ((0, 0), (0, 0), (WIN, 0), (0, 0)))
    vw_pad = jnp.pad(kvh(vw), ((0, 0), (0, 0), (WIN, 0), (0, 0)))
    sl = slopes.reshape(1, NSA_KV_HEADS, NSA_GROUP, 1, 1)
    b_idx = jnp.arange(B)[:, None, None, None]
    h_idx = jnp.arange(NSA_KV_HEADS)[None, :, None, None]
    blk_ids = jnp.arange(n_slc)

    def block(i):
        q0 = i * NSA_QB
        t = q0 + jnp.arange(NSA_QB)
        tf = t.astype(f32)
        qi = lax.dynamic_slice_in_dim(qh, q0, NSA_QB, axis=3)
        gi = lax.dynamic_slice_in_dim(gates, q0, NSA_QB, axis=3)
        s_c = jnp.einsum('bkgqd,bknd->bkgqn', qi, k_cmp).astype(f32) - sl * jnp.abs(tf[:, None] - cmp_ctr[None, :])
        p_c, _ = _softmax_masked(s_c, cmp_end[None, :] <= t[:, None])
        o_c = jnp.einsum('bkgqn,bknd->bkgqd', p_c.astype(dt), v_cmp)
        imp = jnp.einsum('bkgqn,nm->bkqm', p_c, overlap)
        cur = (t // SLC_BLOCK)[:, None]
        forced = (blk_ids[None, :] == 0) | (blk_ids[None, :] == cur) | (blk_ids[None, :] == cur - 1)
        valid = blk_ids[None, :] <= cur
        score = jnp.where(valid, jnp.where(forced, FORCE_SCORE, imp), -FORCE_SCORE)
        top_s, top_i = lax.top_k(score, k_top)
        k_sel = ks_blk[b_idx, h_idx, top_i]
        v_sel = vs_blk[b_idx, h_idx, top_i]
        pos = top_i[..., None] * SLC_BLOCK + jnp.arange(SLC_BLOCK)
        m_s = (top_s >= 0)[..., None] & (pos <= t[:, None, None])
        dist = tf[:, None, None] - pos.astype(f32)
        s_s = jnp.einsum('bkgqd,bkqjld->bkgqjl', qi, k_sel).astype(f32) - sl[..., None] * dist[:, :, None]
        shp = s_s.shape
        p_s, _ = _softmax_masked(s_s.reshape(shp[0], shp[1], shp[2], shp[3], -1),
                                 m_s.reshape(shp[0], shp[1], 1, shp[3], -1))
        o_s = jnp.einsum('bkgqjl,bkqjld->bkgqd', p_s.reshape(shp).astype(dt), v_sel)
        kwi = lax.dynamic_slice_in_dim(kw_pad, q0, NSA_QB + WIN, axis=2)
        vwi = lax.dynamic_slice_in_dim(vw_pad, q0, NSA_QB + WIN, axis=2)
        kp = q0 - WIN + jnp.arange(NSA_QB + WIN)
        rel = t[:, None] - kp[None, :]
        m_w = (kp[None, :] >= 0) & (rel >= 0) & (rel < WIN)
        s_w = jnp.einsum('bkgqd,bknd->bkgqn', qi, kwi).astype(f32) - sl * rel.astype(f32)
        p_w, _ = _softmax_masked(s_w, m_w)
        o_w = jnp.einsum('bkgqn,bknd->bkgqd', p_w.astype(dt), vwi)
        o = gi[..., 0:1] * o_c + gi[..., 1:2] * o_s + gi[..., 2:3] * o_w
        return o.astype(dt)

    out = lax.map(block, jnp.arange(S // NSA_QB))
    return out.transpose(1, 0, 4, 2, 3, 5).reshape(B, S, NSA_Q_W)


def _dilated(q, k, v, slopes):
    f32 = jnp.float32
    B, S, _ = q.shape
    dt = q.dtype

    def heads(t):
        return t.reshape(B, S, DIL_HEADS, HEAD_DIM).transpose(0, 2, 1, 3)

    qh = heads(q) * (HEAD_DIM ** -0.5)
    kh = heads(k)
    vh = heads(v)
    groups = []
    for g, (w, d) in enumerate(DIL_PAIRS):
        hs = slice(g * DIL_HPG, (g + 1) * DIL_HPG)
        groups.append((qh[:, hs], kh[:, hs], vh[:, hs], slopes[hs], w, d))

    def block(i):
        q0 = i * DIL_QB
        t = q0 + jnp.arange(DIL_QB)
        outs, lses = [], []
        for qg, kg, vg, sg, w, d in groups:
            n_keys = w // d + 1
            dist = jnp.arange(n_keys) * d
            pos = t[:, None] - dist[None, :]
            idx = jnp.maximum(pos, 0).reshape(-1)
            qi = lax.dynamic_slice_in_dim(qg, q0, DIL_QB, axis=2)
            ki = jnp.take(kg, idx, axis=2).reshape(B, DIL_HPG, DIL_QB, n_keys, HEAD_DIM)
            vi = jnp.take(vg, idx, axis=2).reshape(B, DIL_HPG, DIL_QB, n_keys, HEAD_DIM)
            s = jnp.einsum('bhqd,bhqjd->bhqj', qi, ki).astype(f32) - sg[None, :, None, None] * dist.astype(f32)
            p, lse = _softmax_masked(s, pos >= 0)
            outs.append(jnp.einsum('bhqj,bhqjd->bhqd', p.astype(dt), vi))
            lses.append(lse)
        alpha = jax.nn.softmax(jnp.stack(lses), axis=0)
        return jnp.concatenate([outs[g] * alpha[g][..., None].astype(dt) for g in range(len(outs))], axis=1)

    out = lax.map(block, jnp.arange(S // DIL_QB))
    return out.transpose(1, 0, 3, 2, 4).reshape(B, S, DIL_W)


def _hgrn2(q, f_logit, inp, g, lb):
    f32 = jnp.float32
    B, S, _ = q.shape
    dt = q.dtype

    def heads(t):
        return t.astype(f32).reshape(B, S, HG_HEADS, HG_DIM).transpose(0, 2, 1, 3)

    qh, flh, vh = heads(q), heads(f_logit), heads(inp)
    lbh = lb.astype(f32).reshape(1, HG_HEADS, 1, HG_DIM)
    log_f = jnp.logaddexp(jnp.log(lbh + LB_TINY), jnp.log1p(-lbh) + jax.nn.log_sigmoid(flh))
    kh = -jnp.expm1(log_f)
    nc = S // HG_CHUNK

    def chunks(t):
        return t.reshape(B, HG_HEADS, nc, HG_CHUNK, HG_DIM).transpose(2, 0, 1, 3, 4)

    ar = jnp.arange(HG_CHUNK)
    causal = (ar[:, None] >= ar[None, :])[:, :, None]

    def step(state, xs):
        qc, kc, vc, lfc = xs
        b = jnp.cumsum(lfc, axis=2)
        diff = jnp.where(causal, b[:, :, :, None, :] - b[:, :, None, :, :], 0.0)
        decay = jnp.where(causal, jnp.exp(diff), 0.0)
        a = jnp.einsum('bhtd,bhsd,bhtsd->bhts', qc, kc, decay)
        o = jnp.einsum('bhts,bhse->bhte', a, vc) + jnp.einsum('bhtd,bhde->bhte', qc * jnp.exp(b), state)
        b_last = b[:, :, -1:, :]
        new_state = jnp.exp(b_last[:, :, 0, :])[..., None] * state + jnp.einsum('bhsd,bhse->bhde', kc * jnp.exp(b_last - b), vc)
        return new_state, o

    s0 = jnp.zeros((B, HG_HEADS, HG_DIM, HG_DIM), f32)
    _, o = lax.scan(step, s0, (chunks(qh), chunks(kh), chunks(vh), chunks(log_f)))
    o = o.transpose(1, 2, 0, 3, 4).reshape(B, HG_HEADS, S, HG_DIM)
    o = o * lax.rsqrt(jnp.mean(o * o, axis=-1, keepdims=True) + EPS)
    o = o.transpose(0, 2, 1, 3).reshape(B, S, HG_W) * jax.nn.silu(g.astype(f32))
    return o.astype(dt)


def setup_inputs(seed: int = 0) -> dict:
    key = jax.random.key(seed)
    ks = jax.random.split(key, 18)
    f32 = jnp.float32

    def nrm(k, shape, fan_in):
        return jax.random.normal(k, shape, f32) * (fan_in ** -0.5)

    def gain(k, shape):
        return 1.0 + 0.05 * jax.random.normal(k, shape, f32)

    return {
        'x': jax.random.normal(ks[0], (BATCH, SEQ, D_MODEL), f32),
        'p': jax.random.normal(ks[1], (DEPTH, BATCH, SEQ, PLE_DIM), f32),
        'w_in': nrm(ks[2], (DEPTH, D_MODEL, IN_TOTAL), D_MODEL),
        'w_out': nrm(ks[3], (DEPTH, MIX_W, D_MODEL), MIX_W),
        'cmp_pos': 0.02 * jax.random.normal(ks[4], (DEPTH, 2, CMP_BLOCK, HEAD_DIM), f32),
        'cmp_w1': nrm(ks[5], (DEPTH, 2, CMP_BLOCK * HEAD_DIM, CMP_HIDDEN), CMP_BLOCK * HEAD_DIM),
        'cmp_w2': nrm(ks[6], (DEPTH, 2, CMP_HIDDEN, HEAD_DIM), CMP_HIDDEN),
        'hg_lb': 0.1 * jax.random.normal(ks[7], (DEPTH, HG_W), f32),
        'g_pre_mix': gain(ks[8], (DEPTH, D_MODEL)),
        'g_post_mix': gain(ks[9], (DEPTH, D_MODEL)),
        'g_pre_mlp': gain(ks[10], (DEPTH, D_MODEL)),
        'g_post_mlp': gain(ks[11], (DEPTH, D_MODEL)),
        'w_up': nrm(ks[12], (DEPTH, D_MODEL, D_FF), D_MODEL),
        'w_down': nrm(ks[13], (DEPTH, D_FF, D_MODEL), D_FF),
        'g_ple': gain(ks[14], (DEPTH, D_MODEL)),
        'w_ple_gate': nrm(ks[15], (DEPTH, D_MODEL, D_MODEL), D_MODEL),
        'w_ple_proj': nrm(ks[16], (DEPTH, PLE_DIM, D_MODEL), PLE_DIM),
    }


def reference(x, p, w_in, w_out, cmp_pos, cmp_w1, cmp_w2, hg_lb, g_pre_mix, g_post_mix,
              g_pre_mlp, g_post_mlp, w_up, w_down, g_ple, w_ple_gate, w_ple_proj):
    nsa_slopes, dil_slopes = _alibi_slopes()
    sm = jax.nn.softmax(hg_lb.astype(jnp.float32), axis=0)
    lower_bounds = jnp.maximum(jnp.cumsum(sm, axis=0) - sm[0:1], 0.0)
    split_pts = [int(v) for v in np.cumsum(IN_WIDTHS)[:-1]]
    h = x
    for l in range(DEPTH):
        hn = _rmsnorm(h, g_pre_mix[l])
        proj = hn @ w_in[l]
        (nq, nkc, nvc, nks, nvs, nkw, nvw, ngate, dq, dk, dv, hq, hf, hi, hg) = jnp.split(proj, split_pts, axis=-1)
        o_nsa = _nsa(nq, nkc, nvc, nks, nvs, nkw, nvw, ngate, cmp_pos[l], cmp_w1[l], cmp_w2[l], nsa_slopes)
        o_dil = _dilated(dq, dk, dv, dil_slopes)
        o_hg = _hgrn2(hq, hf, hi, hg, lower_bounds[l])
        mix = jnp.concatenate([o_nsa, o_dil, o_hg], axis=-1) @ w_out[l]
        h = h + _rmsnorm(mix, g_post_mix[l])
        hn = _rmsnorm(h, g_pre_mlp[l])
        u = jnp.square(jax.nn.relu(hn @ w_up[l]))
        h = h + _rmsnorm(u @ w_down[l], g_post_mlp[l])
        gate = jax.nn.sigmoid(_rmsnorm(h, g_ple[l]) @ w_ple_gate[l])
        h = h + (p[l] @ w_ple_proj[l]) * gate
    return h
```

```cpp
#include <hip/hip_runtime.h>
#include <hip/hip_cooperative_groups.h>
#include <cstdio>
#include <cstdint>
namespace cg = cooperative_groups;

#ifndef REP_P0
#define REP_P0 1
#endif
#ifndef REP_HL
#define REP_HL 1
#endif
#ifndef REP_CG
#define REP_CG 1
#endif
#ifndef REP_DL
#define REP_DL 1
#endif
#ifndef REP_HF
#define REP_HF 1
#endif
#ifndef REP_NSA
#define REP_NSA 1
#endif
#ifndef REP_CMP
#define REP_CMP 1
#endif
#ifndef REP_SEL
#define REP_SEL 1
#endif
#ifndef REP_WIN
#define REP_WIN 1
#endif
#ifndef REP_C2
#define REP_C2 1
#endif
#ifndef REP_SC
#define REP_SC 1
#endif
#ifndef REP_G1
#define REP_G1 1
#endif
#ifndef REP_P2
#define REP_P2 1
#endif
#ifndef REP_P4
#define REP_P4 1
#endif
#ifndef REP_G3
#define REP_G3 1
#endif
#ifndef MK_ONE_LAUNCH
#define MK_ONE_LAUNCH 1
#endif

constexpr int BATCH = 16, SEQ = 2048, DM = 1024, MTOK = BATCH * SEQ, DEPTH = 2;
constexpr int FF = 4096, PLE = 256;
constexpr int IN_TOTAL = 3346, NPROJ = 3584;
constexpr int C_NQ = 0, C_KC = 384, C_VC = 512, C_KS = 640, C_VS = 768, C_KW = 896, C_VW = 1024;
constexpr int C_DQ = 1152, C_DK = 1536, C_DV = 1920, C_HQ = 2304, C_HF = 2560, C_HI = 2816, C_HG = 3072, C_GATE = 3328;
constexpr float EPS = 1e-6f;
constexpr float NEGBIG = -1e30f;

constexpr size_t MiB = 1u << 20;
constexpr size_t WS_CTL = 0, CTL_BYTES = 1 * MiB;
constexpr size_t WS_SSA = 1 * MiB;
constexpr size_t WS_SSB = 3 * MiB;
constexpr size_t WS_XBUF = 5 * MiB;
constexpr size_t WS_KCMP = 6 * MiB;
constexpr size_t WS_VCMP = 7 * MiB;
constexpr size_t WS_HID = 8 * MiB;
constexpr size_t WS_WIN = 12 * MiB;
constexpr size_t WS_WOUT = 26 * MiB;
constexpr size_t WS_WUP = 30 * MiB;
constexpr size_t WS_WDN = 46 * MiB;
constexpr size_t WS_WG = 62 * MiB;
constexpr size_t WS_WPJ = 66 * MiB;
constexpr size_t WS_W1T = 67 * MiB;
constexpr size_t WS_B1P = 71 * MiB;
constexpr size_t WS_PB = 72 * MiB;
constexpr size_t WS_HBA = 88 * MiB;
constexpr size_t WS_PP = 152 * MiB;
constexpr size_t WS_PROJ = 216 * MiB;
constexpr size_t WS_MIX = 440 * MiB;
constexpr size_t WS_U = 216 * MiB;
constexpr size_t WS_END = 504 * MiB;
constexpr size_t WS_OLOC = WS_HBA;
constexpr size_t WS_QE = WS_HBA + 32 * MiB;
constexpr size_t WS_HUS = WS_HBA + 48 * MiB;
constexpr size_t WS_HU = WS_PP;
constexpr size_t WS_HD = WS_PP + 32 * MiB;
constexpr size_t WS_LSE = WS_PP + 33 * MiB;
__host__ __device__ constexpr size_t ws_slab(int kv, int ks) { return (kv == 0 ? WS_PB : WS_PP + 48 * MiB) + (size_t)ks * 4 * MiB; }
constexpr int CW_TMO = 0;
constexpr int CW_BAR = 65536;
constexpr int CW_NSAQ = 512;
constexpr int CW_CNT = 1024;

constexpr int RING_BYTES = 131072;
constexpr int MISC_OFF = RING_BYTES;
constexpr int LDS_BYTES = 147456;
constexpr int LDS_ARGS = MISC_OFF + 4096;
constexpr int LDS_XBST = MISC_OFF + 4096 + 256;
constexpr int LDS_QW = MISC_OFF + 4096 + 320;
constexpr int LDS_WTAB = MISC_OFF + 4096 + 512;
constexpr int LDS_RSTD = MISC_OFF + 8192;

#define LAS __attribute__((address_space(3)))
typedef unsigned short bf16_t;
typedef float f32x4 __attribute__((ext_vector_type(4)));
typedef float f32x2 __attribute__((ext_vector_type(2)));
typedef unsigned u32x4 __attribute__((ext_vector_type(4)));
typedef unsigned u32x2 __attribute__((ext_vector_type(2)));

__device__ __forceinline__ float bf_lo(unsigned u) { return __uint_as_float(u << 16); }
__device__ __forceinline__ float bf_hi(unsigned u) { return __uint_as_float(u & 0xffff0000u); }
__device__ __forceinline__ unsigned f2bf(float f) { unsigned u = __float_as_uint(f); return (u + 0x7fffu + ((u >> 16) & 1u)) >> 16; }
__device__ __forceinline__ unsigned pk2(float lo, float hi) { return f2bf(lo) | (f2bf(hi) << 16); }
__device__ __forceinline__ float rcpf_(float x) { return __builtin_amdgcn_rcpf(x); }
__device__ __forceinline__ float sigmoidf_(float x) { return rcpf_(1.0f + __expf(-x)); }
__device__ __forceinline__ unsigned x16u(unsigned v) { auto r = __builtin_amdgcn_permlane16_swap(v, v, false, false); return r[0] ^ r[1] ^ v; }
__device__ __forceinline__ unsigned x32u(unsigned v) { auto r = __builtin_amdgcn_permlane32_swap(v, v, false, false); return r[0] ^ r[1] ^ v; }
__device__ __forceinline__ float x16f(float v) { return __uint_as_float(x16u(__float_as_uint(v))); }
__device__ __forceinline__ float x32f(float v) { return __uint_as_float(x32u(__float_as_uint(v))); }
template <int CTRL> __device__ __forceinline__ unsigned dppu(unsigned v) { return (unsigned)__builtin_amdgcn_update_dpp((int)v, (int)v, CTRL, 0xf, 0xf, false); }
__device__ __forceinline__ float row_sum16(float v) {
    v += __uint_as_float(dppu<0xB1>(__float_as_uint(v))); v += __uint_as_float(dppu<0x4E>(__float_as_uint(v)));
    v += __uint_as_float(dppu<0x141>(__float_as_uint(v))); v += __uint_as_float(dppu<0x140>(__float_as_uint(v))); return v;
}
__device__ __forceinline__ unsigned row_or16(unsigned v) { v |= dppu<0xB1>(v); v |= dppu<0x4E>(v); v |= dppu<0x141>(v); v |= dppu<0x140>(v); return v; }
__device__ __forceinline__ float wave_sum(float v) { v = row_sum16(v); v += x16f(v); v += x32f(v); return v; }

namespace pg8 {
#define PG8_LAS __attribute__((address_space(3)))
typedef short bf16x8 __attribute__((ext_vector_type(8)));
constexpr int BM = 256, BK = 64, HALF = 128, HTB = HALF * BK * 2, STAGE_BYTES = 8 * HTB, NXCD = 8, WGM = 8;

__host__ __device__ __forceinline__ int lds_byte(int r, int c) { const int st = (r >> 4) * 2 + (c >> 5), rr = r & 15, cc = c & 31, ob = rr * 64 + cc * 2; return st * 1024 + (ob ^ (((ob >> 9) & 1) << 5)); }
__host__ __device__ __forceinline__ void stage_rc(int b, int& R, int& C) { const int st = b / 1024, sb = b % 1024, swz = sb ^ (((sb >> 9) & 1) << 5); R = (st >> 1) * 16 + swz / 64; C = (st & 1) * 32 + (swz % 64) / 2; }
__host__ __device__ __forceinline__ int perm32(int rho) { const int n = rho >> 4, i = rho & 15; return 8 * (i >> 2) + 4 * n + (i & 3); }

struct Unit { int pm, pn; };
struct Gemm { const bf16_t* A; const bf16_t* Bt; int K; int lda; long a_kstep, a_hstep, a_tstep; int ldb; };
__device__ __forceinline__ Gemm make_gemm(const bf16_t* A, const bf16_t* Bt, int K) { asm volatile("" : "+s"(K)); Gemm g; g.A = A; g.Bt = Bt; g.K = K; g.lda = K; g.a_kstep = BK * 2; g.a_hstep = (long)HALF * K * 2; g.a_tstep = 2 * g.a_hstep; g.ldb = K; return g; }

struct StaticOrder {
    int nM, nN, nwg, G, c;
    __device__ void init(int M, int N, int G_, int c_) { nM = M / BM; nN = N / BM; nwg = nM * nN; G = G_; c = c_; }
    __device__ bool next(int i, Unit& u) const {
        const long L = (long)i * G + c; if (L >= nwg) return false;
        int wgid = (int)L; { const int q = nwg / NXCD, r = nwg % NXCD, xcd = wgid % NXCD, off = wgid / NXCD; wgid = (xcd < r ? xcd * (q + 1) : r * (q + 1) + (xcd - r) * q) + off; }
        const int nig = WGM * nN, gid = wgid / nig, fm = gid * WGM, gsz = (nM - fm) < WGM ? (nM - fm) : WGM;
        u.pm = fm + ((wgid % nig) % gsz); u.pn = (wgid % nig) / gsz; return true;
    }
};
struct OneOf { StaticOrder S; int i;
    __device__ bool next(int j, Unit& u) const { return j == 0 ? S.next(i, u) : false; } };
struct OneFixed { Unit u0; bool valid;
    __device__ bool next(int j, Unit& u) const { if (j == 0 && valid) { u = u0; return true; } return false; } };

__device__ __forceinline__ unsigned cvt_pk_bf16(float lo, float hi) { unsigned r; asm volatile("v_cvt_pk_bf16_f32 %0, %1, %2" : "=v"(r) : "v"(lo), "v"(hi)); return r; }

__device__ __forceinline__ float row_rstd16(const float* ss, long row) {
    const f32x4* sp = (const f32x4*)(ss + row * 16);
    const f32x4 a = sp[0], b = sp[1], c = sp[2], d = sp[3];
    const float tot = ((a.x + a.y) + (a.z + a.w)) + ((b.x + b.y) + (b.z + b.w)) + ((c.x + c.y) + (c.z + c.w)) + ((d.x + d.y) + (d.z + d.w));
    return rsqrtf(tot * (1.0f / 1024.0f) + EPS);
}

template <int MODE> struct EpiBf {
    static constexpr bool PERM = true, AFTER_DRAIN = false;
    bf16_t* O; int ldc; const PG8_LAS float* rstd; const float* bias;
    __device__ __forceinline__ void operator()(const f32x4 (&acc)[2][2][4][2], const Unit& u, int ui, int wr, int wc, int fr, int fq) const {
        const int row0 = u.pm * BM + wr * 64 + fr; const int col0 = u.pn * BM + wc * 32 + 8 * fq;
        f32x4 bv[2][2];
        if (MODE == 3) {
#pragma unroll
            for (int bj = 0; bj < 2; ++bj)
#pragma unroll
                for (int n = 0; n < 2; ++n) bv[bj][n] = *(const f32x4*)(bias + col0 + bj * HALF + 4 * n);
        }
#pragma unroll
        for (int ai = 0; ai < 2; ++ai)
#pragma unroll
            for (int m = 0; m < 4; ++m) {
                const long row = row0 + ai * HALF + m * 16;
                float rs = 1.0f;
                if (MODE == 1 || MODE == 2) rs = rstd[ui * 256 + wr * 64 + fr + ai * HALF + m * 16];
                bf16_t* rowp = O + (size_t)row * ldc + col0;
#pragma unroll
                for (int bj = 0; bj < 2; ++bj) {
                    f32x4 v0 = acc[ai][bj][m][0], v1 = acc[ai][bj][m][1];
                    if (MODE == 1) { v0 = v0 * rs; v1 = v1 * rs; }
                    if (MODE == 2) {
                        v0 = v0 * rs; v1 = v1 * rs;
#pragma unroll
                        for (int e = 0; e < 4; ++e) { const float a = fmaxf(v0[e], 0.f), b = fmaxf(v1[e], 0.f); v0[e] = a * a; v1[e] = b * b; }
                    }
                    if (MODE == 3) {
                        v0 = v0 + bv[bj][0]; v1 = v1 + bv[bj][1];
#pragma unroll
                        for (int e = 0; e < 4; ++e) { v0[e] = v0[e] * sigmoidf_(v0[e]); v1[e] = v1[e] * sigmoidf_(v1[e]); }
                    }
                    u32x4 w; w.x = cvt_pk_bf16(v0[0], v0[1]); w.y = cvt_pk_bf16(v0[2], v0[3]); w.z = cvt_pk_bf16(v1[0], v1[1]); w.w = cvt_pk_bf16(v1[2], v1[3]);
                    *(u32x4*)(rowp + bj * HALF) = w;
                }
            }
    }
};

struct EpiF32P {
    static constexpr bool PERM = false, AFTER_DRAIN = false;
    float* C; int ldc;
    __device__ __forceinline__ void operator()(const f32x4 (&acc)[2][2][4][2], const Unit& u, int ui, int wr, int wc, int fr, int fq) const {
        const int row0 = u.pm * BM + wr * 64 + fr, col0 = u.pn * BM + wc * 32 + 4 * fq;
#pragma unroll
        for (int ai = 0; ai < 2; ++ai)
#pragma unroll
            for (int m = 0; m < 4; ++m) { float* rowp = C + (size_t)(row0 + ai * HALF + m * 16) * ldc + col0;
#pragma unroll
                for (int bj = 0; bj < 2; ++bj)
#pragma unroll
                    for (int n = 0; n < 2; ++n) *(f32x4*)(rowp + bj * HALF + n * 16) = acc[ai][bj][m][n]; }
    }
};
struct EpiPle {
    static constexpr bool PERM = true, AFTER_DRAIN = false;
    const PG8_LAS float* rstd; const bf16_t* pp; const bf16_t* hin; float* outf; bf16_t* hb; float* sso;
    __device__ __forceinline__ void operator()(const f32x4 (&acc)[2][2][4][2], const Unit& u, int ui, int wr, int wc, int fr, int fq) const {
        const int row0 = u.pm * BM + wr * 64 + fr; const int col0 = u.pn * BM + wc * 32 + 8 * fq;
        u32x4 pw[2][2][2], hw[2][2][2];
#define PLE_LOAD(set_, b_) do { _Pragma("unroll") for (int q_ = 0; q_ < 2; ++q_) { const long row_ = row0 + ((b_) >> 1) * HALF + (((b_) & 1) * 2 + q_) * 16; \
            _Pragma("unroll") for (int bj_ = 0; bj_ < 2; ++bj_) { const size_t off_ = (size_t)row_ * DM + col0 + bj_ * HALF; pw[set_][q_][bj_] = *(const u32x4*)(pp + off_); hw[set_][q_][bj_] = *(const u32x4*)(hin + off_); } } } while (0)
        PLE_LOAD(0, 0); PLE_LOAD(1, 1);
#pragma unroll
        for (int b = 0; b < 4; ++b) {
            const int set = b & 1, ai = b >> 1;
#pragma unroll
            for (int q = 0; q < 2; ++q) {
                const int m = (b & 1) * 2 + q;
                const long row = row0 + ai * HALF + m * 16;
                const float rs = rstd[ui * 256 + wr * 64 + fr + ai * HALF + m * 16];
                float sq = 0.f;
#pragma unroll
                for (int bj = 0; bj < 2; ++bj) {
                    const size_t off = (size_t)row * DM + col0 + bj * HALF;
                    const u32x4 pwv = pw[set][q][bj], hwv = hw[set][q][bj];
                    const f32x4 a0 = acc[ai][bj][m][0] * rs, a1 = acc[ai][bj][m][1] * rs;
                    f32x4 o0, o1;
                    o0[0] = bf_lo(hwv.x) + bf_lo(pwv.x) * sigmoidf_(a0[0]); o0[1] = bf_hi(hwv.x) + bf_hi(pwv.x) * sigmoidf_(a0[1]);
                    o0[2] = bf_lo(hwv.y) + bf_lo(pwv.y) * sigmoidf_(a0[2]); o0[3] = bf_hi(hwv.y) + bf_hi(pwv.y) * sigmoidf_(a0[3]);
                    o1[0] = bf_lo(hwv.z) + bf_lo(pwv.z) * sigmoidf_(a1[0]); o1[1] = bf_hi(hwv.z) + bf_hi(pwv.z) * sigmoidf_(a1[1]);
                    o1[2] = bf_lo(hwv.w) + bf_lo(pwv.w) * sigmoidf_(a1[2]); o1[3] = bf_hi(hwv.w) + bf_hi(pwv.w) * sigmoidf_(a1[3]);
                    if (outf) { *(f32x4*)(outf + off) = o0; *(f32x4*)(outf + off + 4) = o1; }
                    else {
                        sq += (o0[0] * o0[0] + o0[1] * o0[1]) + (o0[2] * o0[2] + o0[3] * o0[3]) + (o1[0] * o1[0] + o1[1] * o1[1]) + (o1[2] * o1[2] + o1[3] * o1[3]);
                        u32x4 w; w.x = cvt_pk_bf16(o0[0], o0[1]); w.y = cvt_pk_bf16(o0[2], o0[3]); w.z = cvt_pk_bf16(o1[0], o1[1]); w.w = cvt_pk_bf16(o1[2], o1[3]);
                        *(u32x4*)(hb + off) = w;
                    }
                }
                if (!outf) { sq += x16f(sq); sq += x32f(sq); if (fq == 0) sso[row * 16 + u.pn * 4 + wc] = sq; }
            }
            if (b + 2 < 4) { if (set == 0) PLE_LOAD(0, b + 2); else PLE_LOAD(1, b + 2); }
        }
#undef PLE_LOAD
    }
};
struct EpiPost {
    static constexpr bool PERM = true, AFTER_DRAIN = false;
    const bf16_t* base; bf16_t* hb; const float* gvec; float* sso; float* xbuf; unsigned* cnt_bank; unsigned* tmo; PG8_LAS unsigned char* tab;
    __device__ __forceinline__ void operator()(const f32x4 (&acc)[2][2][4][2], const Unit& u, int ui, int wr, int wc, int fr, int fq) const {
        const int wid = wr * 4 + wc, lane = fq * 16 + fr;
        unsigned* cnt = cnt_bank + u.pm * 64;
        u32x4 bpre[2][4][2];
        { const int colp = u.pn * BM + wc * 32 + 8 * fq;
#pragma unroll
          for (int ai = 0; ai < 2; ++ai)
#pragma unroll
            for (int m = 0; m < 4; ++m) { const size_t offp = (size_t)(u.pm * BM + ai * HALF + wr * 64 + m * 16 + fr) * DM + colp;
#pragma unroll
                for (int bj = 0; bj < 2; ++bj) bpre[ai][m][bj] = *(const u32x4*)(base + offp + bj * HALF); } }
        PG8_LAS float* P = (PG8_LAS float*)tab;
        PG8_LAS float* S = (PG8_LAS float*)(tab + 4096);
#pragma unroll
        for (int ai = 0; ai < 2; ++ai)
#pragma unroll
            for (int m = 0; m < 4; ++m) {
                float s = 0.f;
#pragma unroll
                for (int bj = 0; bj < 2; ++bj)
#pragma unroll
                    for (int n = 0; n < 2; ++n) { const f32x4 x = acc[ai][bj][m][n]; s += (x[0] * x[0] + x[1] * x[1]) + (x[2] * x[2] + x[3] * x[3]); }
                s += x16f(s); s += x32f(s);
                if (fq == 0) P[(ai * HALF + wr * 64 + m * 16 + fr) * 4 + wc] = s;
            }
        asm volatile("s_waitcnt lgkmcnt(0)" ::: "memory"); __builtin_amdgcn_s_barrier(); asm volatile("" ::: "memory");
        const int row = wid * 32 + (lane & 31);
        if (lane < 32) {
            const float tot = (P[row * 4 + 0] + P[row * 4 + 1]) + (P[row * 4 + 2] + P[row * 4 + 3]);
            __hip_atomic_store(xbuf + ((size_t)(u.pm * BM + row) * 4 + u.pn), tot, __ATOMIC_RELAXED, __HIP_MEMORY_SCOPE_AGENT);
        }
        asm volatile("s_waitcnt vmcnt(0)" ::: "memory");
        if (lane == 0) __hip_atomic_fetch_add(cnt, 1u, __ATOMIC_RELAXED, __HIP_MEMORY_SCOPE_AGENT);
        if (wid == 0) {
            unsigned spins = 0;
            while ((unsigned)__builtin_amdgcn_readfirstlane(__hip_atomic_load(cnt, __ATOMIC_RELAXED, __HIP_MEMORY_SCOPE_AGENT)) < 32u) {
                __builtin_amdgcn_s_sleep(2);
                if (++spins > (1u << 22)) { if (lane == 0) __hip_atomic_store(tmo, 1u, __ATOMIC_RELAXED, __HIP_MEMORY_SCOPE_AGENT); break; }
            }
            __builtin_amdgcn_fence(__ATOMIC_ACQUIRE, "agent");
        }
        asm volatile("s_waitcnt vmcnt(0) lgkmcnt(0)" ::: "memory"); __builtin_amdgcn_s_barrier(); asm volatile("" ::: "memory");
        if (lane < 32) {
            const float* slot = xbuf + (size_t)(u.pm * BM + row) * 4;
            float t0 = __hip_atomic_load(slot + 0, __ATOMIC_RELAXED, __HIP_MEMORY_SCOPE_AGENT);
            float t1 = __hip_atomic_load(slot + 1, __ATOMIC_RELAXED, __HIP_MEMORY_SCOPE_AGENT);
            float t2 = __hip_atomic_load(slot + 2, __ATOMIC_RELAXED, __HIP_MEMORY_SCOPE_AGENT);
            float t3 = __hip_atomic_load(slot + 3, __ATOMIC_RELAXED, __HIP_MEMORY_SCOPE_AGENT);
            S[row] = rsqrtf(((t0 + t1) + (t2 + t3)) * (1.0f / 1024.0f) + EPS);
        }
        asm volatile("s_waitcnt vmcnt(0) lgkmcnt(0)" ::: "memory"); __builtin_amdgcn_s_barrier(); asm volatile("" ::: "memory");
        const int col0 = u.pn * BM + wc * 32 + 8 * fq;
        f32x4 gv[2][2];
#pragma unroll
        for (int bj = 0; bj < 2; ++bj)
#pragma unroll
            for (int n = 0; n < 2; ++n) gv[bj][n] = *(const f32x4*)(gvec + col0 + bj * HALF + 4 * n);
#pragma unroll
        for (int ai = 0; ai < 2; ++ai)
#pragma unroll
            for (int m = 0; m < 4; ++m) {
                const int r = ai * HALF + wr * 64 + m * 16 + fr; const float rs = S[r];
                const size_t off = (size_t)(u.pm * BM + r) * DM + col0;
                float sq = 0.f;
#pragma unroll
                for (int bj = 0; bj < 2; ++bj) {
                    const u32x4 bw = bpre[ai][m][bj];
                    const f32x4 b0 = {bf_lo(bw.x), bf_hi(bw.x), bf_lo(bw.y), bf_hi(bw.y)}, b1 = {bf_lo(bw.z), bf_hi(bw.z), bf_lo(bw.w), bf_hi(bw.w)};
                    const f32x4 o0 = b0 + acc[ai][bj][m][0] * rs * gv[bj][0], o1 = b1 + acc[ai][bj][m][1] * rs * gv[bj][1];
                    sq += ((o0[0] * o0[0] + o0[1] * o0[1]) + (o0[2] * o0[2] + o0[3] * o0[3])) + ((o1[0] * o1[0] + o1[1] * o1[1]) + (o1[2] * o1[2] + o1[3] * o1[3]));
                    u32x4 w; w.x = cvt_pk_bf16(o0[0], o0[1]); w.y = cvt_pk_bf16(o0[2], o0[3]); w.z = cvt_pk_bf16(o1[0], o1[1]); w.w = cvt_pk_bf16(o1[2], o1[3]);
                    *(u32x4*)(hb + off + bj * HALF) = w;
                }
                sq += x16f(sq); sq += x32f(sq);
                if (fq == 0) sso[(size_t)(u.pm * BM + r) * 16 + u.pn * 4 + wc] = sq;
            }
    }
};

template <class Epi, class Sched, bool ALIGN_EPI>
__device__ __forceinline__ void gemm_phase(PG8_LAS unsigned char* lds, const Gemm g, const Sched& S, const Epi& E) {
    int tid_;
    {   int ln_; asm volatile("v_mbcnt_lo_u32_b32 %0, -1, 0\n\tv_mbcnt_hi_u32_b32 %0, -1, %0" : "=v"(ln_));
        const unsigned hw_ = (unsigned)__builtin_amdgcn_s_getreg((5 << 11) | 4) & 63u; unsigned to_ = LDS_WTAB; asm volatile("" : "+v"(to_));
        int wv_ = (int)((const PG8_LAS unsigned*)(lds + to_))[hw_]; wv_ = __builtin_amdgcn_readfirstlane(wv_); tid_ = wv_ * 64 + ln_; }
    asm volatile("" : "+v"(tid_));
    const int tid = tid_, wid = __builtin_amdgcn_readfirstlane(tid >> 6), lane = tid & 63, wr = wid >> 2, wc = wid & 3, fr = lane & 15, fq = lane >> 4;
    const int K = g.K, nt = K / BK;
    unsigned voffA[2], voffB[2];
#pragma unroll
    for (int i = 0; i < 2; ++i) { int R, C; stage_rc(tid * 16 + i * 8192, R, C); const int Rb = Epi::PERM ? ((R & ~31) + perm32(R & 31)) : R;
        voffA[i] = (unsigned)(R * g.lda + C) * 2u; voffB[i] = (unsigned)(Rb * g.ldb + C) * 2u; }
    const size_t kstepA = (size_t)g.a_kstep, hstepA = (size_t)g.a_hstep, tstepA = (size_t)g.a_tstep;
    const size_t kstepB = (size_t)(BK * 2), hstepB = (size_t)HALF * g.ldb * 2, tstepB = 2 * hstepB;
    const unsigned ldsw = (unsigned)wid * 1024u;
    const int aoff = lds_byte(wr * 64 + fr, fq * 8), boff = lds_byte(wc * 32 + fr, fq * 8);
#define PG8_SA(b, h) (((b) * 2 + (h)) * HTB)
#define PG8_SB(b, h) ((4 + (b) * 2 + (h)) * HTB)
#define PG8_STAGE(bufoff, gbase, voff) do { _Pragma("unroll") for (int _i = 0; _i < 2; ++_i) \
        __builtin_amdgcn_global_load_lds((const unsigned*)((const char*)(gbase) + (voff)[_i]), (PG8_LAS unsigned*)(lds + (bufoff) + ldsw + _i * 8192), 16, 0, 0); } while (0)
#define PG8_LDA(dst, b, h) do { _Pragma("unroll") for (int m = 0; m < 4; ++m) _Pragma("unroll") for (int k = 0; k < 2; ++k) dst[m][k] = *(const PG8_LAS bf16x8*)(lds + PG8_SA(b, h) + aoff + m * 2048 + k * 1024); } while (0)
#define PG8_LDB(dst, b, h) do { _Pragma("unroll") for (int n = 0; n < 2; ++n) _Pragma("unroll") for (int k = 0; k < 2; ++k) dst[n][k] = *(const PG8_LAS bf16x8*)(lds + PG8_SB(b, h) + boff + n * 2048 + k * 1024); } while (0)
#define PG8_MMA(ai, bj, At, Bt) do { __builtin_amdgcn_s_setprio(1); _Pragma("unroll") for (int m = 0; m < 4; ++m) _Pragma("unroll") for (int n = 0; n < 2; ++n) _Pragma("unroll") for (int k = 0; k < 2; ++k) \
        acc[ai][bj][m][n] = __builtin_amdgcn_mfma_f32_16x16x32_bf16(Bt[n][k], At[m][k], acc[ai][bj][m][n], 0, 0, 0); __builtin_amdgcn_s_setprio(0); } while (0)
#define PG8_WAIT_V(n) asm volatile("s_waitcnt vmcnt(" #n ")" ::: "memory")
#define PG8_WAIT_L(n) asm volatile("s_waitcnt lgkmcnt(" #n ")" ::: "memory")
#define PG8_BAR __builtin_amdgcn_s_barrier()
#define PG8_SCHED __builtin_amdgcn_sched_barrier(0)
    Unit cur, nxt; int ui = 0;
    if (!S.next(0, cur)) return;
    f32x4 acc[2][2][4][2];
#pragma unroll
    for (int a = 0; a < 2; ++a)
#pragma unroll
        for (int b = 0; b < 2; ++b)
#pragma unroll
            for (int m = 0; m < 4; ++m)
#pragma unroll
                for (int n = 0; n < 2; ++n) acc[a][b][m][n] = (f32x4){0.f, 0.f, 0.f, 0.f};
    bf16x8 At[4][2], B0[2][2], B1[2][2];
    const char* cA = (const char*)g.A + (size_t)cur.pm * tstepA; const char* cB = (const char*)g.Bt + (size_t)cur.pn * tstepB;
    PG8_STAGE(PG8_SB(0, 0), cB, voffB); PG8_STAGE(PG8_SB(0, 1), cB + hstepB, voffB); PG8_STAGE(PG8_SA(0, 0), cA, voffA); PG8_STAGE(PG8_SA(0, 1), cA + hstepA, voffA);
    if (wr == 1) PG8_BAR;
    PG8_WAIT_V(2); PG8_BAR;
    PG8_STAGE(PG8_SB(1, 0), cB + kstepB, voffB); PG8_STAGE(PG8_SA(1, 0), cA + kstepA, voffA); PG8_STAGE(PG8_SB(1, 1), cB + hstepB + kstepB, voffB);
    PG8_WAIT_V(6); PG8_BAR;
    for (;;) {
        const bool has_next = S.next(ui + 1, nxt);
        const char* nA = has_next ? (const char*)g.A + (size_t)nxt.pm * tstepA : cA; const char* nB = has_next ? (const char*)g.Bt + (size_t)nxt.pn * tstepB : cB;
        for (int t = 0; t < nt; t += 2) {
            const bool last = (t == nt - 2);
            const char* a1 = cA + (size_t)(t + 1) * kstepA;
            const char* a2 = last ? nA : cA + (size_t)(t + 2) * kstepA; const char* b2 = last ? nB : cB + (size_t)(t + 2) * kstepB;
            const char* a3 = a2 + kstepA; const char* b3 = b2 + kstepB;
            PG8_LDB(B0, 0, 0); PG8_LDB(B1, 0, 1); PG8_SCHED; PG8_LDA(At, 0, 0); PG8_STAGE(PG8_SA(1, 1), a1 + hstepA, voffA);
            PG8_WAIT_V(8); PG8_WAIT_L(0); PG8_BAR; PG8_MMA(0, 0, At, B0); PG8_MMA(0, 1, At, B1); PG8_BAR; PG8_SCHED;
            PG8_LDA(At, 0, 1); PG8_STAGE(PG8_SB(0, 0), b2, voffB); PG8_STAGE(PG8_SB(0, 1), b2 + hstepB, voffB); PG8_STAGE(PG8_SA(0, 0), a2, voffA);
            PG8_WAIT_V(8); PG8_WAIT_L(0); PG8_BAR; PG8_MMA(1, 0, At, B0); PG8_MMA(1, 1, At, B1); PG8_BAR; PG8_SCHED;
            PG8_LDB(B0, 1, 0); PG8_LDB(B1, 1, 1); PG8_SCHED; PG8_LDA(At, 1, 0); PG8_STAGE(PG8_SA(0, 1), a2 + hstepA, voffA);
            PG8_WAIT_V(8); PG8_WAIT_L(0); PG8_BAR; PG8_MMA(0, 0, At, B0); PG8_MMA(0, 1, At, B1); PG8_BAR; PG8_SCHED;
            PG8_LDA(At, 1, 1); PG8_STAGE(PG8_SB(1, 0), b3, voffB); PG8_STAGE(PG8_SB(1, 1), b3 + hstepB, voffB); PG8_STAGE(PG8_SA(1, 0), a3, voffA);
            PG8_WAIT_V(8); PG8_WAIT_L(0); PG8_BAR; PG8_MMA(1, 0, At, B0); PG8_MMA(1, 1, At, B1); PG8_BAR; PG8_SCHED;
        }
        if constexpr (ALIGN_EPI) { if (wr == 0) PG8_BAR; }
        if constexpr (!Epi::AFTER_DRAIN) { E(acc, cur, ui, wr, wc, fr, fq); }
        if (!has_next) break;
#pragma unroll
        for (int a = 0; a < 2; ++a)
#pragma unroll
            for (int b = 0; b < 2; ++b)
#pragma unroll
                for (int m = 0; m < 4; ++m)
#pragma unroll
                    for (int n = 0; n < 2; ++n) acc[a][b][m][n] = (f32x4){0.f, 0.f, 0.f, 0.f};
        cur = nxt; cA = nA; cB = nB; ++ui;
        if constexpr (ALIGN_EPI) { if (wr == 1) PG8_BAR; }
    }
    PG8_WAIT_V(0);
    if constexpr (!ALIGN_EPI) { if (wr == 0) PG8_BAR; }
    PG8_BAR;
    if constexpr (Epi::AFTER_DRAIN) { E.fused(acc, cur, wr, wc, fr, fq, lds, wid, lane); }
#undef PG8_SA
#undef PG8_SB
#undef PG8_STAGE
#undef PG8_LDA
#undef PG8_LDB
#undef PG8_MMA
#undef PG8_WAIT_V
#undef PG8_WAIT_L
#undef PG8_BAR
#undef PG8_SCHED
}
}

#define XB_TMO      128
#define XB_XCNT(j)  (256  + 64 * (j))
#define XB_XSUB(j)  (1280 + 64 * (j))
#define XB_XGEN(j)  (2304 + 64 * (j))
#define XB_TOP      3328
#define XB_TOPGEN   3392
#define XCD_BAR_WORDS 3456
#define XB_SPIN_CAP (1u << 20)
__device__ __forceinline__ unsigned xb_ld(unsigned* p)              { return __hip_atomic_load(p, __ATOMIC_RELAXED, __HIP_MEMORY_SCOPE_AGENT); }
__device__ __forceinline__ unsigned xb_add(unsigned* p, unsigned v) { return __hip_atomic_fetch_add(p, v, __ATOMIC_RELAXED, __HIP_MEMORY_SCOPE_AGENT); }
__device__ __forceinline__ unsigned xb_xcc_id() { return (unsigned)__builtin_amdgcn_s_getreg((3 << 11) | 20) & 0xFu; }
#define XB_SPIN(cond, bar) do { unsigned _sp = 0; while (cond) { __builtin_amdgcn_s_sleep(1); \
    if ((++_sp & 255u) == 0u) { if (xb_ld(&(bar)[XB_TMO])) break; if (_sp > XB_SPIN_CAP) { atomicAdd(&(bar)[XB_TMO], 1u); break; } } } } while (0)
__device__ __forceinline__ void xcd_barrier_complete(unsigned* bar, unsigned x, unsigned G, unsigned& nloc, unsigned& nx) {
    unsigned sum, cnt, mine, sp = 0u;
    for (;;) {
        sum = 0u; cnt = 0u; mine = 0u;
#pragma unroll
        for (unsigned j = 0; j < 16; ++j) { const unsigned c = xb_ld(&bar[XB_XCNT(j)]); sum += c; cnt += (c > 0u) ? 1u : 0u; mine = (j == x) ? c : mine; }
        if (sum == G) break;
        __builtin_amdgcn_s_sleep(1);
        if ((++sp & 255u) == 0u) { if (xb_ld(&bar[XB_TMO])) break; if (sp > XB_SPIN_CAP) { atomicAdd(&bar[XB_TMO], 1u); break; } }
    }
    nloc = mine > 0u ? mine : 1u; nx = cnt > 0u ? cnt : 1u;
}
__device__ __forceinline__ void xcd_barrier(unsigned* bar, volatile LAS unsigned* st, bool leader_thread, unsigned G) {
    asm volatile("s_waitcnt vmcnt(0)" ::: "memory");
    __syncthreads();
    if (leader_thread) {
        const unsigned x = xb_xcc_id();
        __builtin_amdgcn_s_waitcnt(0);
        unsigned nloc = st[0], nx = st[1];
        if (nloc == 0u) { xcd_barrier_complete(bar, x, G, nloc, nx); st[0] = nloc; st[1] = nx; }
        const unsigned old = xb_add(&bar[XB_XSUB(x)], 1u);
        const unsigned gen = old / nloc;
        if (old + 1u == (gen + 1u) * nloc) {
            __builtin_amdgcn_fence(__ATOMIC_RELEASE, "agent");
            asm volatile("s_waitcnt vmcnt(0)" ::: "memory");
            const unsigned og = xb_add(&bar[XB_TOP], 1u);
            const unsigned tg = og / nx;
            if (og + 1u == (tg + 1u) * nx) xb_add(&bar[XB_TOPGEN], 1u);
            else XB_SPIN(xb_ld(&bar[XB_TOPGEN]) == tg, bar);
            __builtin_amdgcn_fence(__ATOMIC_ACQUIRE, "agent");
            xb_add(&bar[XB_XGEN(x)], 1u);
            asm volatile("s_waitcnt vmcnt(0)" ::: "memory");
        } else {
            XB_SPIN(xb_ld(&bar[XB_XGEN(x)]) == gen, bar);
            __builtin_amdgcn_fence(__ATOMIC_ACQUIRE, "agent");
            asm volatile("s_waitcnt vmcnt(0)" ::: "memory");
        }
    }
    __syncthreads();
}

struct Args {
    const float* x; const float* p; const float* w_in; const float* w_out; const float* cmp_pos; const float* cmp_w1; const float* cmp_w2; const float* hg_lb;
    const float* g_pre_mix; const float* g_post_mix; const float* g_pre_mlp; const float* g_post_mlp; const float* w_up; const float* w_down; const float* g_ple;
    const float* w_ple_gate; const float* w_ple_proj;
    float* out; unsigned char* ws; int ph_lo, ph_hi;
};

struct Frame {
    LAS unsigned char* lds;
    int tid, lane, wave, G, bid;
    unsigned char* ws;
};

template <class T> __device__ __forceinline__ T* uptr(T* p) {
    const unsigned long long v = (unsigned long long)p; const unsigned lo = __builtin_amdgcn_readfirstlane((unsigned)v), hi = __builtin_amdgcn_readfirstlane((unsigned)(v >> 32));
    return (T*)(__attribute__((address_space(1))) T*)(((unsigned long long)hi << 32) | lo);
}
__device__ __forceinline__ Frame make_frame(LAS unsigned char* lds, Args& A) {
    Frame G; G.lds = lds;
    int lane; asm volatile("v_mbcnt_lo_u32_b32 %0, -1, 0\n\tv_mbcnt_hi_u32_b32 %0, -1, %0" : "=v"(lane));
    const unsigned hw = (unsigned)__builtin_amdgcn_s_getreg((5 << 11) | 4) & 63u;
    unsigned aoff = LDS_ARGS; asm volatile("" : "+v"(aoff));
    int wave = (int)((const LAS unsigned*)(lds + aoff + (LDS_WTAB - LDS_ARGS)))[hw];
    wave = __builtin_amdgcn_readfirstlane(wave);
    asm volatile("" : "+s"(wave));
    G.lane = lane; G.wave = wave; G.tid = wave * 64 + lane;
    int bid = blockIdx.x, gg = gridDim.x; asm volatile("" : "+s"(bid), "+s"(gg));
    G.bid = bid; G.G = gg;
    const LAS Args* la = (const LAS Args*)(lds + aoff);
    A.x = uptr(la->x); A.p = uptr(la->p); A.w_in = uptr(la->w_in); A.w_out = uptr(la->w_out); A.cmp_pos = uptr(la->cmp_pos); A.cmp_w1 = uptr(la->cmp_w1); A.cmp_w2 = uptr(la->cmp_w2);
    A.hg_lb = uptr(la->hg_lb); A.g_pre_mix = uptr(la->g_pre_mix); A.g_post_mix = uptr(la->g_post_mix); A.g_pre_mlp = uptr(la->g_pre_mlp); A.g_post_mlp = uptr(la->g_post_mlp);
    A.w_up = uptr(la->w_up); A.w_down = uptr(la->w_down); A.g_ple = uptr(la->g_ple); A.w_ple_gate = uptr(la->w_ple_gate); A.w_ple_proj = uptr(la->w_ple_proj);
    A.out = uptr(la->out); A.ws = uptr(la->ws); A.ph_lo = 0; A.ph_hi = 0;
    G.ws = A.ws;
    return G;
}
template <class Sched> __device__ __forceinline__ void fill_rstd(const Frame& F, const float* ss, const Sched& S) {
    LAS float* tab = (LAS float*)(F.lds + LDS_RSTD);
    const int half = F.tid >> 8, r = F.tid & 255;
#pragma unroll 1
    for (int i0 = 0; i0 < 8; i0 += 2) {
        pg8::Unit u; if (!S.next(i0 + half, u)) continue;
        tab[(i0 + half) * 256 + r] = pg8::row_rstd16(ss, (long)u.pm * 256 + r);
    }
    __syncthreads();
}
__device__ __forceinline__ void transpose_item(const float* W, int ldw, int col0, int k0, bf16_t* WT, int ldk, int drow0, const float* gsc, int lane) {
    float v[64];
    const float* src = W + (size_t)k0 * ldw + col0 + lane;
#pragma unroll
    for (int k = 0; k < 64; ++k) v[k] = src[(size_t)k * ldw];
    if (gsc) {
#pragma unroll
        for (int k = 0; k < 64; ++k) v[k] *= gsc[k0 + k];
    }
    bf16_t* dst = WT + (size_t)(drow0 + lane) * ldk + k0;
#pragma unroll
    for (int c = 0; c < 8; ++c) { u32x4 o; o.x = pk2(v[8 * c], v[8 * c + 1]); o.y = pk2(v[8 * c + 2], v[8 * c + 3]); o.z = pk2(v[8 * c + 4], v[8 * c + 5]); o.w = pk2(v[8 * c + 6], v[8 * c + 7]); *(u32x4*)(dst + 8 * c) = o; }
}

__device__ __forceinline__ void phase_prologue(const Frame& F, const Args& a) {
    const int gw = F.bid * 8 + F.wave, NGW = F.G * 8;
    {
        constexpr int I_IN1 = 16 * 18, I_IN2 = 16 * 34, I_OUT = 16 * 16, I_UP = 16 * 64, I_DN = 64 * 16, I_G = 16 * 16, I_PJ = 4 * 16, I_C1 = 32 * 4;
        constexpr int I_LAYER = I_IN1 + I_IN2 + I_OUT + I_UP + I_DN + I_G + I_PJ + 2 * I_C1;
        for (int it = gw; it < DEPTH * I_LAYER; it += NGW) {
            const int l = it / I_LAYER; int r = it % I_LAYER;
            const float* W; int ldw, col0, K; bf16_t* WT; int drow0; const float* gsc = nullptr;
            if (r < I_IN1) { W = a.w_in + (size_t)l * DM * IN_TOTAL; ldw = IN_TOTAL; col0 = 0; K = DM; WT = (bf16_t*)(F.ws + WS_WIN) + (size_t)l * NPROJ * DM; drow0 = 0; gsc = a.g_pre_mix + l * DM; }
            else if ((r -= I_IN1) < I_IN2) { W = a.w_in + (size_t)l * DM * IN_TOTAL; ldw = IN_TOTAL; col0 = 1170; K = DM; WT = (bf16_t*)(F.ws + WS_WIN) + (size_t)l * NPROJ * DM; drow0 = 1152; gsc = a.g_pre_mix + l * DM; }
            else if ((r -= I_IN2) < I_OUT) { W = a.w_out + (size_t)l * DM * DM; ldw = DM; col0 = 0; K = DM; WT = (bf16_t*)(F.ws + WS_WOUT) + (size_t)l * DM * DM; drow0 = 0; }
            else if ((r -= I_OUT) < I_UP) { W = a.w_up + (size_t)l * DM * FF; ldw = FF; col0 = 0; K = DM; WT = (bf16_t*)(F.ws + WS_WUP) + (size_t)l * FF * DM; drow0 = 0; gsc = a.g_pre_mlp + l * DM; }
            else if ((r -= I_UP) < I_DN) { W = a.w_down + (size_t)l * FF * DM; ldw = DM; col0 = 0; K = FF; WT = (bf16_t*)(F.ws + WS_WDN) + (size_t)l * DM * FF; drow0 = 0; }
            else if ((r -= I_DN) < I_G) { W = a.w_ple_gate + (size_t)l * DM * DM; ldw = DM; col0 = 0; K = DM; WT = (bf16_t*)(F.ws + WS_WG) + (size_t)l * DM * DM; drow0 = 0; gsc = a.g_ple + l * DM; }
            else if ((r -= I_G) < I_PJ) { W = a.w_ple_proj + (size_t)l * PLE * DM; ldw = DM; col0 = 0; K = PLE; WT = (bf16_t*)(F.ws + WS_WPJ) + (size_t)l * DM * PLE; drow0 = 0; }
            else { r -= I_PJ; const int kv = r / I_C1; r -= kv * I_C1; W = a.cmp_w1 + (size_t)(l * 2 + kv) * 2048 * 256; ldw = 256; col0 = 0; K = 2048; WT = (bf16_t*)(F.ws + WS_W1T) + (size_t)(l * 2 + kv) * 256 * 2048; drow0 = 0; }
            const int nk = K / 64, nb = r / nk, kb = r % nk;
            transpose_item(W, ldw, col0 + 64 * nb, 64 * kb, WT, K, drow0 + 64 * nb, gsc, F.lane);
        }
    }
    for (int l = 0; l < DEPTH; ++l) {
        bf16_t* WIN = (bf16_t*)(F.ws + WS_WIN) + (size_t)l * NPROJ * DM;
        const float* win = a.w_in + (size_t)l * DM * IN_TOTAL; const float* gs = a.g_pre_mix + l * DM;
        for (int idx = F.bid * 512 + F.tid; idx < 256 * DM; idx += F.G * 512) {
            const int r = idx >> 10, k = idx & 1023;
            float v = 0.f; if (r < 18) v = win[(size_t)k * IN_TOTAL + 1152 + r] * gs[k];
            WIN[(size_t)(3328 + r) * DM + k] = (bf16_t)f2bf(v);
        }
    }
    {
        bf16_t* HBB = (bf16_t*)a.out; float* SSB = (float*)(F.ws + WS_SSB);
        for (int m = gw * 2; m < MTOK; m += NGW * 2) {
            const f32x4* xr = (const f32x4*)(a.x + (size_t)m * DM) + F.lane;
            f32x4 v[8]; float s0 = 0.f, s1 = 0.f;
#pragma unroll
            for (int j = 0; j < 8; ++j) v[j] = xr[64 * j];
#pragma unroll
            for (int j = 0; j < 4; ++j) { s0 += (v[j].x * v[j].x + v[j].y * v[j].y) + (v[j].z * v[j].z + v[j].w * v[j].w); s1 += (v[j + 4].x * v[j + 4].x + v[j + 4].y * v[j + 4].y) + (v[j + 4].z * v[j + 4].z + v[j + 4].w * v[j + 4].w); }
            s0 = wave_sum(s0); s1 = wave_sum(s1);
            unsigned long long* o8 = (unsigned long long*)(HBB + (size_t)m * DM) + F.lane;
#pragma unroll
            for (int j = 0; j < 8; ++j) o8[64 * j] = (unsigned long long)pk2(v[j].x, v[j].y) | ((unsigned long long)pk2(v[j].z, v[j].w) << 32);
            if (F.lane < 32) SSB[(size_t)m * 16 + F.lane] = (F.lane == 0) ? s0 : ((F.lane == 16) ? s1 : 0.f);
        }
    }
    {
        float* part = (float*)(F.ws + WS_B1P);
        for (int it = gw; it < 4 * 16 * 4; it += NGW) {
            const int jb = it & 3, c = (it >> 2) & 15, lk = it >> 6;
            const float* pos = a.cmp_pos + (size_t)lk * 2048; const float* w1 = a.cmp_w1 + (size_t)lk * 2048 * 256;
            const int j = jb * 64 + F.lane; float s = 0.f;
#pragma unroll 32
            for (int k = c * 128; k < c * 128 + 128; ++k) s += pos[k] * w1[(size_t)k * 256 + j];
            part[(size_t)(lk * 16 + c) * 256 + j] = s;
        }
    }
}

__device__ __forceinline__ void reduce_bias1(const Frame& F) {
    if (F.bid != 0) return;
    const float* part = (const float*)(F.ws + WS_B1P); float* fin = (float*)(F.ws + WS_B1P + 65536);
    for (int idx = F.tid; idx < 4 * 256; idx += 512) { const int lk = idx >> 8, j = idx & 255; float s = 0.f;
        for (int c = 0; c < 16; ++c) s += part[(size_t)(lk * 16 + c) * 256 + j];
        fin[idx] = s; }
}

__device__ __forceinline__ void convert_p(const Frame& F, const Args& a, int l) {
    const float* src = a.p + (size_t)l * MTOK * PLE; bf16_t* PB = (bf16_t*)(F.ws + WS_PB);
    const size_t n8 = (size_t)MTOK * PLE / 8;
    for (size_t i = (size_t)F.bid * 512 + F.tid; i < n8; i += (size_t)F.G * 512) {
        const f32x4 v0 = *(const f32x4*)(src + i * 8), v1 = *(const f32x4*)(src + i * 8 + 4);
        u32x4 w; w.x = pk2(v0.x, v0.y); w.y = pk2(v0.z, v0.w); w.z = pk2(v1.x, v1.y); w.w = pk2(v1.z, v1.w);
        *(u32x4*)(PB + i * 8) = w;
    }
}

__device__ __forceinline__ void load64(const bf16_t* p, float (&v)[64], float sc) {
    const u32x4* p4 = (const u32x4*)p;
#pragma unroll
    for (int i = 0; i < 8; ++i) { const u32x4 w = p4[i];
        v[8 * i + 0] = bf_lo(w.x) * sc; v[8 * i + 1] = bf_hi(w.x) * sc; v[8 * i + 2] = bf_lo(w.y) * sc; v[8 * i + 3] = bf_hi(w.y) * sc;
        v[8 * i + 4] = bf_lo(w.z) * sc; v[8 * i + 5] = bf_hi(w.z) * sc; v[8 * i + 6] = bf_lo(w.w) * sc; v[8 * i + 7] = bf_hi(w.w) * sc; }
}
__device__ __forceinline__ void stage_bf16(LAS float* dst, const bf16_t* src, int ld, int tid) {
    const int r = tid >> 3, c = tid & 7;
    const u32x4 w = *(const u32x4*)(src + (size_t)r * ld + c * 8);
    const f32x4 v0 = {bf_lo(w.x), bf_hi(w.x), bf_lo(w.y), bf_hi(w.y)}, v1 = {bf_lo(w.z), bf_hi(w.z), bf_lo(w.w), bf_hi(w.w)};
    *(LAS f32x4*)(dst + r * 64 + c * 8) = v0; *(LAS f32x4*)(dst + r * 64 + c * 8 + 4) = v1;
}
__device__ __forceinline__ void stage_f32(LAS float* dst, const float* src, int tid) {
    const int r = tid >> 3, c = tid & 7;
    const f32x4 v0 = *(const f32x4*)(src + r * 64 + c * 8), v1 = *(const f32x4*)(src + r * 64 + c * 8 + 4);
    *(LAS f32x4*)(dst + r * 64 + c * 8) = v0; *(LAS f32x4*)(dst + r * 64 + c * 8 + 4) = v1;
}
__device__ __forceinline__ float dot64(const LAS float* kr, const float (&q)[64]) {
    float s0 = 0.f, s1 = 0.f, s2 = 0.f, s3 = 0.f;
#pragma unroll
    for (int d = 0; d < 64; d += 4) { const f32x4 kv = *(const LAS f32x4*)(kr + d); s0 += q[d] * kv.x; s1 += q[d + 1] * kv.y; s2 += q[d + 2] * kv.z; s3 += q[d + 3] * kv.w; }
    return (s0 + s1) + (s2 + s3);
}
template <class FN>
__device__ __forceinline__ void attend64(const LAS float* Kt, const LAS float* Vt, const float (&q)[64], float (&o)[64], float& m, float& l, FN fn) {
#pragma unroll 1
    for (int j = 0; j < 64; ++j) {
        float bias; if (!fn(j, bias)) continue;
        const float s = dot64(Kt + j * 64, q) + bias;
        if (s > m) { const float c = __expf(m - s); l *= c;
#pragma unroll
            for (int d = 0; d < 64; ++d) o[d] *= c;
            m = s; }
        const float pr = __expf(s - m); l += pr;
#pragma unroll
        for (int d = 0; d < 64; d += 4) { const f32x4 vv = *(const LAS f32x4*)(Vt + j * 64 + d); o[d] += pr * vv.x; o[d + 1] += pr * vv.y; o[d + 2] += pr * vv.z; o[d + 3] += pr * vv.w; }
    }
}
__device__ __forceinline__ float nsa_slope(int h) {
    const int idx = (h >> 1) * 4 + 2 + (h & 1);
    return exp2f(-2.0f * (float)(idx + 1) / 3.0f);
}
__device__ __forceinline__ float dil_slope(int h) {
    const int idx = (h >> 1) * 4 + (h & 1);
    return exp2f(-2.0f * (float)(idx + 1) / 3.0f);
}

namespace att {
typedef short bf16x8 __attribute__((ext_vector_type(8)));
typedef short v4i16 __attribute__((ext_vector_type(4)));
typedef __bf16 bf16x2_t __attribute__((ext_vector_type(2)));
constexpr float NEG = -1e30f, MFLOOR = -1e20f, LOG2E = 1.4426950408889634f, LN2 = 0.6931471805599453f;
constexpr int TILE_BYTES = 8192;
__device__ __forceinline__ int k_off(int row, int ch) { return row * 128 + ((ch ^ ((row >> 1) & 7)) << 4); }
__device__ __forceinline__ int v_off(int row, int byte) { return row * 128 + (byte ^ (((row >> 1) & 3) << 5)); }
__device__ __forceinline__ unsigned cvtpk(float lo, float hi) { f32x2 v = {lo, hi}; bf16x2_t b = __builtin_convertvector(v, bf16x2_t); return __builtin_bit_cast(unsigned, b); }

template <int NH> struct State { f32x4 O[NH][4]; float m[NH], l[NH]; };
template <int NH> __device__ __forceinline__ void state_reset(State<NH>& st, float m0 = MFLOOR) {
#pragma unroll
    for (int g = 0; g < NH; ++g) { st.m[g] = m0; st.l[g] = 0.f;
#pragma unroll
        for (int nt = 0; nt < 4; ++nt) st.O[g][nt] = (f32x4){0.f, 0.f, 0.f, 0.f}; }
}
struct Lane { int c, grp; int kb0, kb1; int vb[4]; };
__device__ __forceinline__ Lane make_lane(int lane) {
    Lane L; L.c = lane & 15; L.grp = lane >> 4;
    L.kb0 = k_off(L.c, L.grp); L.kb1 = k_off(L.c, 4 + L.grp);
    const int i = L.c, sw = ((L.grp & 1) << 1) | (i >> 3);
#pragma unroll
    for (int nt = 0; nt < 4; ++nt) L.vb[nt] = (4 * L.grp + (i >> 2)) * 128 + ((32 * nt + 8 * (i & 3)) ^ (sw << 5));
    return L;
}
struct StageRegs { u32x4 k, v; };
__device__ __forceinline__ void stage_load(StageRegs& r, const bf16_t* srcK, const bf16_t* srcV, long ld, int tid) {
    const int R = tid >> 3, ch = tid & 7;
    r.k = *(const u32x4*)(srcK + (size_t)R * ld + ch * 8); r.v = *(const u32x4*)(srcV + (size_t)R * ld + ch * 8);
}
__device__ __forceinline__ void stage_store(const StageRegs& r, LAS unsigned char* Kt, LAS unsigned char* Vt, int tid) {
    const int R = tid >> 3, ch = tid & 7;
    *(LAS u32x4*)(Kt + k_off(R, ch)) = r.k; *(LAS u32x4*)(Vt + v_off(R, ch * 16)) = r.v;
}
template <int NH> __device__ __forceinline__ void scores(const LAS unsigned char* Kt, const Lane& L, const bf16x8 (&qf)[NH][2], const float (&slope)[NH], float brel, f32x4 (&S)[NH][4]) {
#pragma unroll
    for (int g = 0; g < NH; ++g) { const float sb = slope[g] * brel;
#pragma unroll
        for (int kt = 0; kt < 4; ++kt)
#pragma unroll
            for (int r = 0; r < 4; ++r) S[g][kt][r] = __builtin_fmaf(slope[g], (float)(16 * kt + r), sb); }
#pragma unroll
    for (int kt = 0; kt < 4; ++kt) {
        const bf16x8 k0 = *(const LAS bf16x8*)(Kt + L.kb0 + kt * 2048), k1 = *(const LAS bf16x8*)(Kt + L.kb1 + kt * 2048);
#pragma unroll
        for (int g = 0; g < NH; ++g) {
            S[g][kt] = __builtin_amdgcn_mfma_f32_16x16x32_bf16(k0, qf[g][0], S[g][kt], 0, 0, 0);
            S[g][kt] = __builtin_amdgcn_mfma_f32_16x16x32_bf16(k1, qf[g][1], S[g][kt], 0, 0, 0);
        }
    }
}
template <int NH> __device__ __forceinline__ void scores_lds(const LAS unsigned char* Kt, const Lane& L, const LAS unsigned char* qlds, int lane, const float (&slope)[NH], float brel, f32x4 (&S)[NH][4]) {
    bf16x8 kf[4][2];
#pragma unroll
    for (int kt = 0; kt < 4; ++kt) { kf[kt][0] = *(const LAS bf16x8*)(Kt + L.kb0 + kt * 2048); kf[kt][1] = *(const LAS bf16x8*)(Kt + L.kb1 + kt * 2048); }
#pragma unroll
    for (int g = 0; g < NH; ++g) {
        const bf16x8 q0 = *(const LAS bf16x8*)(qlds + ((g * 2 + 0) * 64 + lane) * 16), q1 = *(const LAS bf16x8*)(qlds + ((g * 2 + 1) * 64 + lane) * 16);
        const float sb = slope[g] * brel;
#pragma unroll
        for (int kt = 0; kt < 4; ++kt) {
#pragma unroll
            for (int r = 0; r < 4; ++r) S[g][kt][r] = __builtin_fmaf(slope[g], (float)(16 * kt + r), sb);
            S[g][kt] = __builtin_amdgcn_mfma_f32_16x16x32_bf16(kf[kt][0], q0, S[g][kt], 0, 0, 0);
            S[g][kt] = __builtin_amdgcn_mfma_f32_16x16x32_bf16(kf[kt][1], q1, S[g][kt], 0, 0, 0);
        }
    }
}
template <int NH> __device__ __forceinline__ void mask(f32x4 (&S)[NH][4], int drel, int dlo, bool row_on) {
#pragma unroll
    for (int kt = 0; kt < 4; ++kt)
#pragma unroll
        for (int r = 0; r < 4; ++r) { const int dl = drel + 16 * kt + r; const bool ok = row_on && dl <= 0 && dl >= dlo;
#pragma unroll
            for (int g = 0; g < NH; ++g) S[g][kt][r] = ok ? S[g][kt][r] : NEG; }
}
template <int NH> __device__ __forceinline__ void online(f32x4 (&S)[NH][4], State<NH>& st) {
#pragma unroll
    for (int g = 0; g < NH; ++g) {
        float mx = fmaxf(fmaxf(S[g][0][0], S[g][0][1]), fmaxf(S[g][0][2], S[g][0][3]));
#pragma unroll
        for (int kt = 1; kt < 4; ++kt) mx = fmaxf(mx, fmaxf(fmaxf(S[g][kt][0], S[g][kt][1]), fmaxf(S[g][kt][2], S[g][kt][3])));
        mx = fmaxf(mx, x16f(mx)); mx = fmaxf(mx, x32f(mx));
        const float mnew = fmaxf(st.m[g], mx);
        const float alpha = __builtin_amdgcn_exp2f(st.m[g] - mnew);
        st.m[g] = mnew; st.l[g] *= alpha;
#pragma unroll
        for (int nt = 0; nt < 4; ++nt) st.O[g][nt] = st.O[g][nt] * alpha;
        float ls = 0.f;
#pragma unroll
        for (int kt = 0; kt < 4; ++kt)
#pragma unroll
            for (int r = 0; r < 4; ++r) { const float pr = __builtin_amdgcn_exp2f(S[g][kt][r] - mnew); S[g][kt][r] = pr; ls += pr; }
        st.l[g] += ls;
    }
}
template <int NH> __device__ __forceinline__ void pv(const LAS unsigned char* Vt, const Lane& L, const f32x4 (&P)[NH][4], State<NH>& st) {
#pragma unroll
    for (int s2 = 0; s2 < 2; ++s2) {
        bf16x8 pf[NH];
#pragma unroll
        for (int g = 0; g < NH; ++g) { u32x4 w; w.x = cvtpk(P[g][2 * s2][0], P[g][2 * s2][1]); w.y = cvtpk(P[g][2 * s2][2], P[g][2 * s2][3]);
            w.z = cvtpk(P[g][2 * s2 + 1][0], P[g][2 * s2 + 1][1]); w.w = cvtpk(P[g][2 * s2 + 1][2], P[g][2 * s2 + 1][3]); pf[g] = __builtin_bit_cast(bf16x8, w); }
#pragma unroll
        for (int nt = 0; nt < 4; ++nt) {
            const v4i16 lo = __builtin_amdgcn_ds_read_tr16_b64_v4i16((LAS v4i16*)(Vt + L.vb[nt] + 4096 * s2));
            const v4i16 hi = __builtin_amdgcn_ds_read_tr16_b64_v4i16((LAS v4i16*)(Vt + L.vb[nt] + 4096 * s2 + 2048));
            const bf16x8 vf = {lo[0], lo[1], lo[2], lo[3], hi[0], hi[1], hi[2], hi[3]};
#pragma unroll
            for (int g = 0; g < NH; ++g) st.O[g][nt] = __builtin_amdgcn_mfma_f32_16x16x32_bf16(vf, pf[g], st.O[g][nt], 0, 0, 0);
        }
    }
}
constexpr float BIGD = 1e30f, RTHR = 8.0f;
template <int NH, int MODE> __device__ __forceinline__ void tile_qk(const LAS unsigned char* Kt, const Lane& L, const LAS unsigned char* qlds, int lane,
        const float (&slope)[NH], float brel, int drel, int dlo, bool row_on, bool need_mask, const State<NH>& st, f32x4 (&S)[NH][4]) {
    {
        f32x4 dm[4];
#pragma unroll
        for (int kt = 0; kt < 4; ++kt)
#pragma unroll
            for (int r = 0; r < 4; ++r) dm[kt][r] = brel + (float)(16 * kt + r);
        if (need_mask) {
#pragma unroll
            for (int kt = 0; kt < 4; ++kt)
#pragma unroll
                for (int r = 0; r < 4; ++r) { const int dl = drel + 16 * kt + r; dm[kt][r] = (row_on && dl <= 0 && dl >= dlo) ? dm[kt][r] : -BIGD; }
        }
        bf16x8 kf[4][2];
#pragma unroll
        for (int kt = 0; kt < 4; ++kt) { kf[kt][0] = *(const LAS bf16x8*)(Kt + L.kb0 + kt * 2048); kf[kt][1] = *(const LAS bf16x8*)(Kt + L.kb1 + kt * 2048); }
        __builtin_amdgcn_s_setprio(1);
#pragma unroll
        for (int g = 0; g < NH; ++g) {
            const bf16x8 q0 = *(const LAS bf16x8*)(qlds + ((g * 2 + 0) * 64 + lane) * 16), q1 = *(const LAS bf16x8*)(qlds + ((g * 2 + 1) * 64 + lane) * 16);
            float mref = st.m[g]; asm volatile("" : "+v"(mref));
#pragma unroll
            for (int kt = 0; kt < 4; ++kt) {
                S[g][kt] = (MODE == 0) ? dm[kt] * slope[g] - mref : dm[kt] * slope[g];
                S[g][kt] = __builtin_amdgcn_mfma_f32_16x16x32_bf16(kf[kt][0], q0, S[g][kt], 0, 0, 0);
                S[g][kt] = __builtin_amdgcn_mfma_f32_16x16x32_bf16(kf[kt][1], q1, S[g][kt], 0, 0, 0);
            }
        }
        __builtin_amdgcn_s_setprio(0);
    }
}
template <int NH, int MODE> __device__ __forceinline__ void tile_sv(const LAS unsigned char* Vt, const Lane& L, f32x4 (&S)[NH][4], State<NH>& st,
        const float (&mfix)[NH], const float (&ilfix)[NH], float (&impm)[4], float (&impn)[4]) {
    bf16x8 pf[NH][2];
#pragma unroll
    for (int g = 0; g < NH; ++g) {
        if (MODE == 2) {
#pragma unroll
            for (int kt = 0; kt < 4; ++kt) {
#pragma unroll
                for (int r = 0; r < 4; ++r) S[g][kt][r] = __builtin_amdgcn_exp2f(S[g][kt][r] - mfix[g]) * ilfix[g];
                impm[kt] += (S[g][kt][0] + S[g][kt][1]) + (S[g][kt][2] + S[g][kt][3]); impn[kt] += S[g][kt][3];
            }
        } else if (MODE == 0) {
            float mg = st.m[g], lg = st.l[g];
            float ls = 0.f; u32x4 w0, w1;
#define TH_EXPPACK(dl_) do { float p_[4][4]; ls = 0.f; \
                _Pragma("unroll") for (int kt = 0; kt < 4; ++kt) _Pragma("unroll") for (int r = 0; r < 4; ++r) { p_[kt][r] = __builtin_amdgcn_exp2f(S[g][kt][r] - (dl_)); ls += p_[kt][r]; } \
                w0.x = cvtpk(p_[0][0], p_[0][1]); w0.y = cvtpk(p_[0][2], p_[0][3]); w0.z = cvtpk(p_[1][0], p_[1][1]); w0.w = cvtpk(p_[1][2], p_[1][3]); \
                w1.x = cvtpk(p_[2][0], p_[2][1]); w1.y = cvtpk(p_[2][2], p_[2][3]); w1.z = cvtpk(p_[3][0], p_[3][1]); w1.w = cvtpk(p_[3][2], p_[3][3]); } while (0)
            {   float p_[4][4];
#pragma unroll
                for (int kt = 0; kt < 4; ++kt)
#pragma unroll
                    for (int r = 0; r < 4; ++r) { p_[kt][r] = __builtin_amdgcn_exp2f(S[g][kt][r]); ls += p_[kt][r]; }
                w0.x = cvtpk(p_[0][0], p_[0][1]); w0.y = cvtpk(p_[0][2], p_[0][3]); w0.z = cvtpk(p_[1][0], p_[1][1]); w0.w = cvtpk(p_[1][2], p_[1][3]);
                w1.x = cvtpk(p_[2][0], p_[2][1]); w1.y = cvtpk(p_[2][2], p_[2][3]); w1.z = cvtpk(p_[3][0], p_[3][1]); w1.w = cvtpk(p_[3][2], p_[3][3]); }
            if (__builtin_expect(__any(!(ls < 4096.f)), 0)) {
                float mx = __builtin_fmaxf(__builtin_fmaxf(S[g][0][0], S[g][0][1]), S[g][0][2]);
                mx = __builtin_fmaxf(__builtin_fmaxf(mx, S[g][0][3]), S[g][1][0]); mx = __builtin_fmaxf(__builtin_fmaxf(mx, S[g][1][1]), S[g][1][2]);
                mx = __builtin_fmaxf(__builtin_fmaxf(mx, S[g][1][3]), S[g][2][0]); mx = __builtin_fmaxf(__builtin_fmaxf(mx, S[g][2][1]), S[g][2][2]);
                mx = __builtin_fmaxf(__builtin_fmaxf(mx, S[g][2][3]), S[g][3][0]); mx = __builtin_fmaxf(__builtin_fmaxf(mx, S[g][3][1]), S[g][3][2]);
                mx = __builtin_fmaxf(mx, S[g][3][3]);
                mx = fmaxf(mx, x16f(mx)); mx = fmaxf(mx, x32f(mx));
                const float dl = fmaxf(mx, 0.f);
                const float alpha = __builtin_amdgcn_exp2f(-dl);
                mg += dl; lg *= alpha;
#pragma unroll
                for (int nt = 0; nt < 4; ++nt) st.O[g][nt] = st.O[g][nt] * alpha;
                TH_EXPPACK(dl);
            }
#undef TH_EXPPACK
            st.m[g] = mg; st.l[g] = lg + ls;
            pf[g][0] = __builtin_bit_cast(bf16x8, w0); pf[g][1] = __builtin_bit_cast(bf16x8, w1);
        } else {
            float mx = fmaxf(fmaxf(S[g][0][0], S[g][0][1]), fmaxf(S[g][0][2], S[g][0][3]));
#pragma unroll
            for (int kt = 1; kt < 4; ++kt) mx = fmaxf(mx, fmaxf(fmaxf(S[g][kt][0], S[g][kt][1]), fmaxf(S[g][kt][2], S[g][kt][3])));
            mx = fmaxf(mx, x16f(mx)); mx = fmaxf(mx, x32f(mx));
            const float mnew = fmaxf(st.m[g], mx);
            const float alpha = __builtin_amdgcn_exp2f(st.m[g] - mnew);
            st.m[g] = mnew; st.l[g] *= alpha;
            float ls = 0.f;
#pragma unroll
            for (int kt = 0; kt < 4; ++kt)
#pragma unroll
                for (int r = 0; r < 4; ++r) { const float pr = __builtin_amdgcn_exp2f(S[g][kt][r] - mnew); S[g][kt][r] = pr; ls += pr; }
            st.l[g] += ls;
        }
        if (MODE == 2) {
#pragma unroll
            for (int s2 = 0; s2 < 2; ++s2) {
                u32x4 wv; wv.x = cvtpk(S[g][2 * s2][0], S[g][2 * s2][1]); wv.y = cvtpk(S[g][2 * s2][2], S[g][2 * s2][3]); wv.z = cvtpk(S[g][2 * s2 + 1][0], S[g][2 * s2 + 1][1]); wv.w = cvtpk(S[g][2 * s2 + 1][2], S[g][2 * s2 + 1][3]);
                pf[g][s2] = __builtin_bit_cast(bf16x8, wv);
            }
        }
    }
    if (MODE != 1) {
        typedef int v2i __attribute__((ext_vector_type(2))); typedef int v4i __attribute__((ext_vector_type(4)));
        const unsigned vbase_ = (unsigned)(unsigned long)Vt;
        const unsigned va0 = vbase_ + L.vb[0], va1 = vbase_ + L.vb[1], va2 = vbase_ + L.vb[2], va3 = vbase_ + L.vb[3];
        v2i lo0, hi0, lo1, hi1;
#define TRRD(lo_, hi_, a_, o0_, o1_) asm volatile("ds_read_b64_tr_b16 %0, %2 offset:" #o0_ "\n\tds_read_b64_tr_b16 %1, %2 offset:" #o1_ : "=&v"(lo_), "=&v"(hi_) : "v"(a_) : "memory")
#define TRWAIT(n_, lo_, hi_) asm volatile("s_waitcnt lgkmcnt(" #n_ ")" : "+v"(lo_), "+v"(hi_))
#define TRPV(lo_, hi_, nt_, s2_) do { const v4i v4_ = {lo_[0], lo_[1], hi_[0], hi_[1]}; const bf16x8 vf_ = __builtin_bit_cast(bf16x8, v4_); \
            _Pragma("unroll") for (int g = 0; g < NH; ++g) st.O[g][nt_] = __builtin_amdgcn_mfma_f32_16x16x32_bf16(vf_, pf[g][s2_], st.O[g][nt_], 0, 0, 0); } while (0)
        __builtin_amdgcn_s_setprio(1);
        TRRD(lo0, hi0, va0, 0, 2048);
        TRRD(lo1, hi1, va1, 0, 2048);    TRWAIT(2, lo0, hi0); TRPV(lo0, hi0, 0, 0);
        TRRD(lo0, hi0, va2, 0, 2048);    TRWAIT(2, lo1, hi1); TRPV(lo1, hi1, 1, 0);
        TRRD(lo1, hi1, va3, 0, 2048);    TRWAIT(2, lo0, hi0); TRPV(lo0, hi0, 2, 0);
        TRRD(lo0, hi0, va0, 4096, 6144); TRWAIT(2, lo1, hi1); TRPV(lo1, hi1, 3, 0);
        TRRD(lo1, hi1, va1, 4096, 6144); TRWAIT(2, lo0, hi0); TRPV(lo0, hi0, 0, 1);
        TRRD(lo0, hi0, va2, 4096, 6144); TRWAIT(2, lo1, hi1); TRPV(lo1, hi1, 1, 1);
        TRRD(lo1, hi1, va3, 4096, 6144); TRWAIT(2, lo0, hi0); TRPV(lo0, hi0, 2, 1);
        TRWAIT(0, lo1, hi1); TRPV(lo1, hi1, 3, 1);
        __builtin_amdgcn_s_setprio(0);
#undef TRRD
#undef TRWAIT
#undef TRPV
    }
}
template <int NH, int MODE> __device__ __forceinline__ void tile_heads(const LAS unsigned char* Kt, const LAS unsigned char* Vt, const Lane& L, const LAS unsigned char* qlds, int lane,
        const float (&slope)[NH], float brel, int drel, int dlo, bool row_on, bool need_mask, State<NH>& st, const float (&mfix)[NH], const float (&ilfix)[NH], float (&impm)[4], float (&impn)[4]) {
    f32x4 S[NH][4];
    tile_qk<NH, MODE>(Kt, L, qlds, lane, slope, brel, drel, dlo, row_on, need_mask, st, S);
    tile_sv<NH, MODE>(Vt, L, S, st, mfix, ilfix, impm, impn);
}
__device__ __forceinline__ void scale_q(const u32x4 (&qw)[2], float sc, bf16x8 (&qf)[2]) {
#pragma unroll
    for (int ks = 0; ks < 2; ++ks) { const u32x4 w = qw[ks]; u32x4 o;
        o.x = cvtpk(bf_lo(w.x) * sc, bf_hi(w.x) * sc); o.y = cvtpk(bf_lo(w.y) * sc, bf_hi(w.y) * sc); o.z = cvtpk(bf_lo(w.z) * sc, bf_hi(w.z) * sc); o.w = cvtpk(bf_lo(w.w) * sc, bf_hi(w.w) * sc);
        qf[ks] = __builtin_bit_cast(bf16x8, o); }
}
__device__ __forceinline__ void load_q(const bf16_t* qrow, int grp, float sc, bf16x8 (&qf)[2]) {
#pragma unroll
    for (int ks = 0; ks < 2; ++ks) { const u32x4 w = *(const u32x4*)(qrow + 32 * ks + 8 * grp); u32x4 o;
        o.x = cvtpk(bf_lo(w.x) * sc, bf_hi(w.x) * sc); o.y = cvtpk(bf_lo(w.y) * sc, bf_hi(w.y) * sc); o.z = cvtpk(bf_lo(w.z) * sc, bf_hi(w.z) * sc); o.w = cvtpk(bf_lo(w.w) * sc, bf_hi(w.w) * sc);
        qf[ks] = __builtin_bit_cast(bf16x8, o); }
}
}

struct DilUnit { int dd, rho, jb, hd, b, T0, nT; };
__device__ __forceinline__ DilUnit dil_decode(int unit) {
    DilUnit U; const int g3 = unit >> 9, rem = unit & 511; U.b = rem >> 5; const int hh = (rem >> 4) & 1;
    if (g3 == 0) { U.dd = 1; U.rho = 0; U.jb = rem & 15; } else if (g3 == 1) { U.dd = 4; U.rho = (rem >> 2) & 3; U.jb = rem & 3; } else { U.dd = 16; U.rho = rem & 15; U.jb = 0; }
    U.hd = 2 * g3 + hh;
    const int tau0 = 128 * U.jb; U.T0 = (tau0 >= 128) ? (tau0 >> 6) - 2 : 0; U.nT = (tau0 >> 6) + 2 - U.T0;
    return U;
}
struct DilStage { u32x4 k[4], v[4], q[2]; };
__device__ __forceinline__ void dil_load(DilStage& sr, const bf16_t* PROJ, const DilUnit& U, int tid) {
    const int R = tid >> 3, ch = tid & 7; const long ld = (long)U.dd * NPROJ;
    const bf16_t* kb = PROJ + (size_t)((long)U.b * SEQ + U.rho) * NPROJ + C_DK + U.hd * 64 + ch * 8; const bf16_t* vb = PROJ + (size_t)((long)U.b * SEQ + U.rho) * NPROJ + C_DV + U.hd * 64 + ch * 8;
#pragma unroll
    for (int i = 0; i < 4; ++i) if (i < U.nT) { const size_t off = (size_t)(64 * (U.T0 + i) + R) * ld; sr.k[i] = *(const u32x4*)(kb + off); sr.v[i] = *(const u32x4*)(vb + off); }
    {
        const int lane = tid & 63, w = tid >> 6; const long qrow = (long)U.b * SEQ + U.rho + (long)U.dd * (128 * U.jb + 16 * w + (lane & 15));
        const bf16_t* qp = PROJ + (size_t)qrow * NPROJ + C_DQ + U.hd * 64 + 8 * (lane >> 4);
        sr.q[0] = *(const u32x4*)(qp); sr.q[1] = *(const u32x4*)(qp + 32); }
}
__device__ __forceinline__ void dil_store(const DilStage& sr, LAS unsigned char* buf, const DilUnit& U, int tid) {
    const int R = tid >> 3, ch = tid & 7;
#pragma unroll
    for (int i = 0; i < 4; ++i) if (i < U.nT) { *(LAS u32x4*)(buf + i * 2 * att::TILE_BYTES + att::k_off(R, ch)) = sr.k[i]; *(LAS u32x4*)(buf + (i * 2 + 1) * att::TILE_BYTES + att::v_off(R, ch * 16)) = sr.v[i]; }
}
__device__ __forceinline__ void dil_compute(const Frame& F, const DilUnit& U, const LAS unsigned char* buf, const u32x4 (&qw)[2]) {
    const int lane = F.lane, w = F.wave;
    const bf16_t* PROJ = (const bf16_t*)(F.ws + WS_PROJ); bf16_t* MIX = (bf16_t*)(F.ws + WS_MIX); float* LSE = (float*)(F.ws + WS_LSE);
    const att::Lane L = att::make_lane(lane);
    const int tauw = 128 * U.jb + 16 * w, tau = tauw + L.c;
    const long row = (long)U.b * SEQ + U.rho + (long)U.dd * tau;
    att::bf16x8 qf[1][2];
    att::scale_q(qw, 0.125f * att::LOG2E, qf[0]);
    const float slope[1] = {dil_slope(U.hd) * (float)U.dd * att::LOG2E};
    att::State<1> st; att::state_reset(st);
#pragma unroll 1
    for (int i = 0; i < U.nT; ++i) {
        const int T = U.T0 + i;
        const LAS unsigned char* Kt = buf + i * 2 * att::TILE_BYTES; const LAS unsigned char* Vt = Kt + att::TILE_BYTES;
        const bool skip = (64 * T > tauw + 15) || (64 * T + 63 < tauw - 128);
        if (!skip) {
            const bool need_mask = !(64 * T + 63 <= tauw && 64 * T >= tauw + 15 - 128);
            const int drel = 64 * T + 4 * L.grp - tau;
            f32x4 S[1][4];
            att::scores<1>(Kt, L, qf, slope, (float)drel, S);
            if (need_mask) att::mask<1>(S, drel, -128, true);
            att::online<1>(S, st);
            att::pv<1>(Vt, L, S, st);
        }
    }
    float lt = st.l[0]; lt += x16f(lt); lt += x32f(lt);
    const float il = rcpf_(lt);
    bf16_t* orow = MIX + (size_t)row * DM + 384 + U.hd * 64 + 4 * L.grp;
#pragma unroll
    for (int nt = 0; nt < 4; ++nt) { const f32x4 o = st.O[0][nt] * il; u32x2 wv; wv.x = att::cvtpk(o[0], o[1]); wv.y = att::cvtpk(o[2], o[3]); *(u32x2*)(orow + 16 * nt) = wv; }
    if (L.grp == 0) LSE[(size_t)row * 8 + U.hd] = (st.m[0] + __log2f(lt)) * att::LN2;
}
__device__ __forceinline__ void dil_units(const Frame& F, int first, int stride) {
    const bf16_t* PROJ = (const bf16_t*)(F.ws + WS_PROJ);
    if (first >= 1536) return;
    DilStage sr;
    DilUnit U = dil_decode(first);
    dil_load(sr, PROJ, U, F.tid); dil_store(sr, F.lds, U, F.tid);
    u32x4 qc[2] = {sr.q[0], sr.q[1]};
    int cur = 0;
#pragma unroll 1
    for (int u = first; u < 1536; u += stride) {
        const bool has_next = u + stride < 1536;
        DilUnit Un = U;
        if (has_next) { Un = dil_decode(u + stride); dil_load(sr, PROJ, Un, F.tid); }
        __syncthreads();
        dil_compute(F, U, F.lds + cur * 65536, qc);
        if (has_next) { dil_store(sr, F.lds + (cur ^ 1) * 65536, Un, F.tid); qc[0] = sr.q[0]; qc[1] = sr.q[1]; }
        cur ^= 1; U = Un;
    }
    __syncthreads();
}
__device__ __forceinline__ void dil_fixup(const Frame& F) {
    bf16_t* MIX = (bf16_t*)(F.ws + WS_MIX); const float* LSE = (const float*)(F.ws + WS_LSE);
    for (int idx = F.bid * 512 + F.tid; idx < MTOK * 48; idx += F.G * 512) {
        const int ch = idx & 7, hd = (idx >> 3) % 6, row = idx / 48, hh = hd & 1, g3 = hd >> 1;
        const float l0 = LSE[(size_t)row * 8 + hh], l1 = LSE[(size_t)row * 8 + 2 + hh], l2 = LSE[(size_t)row * 8 + 4 + hh];
        const float mx = fmaxf(l0, fmaxf(l1, l2));
        const float e0 = __expf(l0 - mx), e1 = __expf(l1 - mx), e2 = __expf(l2 - mx);
        const float al = ((g3 == 0) ? e0 : ((g3 == 1) ? e1 : e2)) * rcpf_((e0 + e1) + e2);
        u32x4* p = (u32x4*)(MIX + (size_t)row * DM + 384 + hd * 64 + ch * 8);
        const u32x4 w = *p; u32x4 o;
        o.x = pk2(bf_lo(w.x) * al, bf_hi(w.x) * al); o.y = pk2(bf_lo(w.y) * al, bf_hi(w.y) * al); o.z = pk2(bf_lo(w.z) * al, bf_hi(w.z) * al); o.w = pk2(bf_lo(w.w) * al, bf_hi(w.w) * al);
        *p = o;
    }
}

struct NsaCtx { int tid, lane, w, t, tw; long row; att::Lane L; float slope[3]; };
__device__ __forceinline__ NsaCtx nsa_ctx(const Frame& F, int b, int kvh, int jb) {
    NsaCtx C; int tid = F.tid, lane = F.lane, w = F.wave;
    asm volatile("" : "+v"(tid), "+v"(lane)); asm volatile("" : "+s"(w));
    C.tid = tid; C.lane = lane; C.w = w; C.L = att::make_lane(lane);
    C.tw = 128 * jb + 16 * w; C.t = C.tw + C.L.c; C.row = (long)b * SEQ + C.t;
#pragma unroll
    for (int g = 0; g < 3; ++g) C.slope[g] = nsa_slope(kvh * 3 + g) * att::LOG2E;
    return C;
}
#define NSA_FIN_ADD(first_, g_, nt_, v_) do { const f32x4 v__ = (v_); u32x2* p__ = (u32x2*)(MIXo + (size_t)C.row * DM + (kvh * 3 + (g_)) * 64 + 4 * L.grp + 16 * (nt_)); u32x2 f__ = (u32x2){0u, 0u}; if (!(first_)) f__ = *p__; u32x2 o__; \
        o__.x = att::cvtpk(bf_lo(f__.x) + v__[0], bf_hi(f__.x) + v__[1]); o__.y = att::cvtpk(bf_lo(f__.y) + v__[2], bf_hi(f__.y) + v__[3]); *p__ = o__; } while (0)
__device__ __forceinline__ float nsa_gate(const bf16_t* PROJ, long row, int kvh, int g, int br) { return sigmoidf_(bf_lo((unsigned)PROJ[(size_t)row * NPROJ + C_GATE + (kvh * 3 + g) * 3 + br])); }

__device__ __forceinline__ unsigned nsa_cmp_topk(const Frame& F, int b, int kvh, int jb) {
    bf16_t* MIXo = (bf16_t*)(F.ws + WS_MIX);
    const NsaCtx C = nsa_ctx(F, b, kvh, jb);
    const att::Lane& L = C.L; const int lane = C.lane, tid = C.tid, w = C.w, t = C.t, tw = C.tw;
    const bf16_t* PROJ = (const bf16_t*)(F.ws + WS_PROJ);
    const bf16_t* KCMP = (const bf16_t*)(F.ws + WS_KCMP) + (size_t)(b * 2 + kvh) * 128 * 64; const bf16_t* VCMP = (const bf16_t*)(F.ws + WS_VCMP) + (size_t)(b * 2 + kvh) * 128 * 64;
    LAS unsigned char* cbuf = F.lds;
    LAS float* impM = (LAS float*)(F.lds + 32768) + w * 1056;
    LAS float* impN = impM + 528;
    LAS unsigned* uni = (LAS unsigned*)(F.lds + 32768 + 8 * 4224);
    LAS unsigned char* qlds = F.lds + 32768 + 8 * 4224 + 256 + w * 6144;
    float slopec[3];
#pragma unroll
    for (int g = 0; g < 3; ++g) {
        slopec[g] = 16.0f * C.slope[g];
        att::bf16x8 qf[2]; att::load_q(PROJ + (size_t)C.row * NPROJ + C_NQ + (kvh * 3 + g) * 64, L.grp, 0.125f * att::LOG2E, qf);
        *(LAS att::bf16x8*)(qlds + ((g * 2 + 0) * 64 + lane) * 16) = qf[0]; *(LAS att::bf16x8*)(qlds + ((g * 2 + 1) * 64 + lane) * 16) = qf[1];
    }
    {
        att::StageRegs s0, s1;
        att::stage_load(s0, KCMP, VCMP, 64, tid); att::stage_load(s1, KCMP + 4096, VCMP + 4096, 64, tid);
        att::stage_store(s0, cbuf, cbuf + att::TILE_BYTES, tid); att::stage_store(s1, cbuf + 2 * att::TILE_BYTES, cbuf + 3 * att::TILE_BYTES, tid);
        for (int i2 = lane; i2 < 1056; i2 += 64) impM[i2] = 0.f;
    }
    __syncthreads();
    const int nmax = (t >= 31) ? ((t - 31) >> 4) : -1, nmaxw = (tw >= 31) ? ((tw - 31) >> 4) : -1, nmaxw_hi = (tw + 15 >= 31) ? ((tw + 15 - 31) >> 4) : -1;
    const float tcf = ((float)t - 15.5f) * (1.0f / 16.0f);
    att::State<3> st; att::state_reset(st);
    {
        f32x4 S[2][3][4];
#pragma unroll
        for (int T = 0; T < 2; ++T) {
            const LAS unsigned char* Kt = cbuf + T * 2 * att::TILE_BYTES;
            const float brel = (float)(64 * T + 4 * L.grp) - tcf; const int drel = 64 * T + 4 * L.grp - nmax;
            f32x4 dm[4];
#pragma unroll
            for (int kt = 0; kt < 4; ++kt)
#pragma unroll
                for (int r = 0; r < 4; ++r) dm[kt][r] = (drel + 16 * kt + r <= 0) ? brel + (float)(16 * kt + r) : -att::BIGD;
            att::bf16x8 kf[4][2];
#pragma unroll
            for (int kt = 0; kt < 4; ++kt) { kf[kt][0] = *(const LAS att::bf16x8*)(Kt + L.kb0 + kt * 2048); kf[kt][1] = *(const LAS att::bf16x8*)(Kt + L.kb1 + kt * 2048); }
#pragma unroll
            for (int g = 0; g < 3; ++g) {
                const att::bf16x8 q0 = *(const LAS att::bf16x8*)(qlds + ((g * 2 + 0) * 64 + lane) * 16), q1 = *(const LAS att::bf16x8*)(qlds + ((g * 2 + 1) * 64 + lane) * 16);
#pragma unroll
                for (int kt = 0; kt < 4; ++kt) {
                    S[T][g][kt] = dm[kt] * slopec[g];
                    S[T][g][kt] = __builtin_amdgcn_mfma_f32_16x16x32_bf16(kf[kt][0], q0, S[T][g][kt], 0, 0, 0);
                    S[T][g][kt] = __builtin_amdgcn_mfma_f32_16x16x32_bf16(kf[kt][1], q1, S[T][g][kt], 0, 0, 0);
                }
            }
        }
        att::bf16x8 pf[3][2][2];
        float impm[2][4], impn[2][4];
#pragma unroll
        for (int T = 0; T < 2; ++T)
#pragma unroll
            for (int kt = 0; kt < 4; ++kt) { impm[T][kt] = 0.f; impn[T][kt] = 0.f; }
#pragma unroll
        for (int g = 0; g < 3; ++g) {
            float mx = att::MFLOOR;
#pragma unroll
            for (int T = 0; T < 2; ++T)
#pragma unroll
                for (int kt = 0; kt < 4; ++kt) mx = fmaxf(mx, fmaxf(fmaxf(S[T][g][kt][0], S[T][g][kt][1]), fmaxf(S[T][g][kt][2], S[T][g][kt][3])));
            mx = fmaxf(mx, x16f(mx)); mx = fmaxf(mx, x32f(mx));
            float ls = 0.f;
#pragma unroll
            for (int T = 0; T < 2; ++T)
#pragma unroll
                for (int kt = 0; kt < 4; ++kt)
#pragma unroll
                    for (int r = 0; r < 4; ++r) { const float e = __builtin_amdgcn_exp2f(S[T][g][kt][r] - mx); S[T][g][kt][r] = e; ls += e; }
            ls += x16f(ls); ls += x32f(ls);
            const float il = (ls > 0.f) ? rcpf_(ls) : 0.f;
#pragma unroll
            for (int T = 0; T < 2; ++T) {
#pragma unroll
                for (int kt = 0; kt < 4; ++kt) { S[T][g][kt] = S[T][g][kt] * il; impm[T][kt] += (S[T][g][kt][0] + S[T][g][kt][1]) + (S[T][g][kt][2] + S[T][g][kt][3]); impn[T][kt] += S[T][g][kt][3]; }
#pragma unroll
                for (int s2 = 0; s2 < 2; ++s2) { u32x4 wv; wv.x = att::cvtpk(S[T][g][2 * s2][0], S[T][g][2 * s2][1]); wv.y = att::cvtpk(S[T][g][2 * s2][2], S[T][g][2 * s2][3]);
                    wv.z = att::cvtpk(S[T][g][2 * s2 + 1][0], S[T][g][2 * s2 + 1][1]); wv.w = att::cvtpk(S[T][g][2 * s2 + 1][2], S[T][g][2 * s2 + 1][3]); pf[g][T][s2] = __builtin_bit_cast(att::bf16x8, wv); }
            }
        }
#pragma unroll
        for (int T = 0; T < 2; ++T)
#pragma unroll
            for (int kt = 0; kt < 4; ++kt) { const int mb = 16 * T + 4 * kt + L.grp; impM[L.c * 33 + mb] = impm[T][kt]; impN[L.c * 33 + mb + 1] = impn[T][kt]; }
#pragma unroll
        for (int T = 0; T < 2; ++T) {
            const LAS unsigned char* Vt = cbuf + T * 2 * att::TILE_BYTES + att::TILE_BYTES;
#pragma unroll
            for (int s2 = 0; s2 < 2; ++s2)
#pragma unroll
                for (int nt = 0; nt < 4; ++nt) {
                    const att::v4i16 lo = __builtin_amdgcn_ds_read_tr16_b64_v4i16((LAS att::v4i16*)(Vt + L.vb[nt] + 4096 * s2));
                    const att::v4i16 hi = __builtin_amdgcn_ds_read_tr16_b64_v4i16((LAS att::v4i16*)(Vt + L.vb[nt] + 4096 * s2 + 2048));
                    const att::bf16x8 vf = {lo[0], lo[1], lo[2], lo[3], hi[0], hi[1], hi[2], hi[3]};
#pragma unroll
                    for (int g = 0; g < 3; ++g) st.O[g][nt] = __builtin_amdgcn_mfma_f32_16x16x32_bf16(vf, pf[g][T][s2], st.O[g][nt], 0, 0, 0);
                }
        }
    }
#pragma unroll
    for (int g = 0; g < 3; ++g) { const float gt = nsa_gate(PROJ, C.row, kvh, g, 0);
#pragma unroll
        for (int nt = 0; nt < 4; ++nt) NSA_FIN_ADD(true, g, nt, st.O[g][nt] * gt); }
    asm volatile("s_waitcnt vmcnt(0)" ::: "memory");
    asm volatile("s_waitcnt lgkmcnt(0)" ::: "memory");
    const int cur = t >> 6, hi = cur - 2;
    unsigned mk = 0u;
    {
        float wv[32]; wv[0] = -1.0f;
#pragma unroll
        for (int m2 = 1; m2 < 32; ++m2) { const float w2 = impM[L.c * 33 + m2] + impN[L.c * 33 + m2]; wv[m2] = (m2 <= hi) ? w2 : -1.0f; }
#pragma unroll
        for (int jj = 0; jj < 8; ++jj) {
            const float v = (L.grp == 0) ? wv[4 * jj] : ((L.grp == 1) ? wv[4 * jj + 1] : ((L.grp == 2) ? wv[4 * jj + 2] : wv[4 * jj + 3]));
            int rank = 0;
#pragma unroll
            for (int m2 = 1; m2 < 32; ++m2) {
                const int d = m2 - 4 * jj; bool cnd;
                if (d < 0) cnd = wv[m2] >= v; else if (d >= 3) cnd = wv[m2] > v; else cnd = (wv[m2] > v) || (wv[m2] == v && L.grp > d);
                rank += cnd ? 1 : 0;
            }
            const int mm = L.grp + 4 * jj;
            if (mm >= 1 && mm <= hi && rank < 5) mk |= 1u << mm;
        }
    }
    mk |= x16u(mk); mk |= x32u(mk);
    mk |= 1u | (1u << cur); if (cur >= 1) mk |= 1u << (cur - 1);
    unsigned um = row_or16(mk);
    if (lane == 0) uni[w] = um;
    __syncthreads();
    return mk;
}
template <int BR, bool DISCARD = false> __device__ __forceinline__ void nsa_branch(const Frame& F, int b, int kvh, int jb, unsigned selmask) {
    bf16_t* MIXo = (bf16_t*)(F.ws + WS_MIX);
    const NsaCtx C = nsa_ctx(F, b, kvh, jb);
    const att::Lane& L = C.L; const int lane = C.lane, w = C.w, t = C.t, tw = C.tw;
    const bf16_t* PROJ = (const bf16_t*)(F.ws + WS_PROJ);
    const LAS unsigned* uni = (const LAS unsigned*)(F.lds + 32768 + 8 * 4224);
    const LAS unsigned char* qlds = F.lds + 32768 + 8 * 4224 + 256 + w * 6144;
    const int R = 8 * w + (lane >> 3), pch = lane & 7;
    const bf16_t* ksrc = PROJ + (size_t)((long)b * SEQ + R) * NPROJ + (BR == 1 ? C_KS : C_KW) + kvh * 64 + 8 * (pch ^ ((R >> 1) & 7));
    const bf16_t* vsrc = PROJ + (size_t)((long)b * SEQ + R) * NPROJ + (BR == 1 ? C_VS : C_VW) + kvh * 64 + 8 * (pch ^ (((R >> 1) & 3) << 1));
#define NSA_DMA(T_, slot_) do { const size_t to_ = (size_t)(64 * (T_)) * NPROJ; LAS unsigned* d_ = (LAS unsigned*)(F.lds + (slot_) * 16384 + w * 1024); \
        __builtin_amdgcn_global_load_lds((const unsigned*)(ksrc + to_), d_, 16, 0, 0); __builtin_amdgcn_global_load_lds((const unsigned*)(vsrc + to_), (LAS unsigned*)((LAS unsigned char*)d_ + 8192), 16, 0, 0); } while (0)
    float dummy3[3] = {0.f, 0.f, 0.f}, dummy4[4] = {0.f, 0.f, 0.f, 0.f};
    float m0 = 0.f; asm volatile("" : "+v"(m0));
    att::State<3> st; att::state_reset(st, m0);
    unsigned rem = 0u; int Tlast = 0, T0, T1, T2;
    if (BR == 1) { unsigned um = 0u;
#pragma unroll
        for (int i2 = 0; i2 < 8; ++i2) um |= uni[i2];
        rem = __builtin_amdgcn_readfirstlane(um); }
#define NSA_NEXT(dst_, prev_) do { if (BR == 1) { if (rem != 0u) { dst_ = __builtin_ctz(rem); rem &= rem - 1; } else dst_ = -1; } else { dst_ = ((prev_) >= 0 && (prev_) < Tlast) ? (prev_) + 1 : -1; } } while (0)
    if (BR == 1) { T0 = __builtin_ctz(rem); rem &= rem - 1; } else { T0 = (2 * jb >= 8) ? 2 * jb - 8 : 0; Tlast = 2 * jb + 1; }
    NSA_NEXT(T1, T0); NSA_NEXT(T2, T1);
    asm volatile("s_waitcnt lgkmcnt(0)" ::: "memory"); __builtin_amdgcn_s_barrier();
    NSA_DMA(T0, 0);
    if (T1 >= 0) { NSA_DMA(T1, 1); asm volatile("s_waitcnt vmcnt(2)" ::: "memory"); } else { asm volatile("s_waitcnt vmcnt(0)" ::: "memory"); }
    __builtin_amdgcn_s_barrier();
    const bool late = ((unsigned)__builtin_amdgcn_s_getreg((5 << 11) | 4) & 1u) != 0u;
    f32x4 S[3][4]; bool haveS = false; const LAS unsigned char* Vprev = F.lds;
    int slot = 0;
#pragma unroll 1
    for (;;) {
        if (T2 >= 0) { NSA_DMA(T2, (slot + 2) & 3); }
        const LAS unsigned char* Kt = F.lds + slot * 16384; const LAS unsigned char* Vt = Kt + att::TILE_BYTES;
        const int T = T0, drel = 64 * T + 4 * L.grp - t;
        if (late && haveS) att::tile_sv<3, 0>(Vprev, L, S, st, dummy3, dummy3, dummy4, dummy4);
        bool act;
        if (BR == 1) {
            const bool row_on = (selmask >> T) & 1u; act = __any(row_on);
            if (act) att::tile_qk<3, 0>(Kt, L, qlds, lane, C.slope, (float)drel, drel, -1000000, row_on, !(__all(row_on) && 64 * T + 63 <= tw), st, S);
        } else {
            act = !((64 * T > tw + 15) || (64 * T + 63 < tw - 511));
            if (act) att::tile_qk<3, 0>(Kt, L, qlds, lane, C.slope, (float)drel, drel, -511, true, !(64 * T + 63 <= tw && 64 * T >= tw + 15 - 511), st, S);
        }
        if (!late) { if (act) att::tile_sv<3, 0>(Vt, L, S, st, dummy3, dummy3, dummy4, dummy4); }
        else { haveS = act; Vprev = Vt; }
        if (T2 >= 0) { asm volatile("s_waitcnt vmcnt(2) lgkmcnt(0)" ::: "memory"); } else { asm volatile("s_waitcnt vmcnt(0) lgkmcnt(0)" ::: "memory"); }
        __builtin_amdgcn_s_barrier();
        if (T1 < 0) break;
        T0 = T1; T1 = T2; NSA_NEXT(T2, T1); slot = (slot + 1) & 3;
    }
    if (late && haveS) att::tile_sv<3, 0>(Vprev, L, S, st, dummy3, dummy3, dummy4, dummy4);
#undef NSA_DMA
#undef NSA_NEXT
#pragma unroll
    for (int g = 0; g < 3; ++g) { float lt = st.l[g]; lt += x16f(lt); lt += x32f(lt); const float sc = (lt > 0.f) ? nsa_gate(PROJ, C.row, kvh, g, BR) * rcpf_(lt) : 0.f;
#pragma unroll
        for (int nt = 0; nt < 4; ++nt) { if (DISCARD) { asm volatile("" :: "v"(st.O[g][nt][0] * sc), "v"(st.O[g][nt][1]), "v"(st.O[g][nt][2]), "v"(st.O[g][nt][3])); } else NSA_FIN_ADD(false, g, nt, st.O[g][nt] * sc); } }
    asm volatile("s_waitcnt vmcnt(0)" ::: "memory");
}
__device__ __forceinline__ void nsa_unit2(const Frame& F, int b, int kvh, int jb) {
    unsigned selmask = nsa_cmp_topk(F, b, kvh, jb);
#if REP_CMP > 1
    selmask = nsa_cmp_topk(F, b, kvh, jb);
#endif
#if REP_SEL > 1
    nsa_branch<1, true>(F, b, kvh, jb, selmask);
#endif
#if REP_WIN > 1
    nsa_branch<2, true>(F, b, kvh, jb, selmask);
#endif
    nsa_branch<1>(F, b, kvh, jb, selmask);
    nsa_branch<2>(F, b, kvh, jb, selmask);
}
#undef NSA_FIN_ADD

__device__ __forceinline__ void hgrn_local(const Frame& F, const Args& a, int l, int u) {
    typedef short bf16x8 __attribute__((ext_vector_type(8)));
    typedef short v4i16 __attribute__((ext_vector_type(4)));
    const int c = u & 31, bh = u >> 5, b = bh >> 2, h = bh & 3, lane = F.lane, l15 = lane & 15, grp = lane >> 4;
    const bf16_t* PROJ = (const bf16_t*)(F.ws + WS_PROJ);
    bf16_t* OLOC = (bf16_t*)(F.ws + WS_OLOC); bf16_t* QE = (bf16_t*)(F.ws + WS_QE); bf16_t* HU = (bf16_t*)(F.ws + WS_HU); float* HD = (float*)(F.ws + WS_HD);
    LAS unsigned char* QS = F.lds + F.wave * 16384;
    LAS unsigned char* KS = QS + 2048;
    LAS unsigned char* VV = QS + 4096;
    LAS float* GF = (LAS float*)(QS + 6144);
    float lb = 0.f;
    if (l == 1) lb = sigmoidf_(a.hg_lb[256 + h * 64 + lane] - a.hg_lb[h * 64 + lane]);
    const float omlb = 1.0f - lb;
    f32x4 Sacc[4][4];
#pragma unroll
    for (int dt = 0; dt < 4; ++dt)
#pragma unroll
        for (int et = 0; et < 4; ++et) Sacc[dt][et] = (f32x4){0.f, 0.f, 0.f, 0.f};
    float e0 = 1.0f;
    const long row0 = (long)b * SEQ + c * 64;
    const int qs_w = (lane >> 3), qs_wb = (lane & 7) * 2;
    const int tr_row = 4 * grp + (l15 >> 2), tr_col = 8 * (l15 & 3);
    LAS unsigned char* RQ = QS + 6400;
    LAS unsigned char* RF = QS + 8448;
    LAS unsigned char* OST = QS + 6400;
    LAS unsigned char* QEST = QS + 10752;
    const int wrow = lane >> 3, wch = lane & 7;
    const bf16_t* gin = PROJ + (size_t)(row0 + wrow) * NPROJ + h * 64 + wch * 8;
    u32x4 rq[2], rf[2], rv[2];
#pragma unroll
    for (int i = 0; i < 2; ++i) { const bf16_t* r = gin + (size_t)(8 * i) * NPROJ; rq[i] = *(const u32x4*)(r + C_HQ); rf[i] = *(const u32x4*)(r + C_HF); rv[i] = *(const u32x4*)(r + C_HI); }
#pragma unroll 1
    for (int I = 0; I < 4; ++I) {
        asm volatile("s_waitcnt lgkmcnt(0)" ::: "memory");
#pragma unroll
        for (int i = 0; i < 2; ++i) { *(LAS u32x4*)(RQ + (wrow + 8 * i) * 128 + wch * 16) = rq[i]; *(LAS u32x4*)(RF + (wrow + 8 * i) * 128 + wch * 16) = rf[i]; *(LAS u32x4*)(VV + att::v_off(wrow + 8 * i, wch * 16)) = rv[i]; }
        {
            const int In = (I < 3) ? I + 1 : I;
#pragma unroll
            for (int i = 0; i < 2; ++i) { const bf16_t* r = gin + (size_t)(16 * In + 8 * i) * NPROJ; rq[i] = *(const u32x4*)(r + C_HQ); rf[i] = *(const u32x4*)(r + C_HF); rv[i] = *(const u32x4*)(r + C_HI); }
        }
        asm volatile("s_waitcnt lgkmcnt(0)" ::: "memory");
        float ex = 1.0f;
#pragma unroll
        for (int t = 0; t < 16; ++t) {
            const float qv = bf_lo((unsigned)*(const LAS bf16_t*)(RQ + t * 128 + lane * 2)), fv = bf_lo((unsigned)*(const LAS bf16_t*)(RF + t * 128 + lane * 2));
            const float sg = sigmoidf_(fv);
            const float f = lb + omlb * sg, kk = omlb * (1.0f - sg);
            ex = fmaxf(ex * f, 1e-35f);
            const float qs = qv * ex;
            *(LAS bf16_t*)(QS + att::k_off(t, qs_w) + qs_wb) = (bf16_t)f2bf(qs);
            *(LAS bf16_t*)(KS + att::v_off(t, lane * 2)) = (bf16_t)f2bf(kk * rcpf_(ex));
            *(LAS bf16_t*)(QEST + t * 128 + lane * 2) = (bf16_t)f2bf(qs * e0);
        }
        GF[lane] = ex; e0 *= ex;
        asm volatile("s_waitcnt lgkmcnt(0)" ::: "memory");
#pragma unroll
        for (int i = 0; i < 2; ++i) *(u32x4*)(QE + (size_t)(row0 + I * 16 + wrow + 8 * i) * 256 + h * 64 + wch * 8) = *(const LAS u32x4*)(QEST + (wrow + 8 * i) * 128 + wch * 16);
        f32x4 Oacc[4];
#pragma unroll
        for (int et = 0; et < 4; ++et) Oacc[et] = (f32x4){0.f, 0.f, 0.f, 0.f};
#pragma unroll
        for (int ks = 0; ks < 2; ++ks) {
            const u32x2 lo = *(const LAS u32x2*)(QS + att::k_off(l15, 4 * ks + (grp >> 1)) + 8 * (grp & 1));
            const u32x2 hi = *(const LAS u32x2*)(QS + att::k_off(l15, 4 * ks + 2 + (grp >> 1)) + 8 * (grp & 1));
            u32x4 aw; aw.x = lo.x; aw.y = lo.y; aw.z = hi.x; aw.w = hi.y;
            const bf16x8 af = __builtin_bit_cast(bf16x8, aw);
#pragma unroll
            for (int et = 0; et < 4; ++et) {
                u32x4 bw; bw.x = att::cvtpk(Sacc[2 * ks][et][0], Sacc[2 * ks][et][1]); bw.y = att::cvtpk(Sacc[2 * ks][et][2], Sacc[2 * ks][et][3]);
                bw.z = att::cvtpk(Sacc[2 * ks + 1][et][0], Sacc[2 * ks + 1][et][1]); bw.w = att::cvtpk(Sacc[2 * ks + 1][et][2], Sacc[2 * ks + 1][et][3]);
                Oacc[et] = __builtin_amdgcn_mfma_f32_16x16x32_bf16(af, __builtin_bit_cast(bf16x8, bw), Oacc[et], 0, 0, 0);
            }
        }
        f32x4 AT = (f32x4){0.f, 0.f, 0.f, 0.f};
#pragma unroll
        for (int ks = 0; ks < 2; ++ks) {
            const bf16x8 ka = *(const LAS bf16x8*)(KS + att::v_off(l15, (4 * ks + grp) * 16));
            const bf16x8 qb = *(const LAS bf16x8*)(QS + att::k_off(l15, 4 * ks + grp));
            AT = __builtin_amdgcn_mfma_f32_16x16x32_bf16(ka, qb, AT, 0, 0, 0);
        }
#pragma unroll
        for (int r = 0; r < 4; ++r) AT[r] = (4 * grp + r <= l15) ? AT[r] : 0.f;
        u32x4 atw; atw.x = att::cvtpk(AT[0], AT[1]); atw.y = att::cvtpk(AT[2], AT[3]); atw.z = 0u; atw.w = 0u;
        const bf16x8 atf = __builtin_bit_cast(bf16x8, atw);
        bf16x8 vf[4];
#pragma unroll
        for (int et = 0; et < 4; ++et) { const v4i16 tv = __builtin_amdgcn_ds_read_tr16_b64_v4i16((LAS v4i16*)(VV + att::v_off(tr_row, 32 * et + tr_col)));
            vf[et] = (bf16x8){tv[0], tv[1], tv[2], tv[3], 0, 0, 0, 0}; }
#pragma unroll
        for (int et = 0; et < 4; ++et) Oacc[et] = __builtin_amdgcn_mfma_f32_16x16x32_bf16(atf, vf[et], Oacc[et], 0, 0, 0);
#pragma unroll
        for (int et = 0; et < 4; ++et)
#pragma unroll
            for (int r = 0; r < 4; ++r) *(LAS float*)(OST + (4 * grp + r) * 272 + (16 * et + l15) * 4) = Oacc[et][r];
        asm volatile("s_waitcnt lgkmcnt(0)" ::: "memory");
#pragma unroll
        for (int i = 0; i < 4; ++i) { const f32x4 ov = *(const LAS f32x4*)(OST + (grp + 4 * i) * 272 + l15 * 16); u32x2 ow; ow.x = att::cvtpk(ov[0], ov[1]); ow.y = att::cvtpk(ov[2], ov[3]);
            *(u32x2*)(OLOC + (size_t)(row0 + I * 16 + grp + 4 * i) * 256 + h * 64 + 4 * l15) = ow; }
#pragma unroll
        for (int dt = 0; dt < 4; ++dt) {
            const v4i16 tk = __builtin_amdgcn_ds_read_tr16_b64_v4i16((LAS v4i16*)(KS + att::v_off(tr_row, 32 * dt + tr_col)));
            const bf16x8 kf = (bf16x8){tk[0], tk[1], tk[2], tk[3], 0, 0, 0, 0};
            const f32x4 g4 = *(const LAS f32x4*)(GF + 16 * dt + 4 * grp);
#pragma unroll
            for (int et = 0; et < 4; ++et) { Sacc[dt][et] = __builtin_amdgcn_mfma_f32_16x16x32_bf16(kf, vf[et], Sacc[dt][et], 0, 0, 0); Sacc[dt][et] = Sacc[dt][et] * g4; }
        }
    }
#pragma unroll
    for (int dt = 0; dt < 4; ++dt)
#pragma unroll
        for (int et = 0; et < 4; ++et) { u32x2 w2; w2.x = att::cvtpk(Sacc[dt][et][0], Sacc[dt][et][1]); w2.y = att::cvtpk(Sacc[dt][et][2], Sacc[dt][et][3]); *(u32x2*)(HU + (size_t)u * 4096 + (16 * et + l15) * 64 + 16 * dt + 4 * grp) = w2; }
    HD[(size_t)u * 64 + lane] = e0;
    asm volatile("s_waitcnt lgkmcnt(0)" ::: "memory");
}
__device__ __forceinline__ void hgrn_scan(const Frame& F) {
    const bf16_t* HU = (const bf16_t*)(F.ws + WS_HU); const float* HD = (const float*)(F.ws + WS_HD); bf16_t* HUS = (bf16_t*)(F.ws + WS_HUS);
    for (int idx = F.bid * 512 + F.tid; idx < 64 * 4096; idx += F.G * 512) {
        const int bh = idx >> 12, ed = idx & 4095, d = ed & 63;
        float S = 0.f;
        float uv[32], dv[32];
#pragma unroll
        for (int c = 0; c < 32; ++c) { uv[c] = bf_lo((unsigned)HU[(size_t)(bh * 32 + c) * 4096 + ed]); dv[c] = HD[(size_t)(bh * 32 + c) * 64 + d]; }
#pragma unroll
        for (int c = 0; c < 32; ++c) { HUS[(size_t)(bh * 32 + c) * 4096 + ed] = (bf16_t)f2bf(S); S = dv[c] * S + uv[c]; }
    }
}
__device__ __forceinline__ void hgrn_final(const Frame& F, int u) {
    typedef short bf16x8 __attribute__((ext_vector_type(8)));
    const int c = u & 31, bh = u >> 5, b = bh >> 2, h = bh & 3, lane = F.lane, l15 = lane & 15, grp = lane >> 4;
    const bf16_t* PROJ = (const bf16_t*)(F.ws + WS_PROJ); bf16_t* MIX = (bf16_t*)(F.ws + WS_MIX);
    const bf16_t* OLOC = (const bf16_t*)(F.ws + WS_OLOC); const bf16_t* QE = (const bf16_t*)(F.ws + WS_QE); const bf16_t* HUS = (const bf16_t*)(F.ws + WS_HUS);
    const long row0 = (long)b * SEQ + c * 64;
    bf16x8 af[4][2];
#pragma unroll
    for (int et = 0; et < 4; ++et)
#pragma unroll
        for (int ks = 0; ks < 2; ++ks) af[et][ks] = *(const bf16x8*)(HUS + (size_t)u * 4096 + (16 * et + l15) * 64 + 32 * ks + 8 * grp);
#pragma unroll 1
    for (int tt = 0; tt < 4; ++tt) {
        const long row = row0 + 16 * tt + l15;
        const bf16x8 b0 = *(const bf16x8*)(QE + (size_t)row * 256 + h * 64 + 8 * grp), b1 = *(const bf16x8*)(QE + (size_t)row * 256 + h * 64 + 32 + 8 * grp);
        f32x4 acc[4]; float sq = 0.f;
#pragma unroll
        for (int et = 0; et < 4; ++et) {
            { const u32x2 ow = *(const u32x2*)(OLOC + (size_t)row * 256 + h * 64 + 16 * et + 4 * grp); acc[et] = (f32x4){bf_lo(ow.x), bf_hi(ow.x), bf_lo(ow.y), bf_hi(ow.y)}; }
            acc[et] = __builtin_amdgcn_mfma_f32_16x16x32_bf16(af[et][0], b0, acc[et], 0, 0, 0);
            acc[et] = __builtin_amdgcn_mfma_f32_16x16x32_bf16(af[et][1], b1, acc[et], 0, 0, 0);
        }
#pragma unroll
        for (int et = 0; et < 4; ++et) sq += (acc[et][0] * acc[et][0] + acc[et][1] * acc[et][1]) + (acc[et][2] * acc[et][2] + acc[et][3] * acc[et][3]);
        sq += x16f(sq); sq += x32f(sq);
        const float rs = rsqrtf(sq * (1.0f / 64.0f) + EPS);
#pragma unroll
        for (int et = 0; et < 4; ++et) {
            const u32x2 gw = *(const u32x2*)(PROJ + (size_t)row * NPROJ + C_HG + h * 64 + 16 * et + 4 * grp);
            const float g0 = bf_lo(gw.x), g1 = bf_hi(gw.x), g2 = bf_lo(gw.y), g3 = bf_hi(gw.y);
            u32x2 o; o.x = pk2(acc[et][0] * rs * (g0 * sigmoidf_(g0)), acc[et][1] * rs * (g1 * sigmoidf_(g1))); o.y = pk2(acc[et][2] * rs * (g2 * sigmoidf_(g2)), acc[et][3] * rs * (g3 * sigmoidf_(g3)));
            *(u32x2*)(MIX + (size_t)row * DM + 768 + h * 64 + 16 * et + 4 * grp) = o;
        }
    }
}

__device__ __forceinline__ void phase_cmp2(const Frame& F, const Args& a, int l) {
    const int kv = F.bid >> 7, rbase = (F.bid & 127) * 32, lane = F.lane;
    LAS float* w2s = (LAS float*)F.lds;
    LAS float* hids = (LAS float*)(F.lds + 65536) + F.wave * 256;
    const float* bias = (const float*)(F.ws + WS_B1P + 65536) + (l * 2 + kv) * 256;
    const f32x4 bv = *(const f32x4*)(bias + 4 * lane);
    bf16_t* dstb = (bf16_t*)(F.ws + (kv == 0 ? WS_KCMP : WS_VCMP));
    f32x4 hs4[4];
#pragma unroll
    for (int rr = 0; rr < 4; ++rr) { const int rowi = rbase + F.wave * 4 + rr; f32x4 t4 = bv;
#pragma unroll
        for (int ks = 0; ks < 2; ++ks) t4 = t4 + *(const f32x4*)((const float*)(F.ws + ws_slab(kv, ks)) + (size_t)rowi * 256 + 4 * lane);
        hs4[rr] = t4; }
    { const float* w2 = a.cmp_w2 + (size_t)(l * 2 + kv) * 256 * 64;
#pragma unroll
      for (int i = 0; i < 8; ++i) *(LAS f32x4*)(w2s + (F.tid + 512 * i) * 4) = *(const f32x4*)(w2 + (F.tid + 512 * i) * 4); }
    __syncthreads();
#pragma unroll
    for (int rr = 0; rr < 4; ++rr) {
        const int rowi = rbase + F.wave * 4 + rr;
        f32x4 hsum = hs4[rr];
#pragma unroll
        for (int e = 0; e < 4; ++e) hsum[e] = hsum[e] * sigmoidf_(hsum[e]);
        asm volatile("s_waitcnt lgkmcnt(0)" ::: "memory");
        *(LAS f32x4*)(hids + 4 * lane) = hsum;
        asm volatile("s_waitcnt lgkmcnt(0)" ::: "memory");
        float s0 = 0.f, s1 = 0.f;
#pragma unroll 8
        for (int j = 0; j < 256; j += 4) { const f32x4 h4 = *(const LAS f32x4*)(hids + j);
            s0 += h4.x * w2s[(j + 0) * 64 + lane] + h4.z * w2s[(j + 2) * 64 + lane]; s1 += h4.y * w2s[(j + 1) * 64 + lane] + h4.w * w2s[(j + 3) * 64 + lane]; }
        dstb[(size_t)rowi * 64 + lane] = ((rowi & 127) == 127) ? (bf16_t)0 : (bf16_t)f2bf(s0 + s1);
    }
    __syncthreads();
}

constexpr int NPH = 1 + 8 * DEPTH;

template <int KF> __device__ __forceinline__ constexpr bool kf_on(int kind) { return KF < 0 || kind == KF || (kind >= 10 && kind / 10 == KF) || (KF >= 10 && KF / 10 == kind); }
template <int KF> __device__ __forceinline__ void mega_body(const Args& args_in) {
    extern __shared__ __attribute__((aligned(16))) unsigned char lds_raw[];
    LAS unsigned char* const lds = (LAS unsigned char*)lds_raw;
    {
        const int tid0 = threadIdx.x;
        const unsigned hw0 = (unsigned)__builtin_amdgcn_s_getreg((5 << 11) | 4) & 63u;
        if ((tid0 & 63) == 0) ((LAS unsigned*)(lds + LDS_WTAB))[hw0] = (unsigned)(tid0 >> 6);
        if (tid0 == 0) { ((LAS unsigned*)(lds + LDS_XBST))[0] = 0u; ((LAS unsigned*)(lds + LDS_XBST))[1] = 0u;
#if MK_ONE_LAUNCH
            (void)xb_add((unsigned*)(args_in.ws + WS_CTL) + CW_BAR + XB_XCNT(xb_xcc_id()), 1u);
#endif
        }
        if (tid0 == 0) { LAS Args* la = (LAS Args*)(lds + LDS_ARGS);
            la->x = args_in.x; la->p = args_in.p; la->w_in = args_in.w_in; la->w_out = args_in.w_out; la->cmp_pos = args_in.cmp_pos; la->cmp_w1 = args_in.cmp_w1; la->cmp_w2 = args_in.cmp_w2; la->hg_lb = args_in.hg_lb;
            la->g_pre_mix = args_in.g_pre_mix; la->g_post_mix = args_in.g_post_mix; la->g_pre_mlp = args_in.g_pre_mlp; la->g_post_mlp = args_in.g_post_mlp; la->w_up = args_in.w_up; la->w_down = args_in.w_down;
            la->g_ple = args_in.g_ple; la->w_ple_gate = args_in.w_ple_gate; la->w_ple_proj = args_in.w_ple_proj; la->out = args_in.out; la->ws = args_in.ws; }
        __syncthreads();
    }
#if MK_ONE_LAUNCH
    const int lo = 0, hi = NPH;
#else
    const int lo = args_in.ph_lo, hi = args_in.ph_hi;
#endif
#define PHASE_KIND_FILTER(kind) kf_on<KF>(kind)
#define INK(kind, k) (PHASE_KIND_FILTER(kind) && lo <= (k) && (k) < hi)
#define IN(k) (lo <= (k) && (k) < hi)
#define SEAM(k) do { if (IN(k) && IN((k) + 1)) { if ((k) == 0) { cg::this_grid().sync(); } else { Args a_; const Frame Fb = make_frame(lds, a_); \
        xcd_barrier((unsigned*)(Fb.ws + WS_CTL) + CW_BAR, (volatile LAS unsigned*)(lds + LDS_XBST), Fb.tid == 0, (unsigned)Fb.G); } } } while (0)
#define PHASE_BEGIN Args args; const Frame F = make_frame(lds, args); \
    unsigned* const ctl = (unsigned*)(F.ws + WS_CTL); bf16_t* const PROJ = (bf16_t*)(F.ws + WS_PROJ); bf16_t* const MIX = (bf16_t*)(F.ws + WS_MIX); bf16_t* const HBA = (bf16_t*)(F.ws + WS_HBA); bf16_t* const HBB = (bf16_t*)args.out; \
    bf16_t* const U = (bf16_t*)(F.ws + WS_U); bf16_t* const PP = (bf16_t*)(F.ws + WS_PP); bf16_t* const PB = (bf16_t*)(F.ws + WS_PB); float* const SSA = (float*)(F.ws + WS_SSA); float* const SSB = (float*)(F.ws + WS_SSB); float* const XBUF = (float*)(F.ws + WS_XBUF); \
    (void)ctl; (void)PROJ; (void)MIX; (void)HBA; (void)HBB; (void)U; (void)PP; (void)PB; (void)SSA; (void)SSB; (void)XBUF;

    for (int rep_ = 0; rep_ < REP_P0; ++rep_) if (INK(0, 0)) { PHASE_BEGIN phase_prologue(F, args); }
    SEAM(0);

#pragma unroll 1
    for (int l = 0; l < DEPTH; ++l) {
        const int pb = 1 + 8 * l;
        for (int rep_ = 0; rep_ < REP_G1; ++rep_) if (INK(1, pb + 0)) { PHASE_BEGIN
            if (l == 0) reduce_bias1(F);
            pg8::Gemm g = pg8::make_gemm(HBB, (const bf16_t*)(F.ws + WS_WIN) + (size_t)l * NPROJ * DM, DM);
            pg8::StaticOrder S; S.init(MTOK, NPROJ, F.G, F.bid);
            fill_rstd(F, SSB, S);
            pg8::EpiBf<1> E{PROJ, NPROJ, (const LAS float*)(F.lds + LDS_RSTD), nullptr};
            pg8::gemm_phase<pg8::EpiBf<1>, pg8::StaticOrder, true>(F.lds, g, S, E);
        }
        SEAM(pb + 0);
        for (int rep_ = 0; rep_ < REP_P2; ++rep_) if (INK(2, pb + 1)) { PHASE_BEGIN
            for (int r2_ = 0; r2_ < REP_HL; ++r2_) if (PHASE_KIND_FILTER(21)) { hgrn_local(F, args, l, F.bid * 8 + F.wave); __syncthreads(); }
            for (int r2_ = 0; r2_ < REP_CG; ++r2_) if (F.bid < 64 && PHASE_KIND_FILTER(20)) {
                const int ks = F.bid & 1, bb = (F.bid >> 1) & 15, kv = F.bid >> 5;
                pg8::Gemm g; g.A = PROJ + (kv == 0 ? C_KC : C_VC) + (size_t)(16 * ks) * NPROJ; g.Bt = (const bf16_t*)(F.ws + WS_W1T) + (size_t)(l * 2 + kv) * 256 * 2048 + 1024 * ks; g.K = 1024; g.ldb = 2048;
                asm volatile("" : "+s"(g.K));
                g.lda = 16 * NPROJ; g.a_kstep = (long)NPROJ * 2; g.a_hstep = 128; g.a_tstep = (long)SEQ * NPROJ * 2;
                pg8::OneFixed S; S.u0.pm = bb; S.u0.pn = 0; S.valid = true;
                pg8::EpiF32P E{(float*)(F.ws + ws_slab(kv, ks)), 256};
                pg8::gemm_phase<pg8::EpiF32P, pg8::OneFixed, false>(F.lds, g, S, E);
                __syncthreads();
            }
            if (F.bid >= 64) {
                for (int r2_ = 0; r2_ < REP_DL; ++r2_) if (PHASE_KIND_FILTER(22)) dil_units(F, F.bid - 64, 192);
            }
        }
        SEAM(pb + 1);
        if (INK(3, pb + 2)) { PHASE_BEGIN for (int r2_ = 0; r2_ < REP_C2; ++r2_) phase_cmp2(F, args, l); for (int r2_ = 0; r2_ < REP_SC; ++r2_) hgrn_scan(F); dil_fixup(F); }
        SEAM(pb + 2);
        for (int rep_ = 0; rep_ < REP_P4; ++rep_) if (INK(4, pb + 3)) { PHASE_BEGIN
            for (int r2_ = 0; r2_ < REP_HF; ++r2_) { hgrn_final(F, F.bid * 8 + F.wave); __syncthreads(); }
            {
                unsigned* qhead = ctl + CW_NSAQ + 64 * l;
                LAS unsigned* qw = (LAS unsigned*)(F.lds + LDS_QW);
#pragma unroll 1
                for (;;) {
                    __syncthreads();
                    if (F.tid == 0) *qw = __hip_atomic_fetch_add(qhead, 1u, __ATOMIC_RELAXED, __HIP_MEMORY_SCOPE_AGENT);
                    __syncthreads();
                    const unsigned idx = (unsigned)__builtin_amdgcn_readfirstlane((int)*qw);
                    if (idx >= 512u) break;
                    const int jb = 15 - (int)(idx >> 5), kvh = (int)(idx & 1u), bb = (int)((idx >> 1) & 15u);
                    nsa_unit2(F, bb, kvh, jb);
                }
            }
        }
        SEAM(pb + 3);
        if (INK(5, pb + 4)) { PHASE_BEGIN
            convert_p(F, args, l);
            pg8::Gemm g = pg8::make_gemm(MIX, (const bf16_t*)(F.ws + WS_WOUT) + (size_t)l * DM * DM, DM);
            pg8::StaticOrder S; S.init(MTOK, DM, F.G, F.bid);
            pg8::EpiPost E{HBB, HBA, args.g_post_mix + l * DM, SSA, XBUF, ctl + CW_CNT + ((l * 2 + 0) * 128) * 64, ctl + CW_TMO, F.lds + LDS_RSTD};
            pg8::gemm_phase<pg8::EpiPost, pg8::StaticOrder, true>(F.lds, g, S, E);
        }
        SEAM(pb + 4);
        for (int rep_ = 0; rep_ < REP_G3; ++rep_) if (INK(6, pb + 5)) { PHASE_BEGIN
            if (PHASE_KIND_FILTER(60)) {
                pg8::Gemm g = pg8::make_gemm(HBA, (const bf16_t*)(F.ws + WS_WUP) + (size_t)l * FF * DM, DM);
                pg8::StaticOrder S; S.init(MTOK, FF, F.G, F.bid);
                fill_rstd(F, SSA, S);
                pg8::EpiBf<2> E{U, FF, (const LAS float*)(F.lds + LDS_RSTD), nullptr};
                pg8::gemm_phase<pg8::EpiBf<2>, pg8::StaticOrder, true>(F.lds, g, S, E);
            }
        }
        SEAM(pb + 5);
        if (INK(7, pb + 6)) { PHASE_BEGIN
            pg8::Gemm g = pg8::make_gemm(U, (const bf16_t*)(F.ws + WS_WDN) + (size_t)l * DM * FF, FF);
            pg8::StaticOrder S; S.init(MTOK, DM, F.G, F.bid);
            pg8::EpiPost E{HBA, HBA, args.g_post_mlp + l * DM, SSA, XBUF, ctl + CW_CNT + ((l * 2 + 1) * 128) * 64, ctl + CW_TMO, F.lds + LDS_RSTD};
            pg8::gemm_phase<pg8::EpiPost, pg8::StaticOrder, true>(F.lds, g, S, E);
        }
        SEAM(pb + 6);
        if (INK(8, pb + 7)) { PHASE_BEGIN
            {
                pg8::Gemm gp = pg8::make_gemm(PB, (const bf16_t*)(F.ws + WS_WPJ) + (size_t)l * DM * PLE, PLE);
                pg8::StaticOrder Sp; Sp.init(MTOK, DM, F.G, F.bid);
                pg8::EpiBf<0> Ep{PP, DM, nullptr, nullptr};
                pg8::gemm_phase<pg8::EpiBf<0>, pg8::StaticOrder, true>(F.lds, gp, Sp, Ep);
                asm volatile("s_waitcnt vmcnt(0)" ::: "memory");
                __syncthreads();
            }
            pg8::Gemm g = pg8::make_gemm(HBA, (const bf16_t*)(F.ws + WS_WG) + (size_t)l * DM * DM, DM);
            pg8::StaticOrder S; S.init(MTOK, DM, F.G, F.bid);
            fill_rstd(F, SSA, S);
            pg8::EpiPle E{(const LAS float*)(F.lds + LDS_RSTD), PP, HBA, (l == DEPTH - 1) ? args.out : (float*)nullptr, HBB, SSB};
            pg8::gemm_phase<pg8::EpiPle, pg8::StaticOrder, true>(F.lds, g, S, E);
        }
        SEAM(pb + 7);
    }
#undef IN
#undef SEAM
#undef INK
#undef PHASE_KIND_FILTER
#undef PHASE_BEGIN
}
template <int KF> __global__ void __launch_bounds__(512, 2) mega_k(Args args) { mega_body<KF>(args); }

template <int KF> static bool setup_kernel() {
    return hipFuncSetAttribute((const void*)mega_k<KF>, hipFuncAttributeMaxDynamicSharedMemorySize, LDS_BYTES) == hipSuccess;
}
template <int KF> static void launch_phase(int grid, const Args& a, hipStream_t stream) {
    hipLaunchKernelGGL(mega_k<KF>, dim3(grid), dim3(512), LDS_BYTES, stream, a);
}
extern "C" void kernel_launch(void* const* d_in, const int* in_sizes, int n_in, void* d_out, int out_size, void* d_ws, size_t ws_size, hipStream_t stream) {
    static int grid = 0;
    if (grid == 0) {
        if (n_in != 17 || in_sizes[0] != MTOK * DM || out_size != MTOK * DM || ws_size < WS_END) {
            fprintf(stderr, "kernel_launch: unexpected problem (n_in %d, in0 %d, out %d, ws %zu)\n", n_in, n_in > 0 ? in_sizes[0] : -1, out_size, ws_size); grid = -1; return; }
        int dev = 0, cus = 0, per_cu = 0;
        (void)hipGetDevice(&dev); (void)hipDeviceGetAttribute(&cus, hipDeviceAttributeMultiprocessorCount, dev);
        bool ok = true;
#if MK_ONE_LAUNCH
        ok = setup_kernel<-1>();
        if (hipOccupancyMaxActiveBlocksPerMultiprocessor(&per_cu, (const void*)mega_k<-1>, 512, LDS_BYTES) != hipSuccess || per_cu < 1) { fprintf(stderr, "kernel_launch: occupancy query says %d\n", per_cu); }
#else
        ok = setup_kernel<0>() && setup_kernel<1>() && setup_kernel<20>() && setup_kernel<21>() && setup_kernel<22>() && setup_kernel<3>() && setup_kernel<4>() && setup_kernel<5>() && setup_kernel<6>() && setup_kernel<7>() && setup_kernel<8>();
#endif
        if (!ok) { fprintf(stderr, "kernel_launch: hipFuncSetAttribute failed\n"); grid = -1; return; }
        (void)hipGetLastError();
        grid = cus;
        if (grid != 256) fprintf(stderr, "kernel_launch: %d CUs; this kernel is built for 256\n", grid);
    }
    if (grid < 0) return;
    (void)hipMemsetAsync((char*)d_ws + WS_CTL, 0, CTL_BYTES, stream);
    Args a{};
    a.x = (const float*)d_in[0]; a.p = (const float*)d_in[1]; a.w_in = (const float*)d_in[2]; a.w_out = (const float*)d_in[3]; a.cmp_pos = (const float*)d_in[4];
    a.cmp_w1 = (const float*)d_in[5]; a.cmp_w2 = (const float*)d_in[6]; a.hg_lb = (const float*)d_in[7]; a.g_pre_mix = (const float*)d_in[8]; a.g_post_mix = (const float*)d_in[9];
    a.g_pre_mlp = (const float*)d_in[10]; a.g_post_mlp = (const float*)d_in[11]; a.w_up = (const float*)d_in[12]; a.w_down = (const float*)d_in[13]; a.g_ple = (const float*)d_in[14];
    a.w_ple_gate = (const float*)d_in[15]; a.w_ple_proj = (const float*)d_in[16];
    a.out = (float*)d_out; a.ws = (unsigned char*)d_ws;
#if MK_ONE_LAUNCH
    a.ph_lo = 0; a.ph_hi = NPH;
    void* kargs[] = {&a};
    hipError_t e = hipLaunchCooperativeKernel((const void*)mega_k<-1>, dim3(grid), dim3(512), kargs, LDS_BYTES, stream);
    if (e != hipSuccess) fprintf(stderr, "kernel_launch: cooperative launch failed: %s\n", hipGetErrorString(e));
#else
    for (int ph = 0; ph < NPH; ++ph) {
        a.ph_lo = ph; a.ph_hi = ph + 1;
        const int kind = (ph == 0) ? 0 : ((ph - 1) % 8) + 1;
        switch (kind) {
            case 0: launch_phase<0>(grid, a, stream); break;
            case 1: launch_phase<1>(grid, a, stream); break;
            case 2: launch_phase<20>(grid, a, stream); launch_phase<21>(grid, a, stream); launch_phase<22>(grid, a, stream); break;
            case 3: launch_phase<3>(grid, a, stream); break;
            case 4: launch_phase<4>(grid, a, stream); break;
            case 5: launch_phase<5>(grid, a, stream); break;
            case 6: launch_phase<6>(grid, a, stream); break;
            case 7: launch_phase<7>(grid, a, stream); break;
            default: launch_phase<8>(grid, a, stream); break;
        }
    }
#endif
}
```

```cpp
#include <hip/hip_runtime.h>
#include <hip/hip_cooperative_groups.h>
#include <cstdio>
#include <cstdint>
namespace cg = cooperative_groups;

#ifndef REP_P0
#define REP_P0 1
#endif
#ifndef REP_HL
#define REP_HL 1
#endif
#ifndef REP_CG
#define REP_CG 1
#endif
#ifndef REP_DL
#define REP_DL 1
#endif
#ifndef REP_HF
#define REP_HF 1
#endif
#ifndef REP_NSA
#define REP_NSA 1
#endif
#ifndef REP_CMP
#define REP_CMP 1
#endif
#ifndef REP_SEL
#define REP_SEL 1
#endif
#ifndef REP_WIN
#define REP_WIN 1
#endif
#ifndef REP_C2
#define REP_C2 1
#endif
#ifndef REP_SC
#define REP_SC 1
#endif
#ifndef REP_G1
#define REP_G1 1
#endif
#ifndef REP_P2
#define REP_P2 1
#endif
#ifndef REP_P4
#define REP_P4 1
#endif
#ifndef REP_G3
#define REP_G3 1
#endif
#ifndef MK_ONE_LAUNCH
#define MK_ONE_LAUNCH 1
#endif

constexpr int BATCH = 16, SEQ = 2048, DM = 1024, MTOK = BATCH * SEQ, DEPTH = 2;
constexpr int FF = 4096, PLE = 256;
constexpr int IN_TOTAL = 3346, NPROJ = 3584;
constexpr int C_NQ = 0, C_KC = 384, C_VC = 512, C_KS = 640, C_VS = 768, C_KW = 896, C_VW = 1024;
constexpr int C_DQ = 1152, C_DK = 1536, C_DV = 1920, C_HQ = 2304, C_HF = 2560, C_HI = 2816, C_HG = 3072, C_GATE = 3328;
constexpr float EPS = 1e-6f;
constexpr float NEGBIG = -1e30f;

constexpr size_t MiB = 1u << 20;
constexpr size_t WS_CTL = 0, CTL_BYTES = 1 * MiB;
constexpr size_t WS_SSA = 1 * MiB;
constexpr size_t WS_SSB = 3 * MiB;
constexpr size_t WS_XBUF = 5 * MiB;
constexpr size_t WS_KCMP = 6 * MiB;
constexpr size_t WS_VCMP = 7 * MiB;
constexpr size_t WS_HID = 8 * MiB;
constexpr size_t WS_WIN = 12 * MiB;
constexpr size_t WS_WOUT = 26 * MiB;
constexpr size_t WS_WUP = 30 * MiB;
constexpr size_t WS_WDN = 46 * MiB;
constexpr size_t WS_WG = 62 * MiB;
constexpr size_t WS_WPJ = 66 * MiB;
constexpr size_t WS_W1T = 67 * MiB;
constexpr size_t WS_B1P = 71 * MiB;
constexpr size_t WS_PB = 72 * MiB;
constexpr size_t WS_HBA = 88 * MiB;
constexpr size_t WS_PP = 152 * MiB;
constexpr size_t WS_PROJ = 216 * MiB;
constexpr size_t WS_MIX = 440 * MiB;
constexpr size_t WS_U = 216 * MiB;
constexpr size_t WS_END = 504 * MiB;
constexpr size_t WS_OLOC = WS_HBA;
constexpr size_t WS_QE = WS_HBA + 32 * MiB;
constexpr size_t WS_HUS = WS_HBA + 48 * MiB;
constexpr size_t WS_HU = WS_PP;
constexpr size_t WS_HD = WS_PP + 32 * MiB;
constexpr size_t WS_LSE = WS_PP + 33 * MiB;
__host__ __device__ constexpr size_t ws_slab(int kv, int ks) { return (kv == 0 ? WS_PB : WS_PP + 48 * MiB) + (size_t)ks * 4 * MiB; }
constexpr int CW_TMO = 0;
constexpr int CW_BAR = 65536;
constexpr int CW_NSAQ = 512;
constexpr int CW_CNT = 1024;

constexpr int RING_BYTES = 131072;
constexpr int MISC_OFF = RING_BYTES;
constexpr int LDS_BYTES = 147456;
constexpr int LDS_ARGS = MISC_OFF + 4096;
constexpr int LDS_XBST = MISC_OFF + 4096 + 256;
constexpr int LDS_QW = MISC_OFF + 4096 + 320;
constexpr int LDS_WTAB = MISC_OFF + 4096 + 512;
constexpr int LDS_RSTD = MISC_OFF + 8192;

#define LAS __attribute__((address_space(3)))
typedef unsigned short bf16_t;
typedef float f32x4 __attribute__((ext_vector_type(4)));
typedef float f32x2 __attribute__((ext_vector_type(2)));
typedef unsigned u32x4 __attribute__((ext_vector_type(4)));
typedef unsigned u32x2 __attribute__((ext_vector_type(2)));

__device__ __forceinline__ float bf_lo(unsigned u) { return __uint_as_float(u << 16); }
__device__ __forceinline__ float bf_hi(unsigned u) { return __uint_as_float(u & 0xffff0000u); }
__device__ __forceinline__ unsigned f2bf(float f) { unsigned u = __float_as_uint(f); return (u + 0x7fffu + ((u >> 16) & 1u)) >> 16; }
__device__ __forceinline__ unsigned pk2(float lo, float hi) { return f2bf(lo) | (f2bf(hi) << 16); }
__device__ __forceinline__ float rcpf_(float x) { return __builtin_amdgcn_rcpf(x); }
__device__ __forceinline__ float sigmoidf_(float x) { return rcpf_(1.0f + __expf(-x)); }
__device__ __forceinline__ unsigned x16u(unsigned v) { auto r = __builtin_amdgcn_permlane16_swap(v, v, false, false); return r[0] ^ r[1] ^ v; }
__device__ __forceinline__ unsigned x32u(unsigned v) { auto r = __builtin_amdgcn_permlane32_swap(v, v, false, false); return r[0] ^ r[1] ^ v; }
__device__ __forceinline__ float x16f(float v) { return __uint_as_float(x16u(__float_as_uint(v))); }
__device__ __forceinline__ float x32f(float v) { return __uint_as_float(x32u(__float_as_uint(v))); }
template <int CTRL> __device__ __forceinline__ unsigned dppu(unsigned v) { return (unsigned)__builtin_amdgcn_update_dpp((int)v, (int)v, CTRL, 0xf, 0xf, false); }
__device__ __forceinline__ float row_sum16(float v) {
    v += __uint_as_float(dppu<0xB1>(__float_as_uint(v))); v += __uint_as_float(dppu<0x4E>(__float_as_uint(v)));
    v += __uint_as_float(dppu<0x141>(__float_as_uint(v))); v += __uint_as_float(dppu<0x140>(__float_as_uint(v))); return v;
}
__device__ __forceinline__ unsigned row_or16(unsigned v) { v |= dppu<0xB1>(v); v |= dppu<0x4E>(v); v |= dppu<0x141>(v); v |= dppu<0x140>(v); return v; }
__device__ __forceinline__ float wave_sum(float v) { v = row_sum16(v); v += x16f(v); v += x32f(v); return v; }

namespace pg8 {
#define PG8_LAS __attribute__((address_space(3)))
typedef short bf16x8 __attribute__((ext_vector_type(8)));
constexpr int BM = 256, BK = 64, HALF = 128, HTB = HALF * BK * 2, STAGE_BYTES = 8 * HTB, NXCD = 8, WGM = 8;

__host__ __device__ __forceinline__ int lds_byte(int r, int c) { const int st = (r >> 4) * 2 + (c >> 5), rr = r & 15, cc = c & 31, ob = rr * 64 + cc * 2; return st * 1024 + (ob ^ (((ob >> 9) & 1) << 5)); }
__host__ __device__ __forceinline__ void stage_rc(int b, int& R, int& C) { const int st = b / 1024, sb = b % 1024, swz = sb ^ (((sb >> 9) & 1) << 5); R = (st >> 1) * 16 + swz / 64; C = (st & 1) * 32 + (swz % 64) / 2; }
__host__ __device__ __forceinline__ int perm32(int rho) { const int n = rho >> 4, i = rho & 15; return 8 * (i >> 2) + 4 * n + (i & 3); }

struct Unit { int pm, pn; };
struct Gemm { const bf16_t* A; const bf16_t* Bt; int K; int lda; long a_kstep, a_hstep, a_tstep; int ldb; };
__device__ __forceinline__ Gemm make_gemm(const bf16_t* A, const bf16_t* Bt, int K) { asm volatile("" : "+s"(K)); Gemm g; g.A = A; g.Bt = Bt; g.K = K; g.lda = K; g.a_kstep = BK * 2; g.a_hstep = (long)HALF * K * 2; g.a_tstep = 2 * g.a_hstep; g.ldb = K; return g; }

struct StaticOrder {
    int nM, nN, nwg, G, c;
    __device__ void init(int M, int N, int G_, int c_) { nM = M / BM; nN = N / BM; nwg = nM * nN; G = G_; c = c_; }
    __device__ bool next(int i, Unit& u) const {
        const long L = (long)i * G + c; if (L >= nwg) return false;
        int wgid = (int)L; { const int q = nwg / NXCD, r = nwg % NXCD, xcd = wgid % NXCD, off = wgid / NXCD; wgid = (xcd < r ? xcd * (q + 1) : r * (q + 1) + (xcd - r) * q) + off; }
        const int nig = WGM * nN, gid = wgid / nig, fm = gid * WGM, gsz = (nM - fm) < WGM ? (nM - fm) : WGM;
        u.pm = fm + ((wgid % nig) % gsz); u.pn = (wgid % nig) / gsz; return true;
    }
};
struct OneOf { StaticOrder S; int i;
    __device__ bool next(int j, Unit& u) const { return j == 0 ? S.next(i, u) : false; } };
struct OneFixed { Unit u0; bool valid;
    __device__ bool next(int j, Unit& u) const { if (j == 0 && valid) { u = u0; return true; } return false; } };

__device__ __forceinline__ unsigned cvt_pk_bf16(float lo, float hi) { unsigned r; asm volatile("v_cvt_pk_bf16_f32 %0, %1, %2" : "=v"(r) : "v"(lo), "v"(hi)); return r; }

__device__ __forceinline__ float row_rstd16(const float* ss, long row) {
    const f32x4* sp = (const f32x4*)(ss + row * 16);
    const f32x4 a = sp[0], b = sp[1], c = sp[2], d = sp[3];
    const float tot = ((a.x + a.y) + (a.z + a.w)) + ((b.x + b.y) + (b.z + b.w)) + ((c.x + c.y) + (c.z + c.w)) + ((d.x + d.y) + (d.z + d.w));
    return rsqrtf(tot * (1.0f / 1024.0f) + EPS);
}

template <int MODE> struct EpiBf {
    static constexpr bool PERM = true, AFTER_DRAIN = false;
    bf16_t* O; int ldc; const PG8_LAS float* rstd; const float* bias;
    __device__ __forceinline__ void operator()(const f32x4 (&acc)[2][2][4][2], const Unit& u, int ui, int wr, int wc, int fr, int fq) const {
        const int row0 = u.pm * BM + wr * 64 + fr; const int col0 = u.pn * BM + wc * 32 + 8 * fq;
        f32x4 bv[2][2];
        if (MODE == 3) {
#pragma unroll
            for (int bj = 0; bj < 2; ++bj)
#pragma unroll
                for (int n = 0; n < 2; ++n) bv[bj][n] = *(const f32x4*)(bias + col0 + bj * HALF + 4 * n);
        }
#pragma unroll
        for (int ai = 0; ai < 2; ++ai)
#pragma unroll
            for (int m = 0; m < 4; ++m) {
                const long row = row0 + ai * HALF + m * 16;
                float rs = 1.0f;
                if (MODE == 1 || MODE == 2) rs = rstd[ui * 256 + wr * 64 + fr + ai * HALF + m * 16];
                bf16_t* rowp = O + (size_t)row * ldc + col0;
#pragma unroll
                for (int bj = 0; bj < 2; ++bj) {
                    f32x4 v0 = acc[ai][bj][m][0], v1 = acc[ai][bj][m][1];
                    if (MODE == 1) { v0 = v0 * rs; v1 = v1 * rs; }
                    if (MODE == 2) {
                        v0 = v0 * rs; v1 = v1 * rs;
#pragma unroll
                        for (int e = 0; e < 4; ++e) { const float a = fmaxf(v0[e], 0.f), b = fmaxf(v1[e], 0.f); v0[e] = a * a; v1[e] = b * b; }
                    }
                    if (MODE == 3) {
                        v0 = v0 + bv[bj][0]; v1 = v1 + bv[bj][1];
#pragma unroll
                        for (int e = 0; e < 4; ++e) { v0[e] = v0[e] * sigmoidf_(v0[e]); v1[e] = v1[e] * sigmoidf_(v1[e]); }
                    }
                    u32x4 w; w.x = cvt_pk_bf16(v0[0], v0[1]); w.y = cvt_pk_bf16(v0[2], v0[3]); w.z = cvt_pk_bf16(v1[0], v1[1]); w.w = cvt_pk_bf16(v1[2], v1[3]);
                    *(u32x4*)(rowp + bj * HALF) = w;
                }
            }
    }
};

struct EpiF32P {
    static constexpr bool PERM = false, AFTER_DRAIN = false;
    float* C; int ldc;
    __device__ __forceinline__ void operator()(const f32x4 (&acc)[2][2][4][2], const Unit& u, int ui, int wr, int wc, int fr, int fq) const {
        const int row0 = u.pm * BM + wr * 64 + fr, col0 = u.pn * BM + wc * 32 + 4 * fq;
#pragma unroll
        for (int ai = 0; ai < 2; ++ai)
#pragma unroll
            for (int m = 0; m < 4; ++m) { float* rowp = C + (size_t)(row0 + ai * HALF + m * 16) * ldc + col0;
#pragma unroll
                for (int bj = 0; bj < 2; ++bj)
#pragma unroll
                    for (int n = 0; n < 2; ++n) *(f32x4*)(rowp + bj * HALF + n * 16) = acc[ai][bj][m][n]; }
    }
};
struct EpiPle {
    static constexpr bool PERM = true, AFTER_DRAIN = false;
    const PG8_LAS float* rstd; const bf16_t* pp; const bf16_t* hin; float* outf; bf16_t* hb; float* sso;
    __device__ __forceinline__ void operator()(const f32x4 (&acc)[2][2][4][2], const Unit& u, int ui, int wr, int wc, int fr, int fq) const {
        const int row0 = u.pm * BM + wr * 64 + fr; const int col0 = u.pn * BM + wc * 32 + 8 * fq;
        u32x4 pw[2][2][2], hw[2][2][2];
#define PLE_LOAD(set_, b_) do { _Pragma("unroll") for (int q_ = 0; q_ < 2; ++q_) { const long row_ = row0 + ((b_) >> 1) * HALF + (((b_) & 1) * 2 + q_) * 16; \
            _Pragma("unroll") for (int bj_ = 0; bj_ < 2; ++bj_) { const size_t off_ = (size_t)row_ * DM + col0 + bj_ * HALF; pw[set_][q_][bj_] = *(const u32x4*)(pp + off_); hw[set_][q_][bj_] = *(const u32x4*)(hin + off_); } } } while (0)
        PLE_LOAD(0, 0); PLE_LOAD(1, 1);
#pragma unroll
        for (int b = 0; b < 4; ++b) {
            const int set = b & 1, ai = b >> 1;
#pragma unroll
            for (int q = 0; q < 2; ++q) {
                const int m = (b & 1) * 2 + q;
                const long row = row0 + ai * HALF + m * 16;
                const float rs = rstd[ui * 256 + wr * 64 + fr + ai * HALF + m * 16];
                float sq = 0.f;
#pragma unroll
                for (int bj = 0; bj < 2; ++bj) {
                    const size_t off = (size_t)row * DM + col0 + bj * HALF;
                    const u32x4 pwv = pw[set][q][bj], hwv = hw[set][q][bj];
                    const f32x4 a0 = acc[ai][bj][m][0] * rs, a1 = acc[ai][bj][m][1] * rs;
                    f32x4 o0, o1;
                    o0[0] = bf_lo(hwv.x) + bf_lo(pwv.x) * sigmoidf_(a0[0]); o0[1] = bf_hi(hwv.x) + bf_hi(pwv.x) * sigmoidf_(a0[1]);
                    o0[2] = bf_lo(hwv.y) + bf_lo(pwv.y) * sigmoidf_(a0[2]); o0[3] = bf_hi(hwv.y) + bf_hi(pwv.y) * sigmoidf_(a0[3]);
                    o1[0] = bf_lo(hwv.z) + bf_lo(pwv.z) * sigmoidf_(a1[0]); o1[1] = bf_hi(hwv.z) + bf_hi(pwv.z) * sigmoidf_(a1[1]);
                    o1[2] = bf_lo(hwv.w) + bf_lo(pwv.w) * sigmoidf_(a1[2]); o1[3] = bf_hi(hwv.w) + bf_hi(pwv.w) * sigmoidf_(a1[3]);
                    if (outf) { *(f32x4*)(outf + off) = o0; *(f32x4*)(outf + off + 4) = o1; }
                    else {
                        sq += (o0[0] * o0[0] + o0[1] * o0[1]) + (o0[2] * o0[2] + o0[3] * o0[3]) + (o1[0] * o1[0] + o1[1] * o1[1]) + (o1[2] * o1[2] + o1[3] * o1[3]);
                        u32x4 w; w.x = cvt_pk_bf16(o0[0], o0[1]); w.y = cvt_pk_bf16(o0[2], o0[3]); w.z = cvt_pk_bf16(o1[0], o1[1]); w.w = cvt_pk_bf16(o1[2], o1[3]);
                        *(u32x4*)(hb + off) = w;
                    }
                }
                if (!outf) { sq += x16f(sq); sq += x32f(sq); if (fq == 0) sso[row * 16 + u.pn * 4 + wc] = sq; }
            }
            if (b + 2 < 4) { if (set == 0) PLE_LOAD(0, b + 2); else PLE_LOAD(1, b + 2); }
        }
#undef PLE_LOAD
    }
};
struct EpiPost {
    static constexpr bool PERM = true, AFTER_DRAIN = false;
    const bf16_t* base; bf16_t* hb; const float* gvec; float* sso; float* xbuf; unsigned* cnt_bank; unsigned* tmo; PG8_LAS unsigned char* tab;
    __device__ __forceinline__ void operator()(const f32x4 (&acc)[2][2][4][2], const Unit& u, int ui, int wr, int wc, int fr, int fq) const {
        const int wid = wr * 4 + wc, lane = fq * 16 + fr;
        unsigned* cnt = cnt_bank + u.pm * 64;
        u32x4 bpre[2][4][2];
        { const int colp = u.pn * BM + wc * 32 + 8 * fq;
#pragma unroll
          for (int ai = 0; ai < 2; ++ai)
#pragma unroll
            for (int m = 0; m < 4; ++m) { const size_t offp = (size_t)(u.pm * BM + ai * HALF + wr * 64 + m * 16 + fr) * DM + colp;
#pragma unroll
                for (int bj = 0; bj < 2; ++bj) bpre[ai][m][bj] = *(const u32x4*)(base + offp + bj * HALF); } }
        PG8_LAS float* P = (PG8_LAS float*)tab;
        PG8_LAS float* S = (PG8_LAS float*)(tab + 4096);
#pragma unroll
        for (int ai = 0; ai < 2; ++ai)
#pragma unroll
            for (int m = 0; m < 4; ++m) {
                float s = 0.f;
#pragma unroll
                for (int bj = 0; bj < 2; ++bj)
#pragma unroll
                    for (int n = 0; n < 2; ++n) { const f32x4 x = acc[ai][bj][m][n]; s += (x[0] * x[0] + x[1] * x[1]) + (x[2] * x[2] + x[3] * x[3]); }
                s += x16f(s); s += x32f(s);
                if (fq == 0) P[(ai * HALF + wr * 64 + m * 16 + fr) * 4 + wc] = s;
            }
        asm volatile("s_waitcnt lgkmcnt(0)" ::: "memory"); __builtin_amdgcn_s_barrier(); asm volatile("" ::: "memory");
        const int row = wid * 32 + (lane & 31);
        if (lane < 32) {
            const float tot = (P[row * 4 + 0] + P[row * 4 + 1]) + (P[row * 4 + 2] + P[row * 4 + 3]);
            __hip_atomic_store(xbuf + ((size_t)(u.pm * BM + row) * 4 + u.pn), tot, __ATOMIC_RELAXED, __HIP_MEMORY_SCOPE_AGENT);
        }
        asm volatile("s_waitcnt vmcnt(0)" ::: "memory");
        if (lane == 0) __hip_atomic_fetch_add(cnt, 1u, __ATOMIC_RELAXED, __HIP_MEMORY_SCOPE_AGENT);
        if (wid == 0) {
            unsigned spins = 0;
            while ((unsigned)__builtin_amdgcn_readfirstlane(__hip_atomic_load(cnt, __ATOMIC_RELAXED, __HIP_MEMORY_SCOPE_AGENT)) < 32u) {
                __builtin_amdgcn_s_sleep(2);
                if (++spins > (1u << 22)) { if (lane == 0) __hip_atomic_store(tmo, 1u, __ATOMIC_RELAXED, __HIP_MEMORY_SCOPE_AGENT); break; }
            }
            __builtin_amdgcn_fence(__ATOMIC_ACQUIRE, "agent");
        }
        asm volatile("s_waitcnt vmcnt(0) lgkmcnt(0)" ::: "memory"); __builtin_amdgcn_s_barrier(); asm volatile("" ::: "memory");
        if (lane < 32) {
            const float* slot = xbuf + (size_t)(u.pm * BM + row) * 4;
            float t0 = __hip_atomic_load(slot + 0, __ATOMIC_RELAXED, __HIP_MEMORY_SCOPE_AGENT);
            float t1 = __hip_atomic_load(slot + 1, __ATOMIC_RELAXED, __HIP_MEMORY_SCOPE_AGENT);
            float t2 = __hip_atomic_load(slot + 2, __ATOMIC_RELAXED, __HIP_MEMORY_SCOPE_AGENT);
            float t3 = __hip_atomic_load(slot + 3, __ATOMIC_RELAXED, __HIP_MEMORY_SCOPE_AGENT);
            S[row] = rsqrtf(((t0 + t1) + (t2 + t3)) * (1.0f / 1024.0f) + EPS);
        }
        asm volatile("s_waitcnt vmcnt(0) lgkmcnt(0)" ::: "memory"); __builtin_amdgcn_s_barrier(); asm volatile("" ::: "memory");
        const int col0 = u.pn * BM + wc * 32 + 8 * fq;
        f32x4 gv[2][2];
#pragma unroll
        for (int bj = 0; bj < 2; ++bj)
#pragma unroll
            for (int n = 0; n < 2; ++n) gv[bj][n] = *(const f32x4*)(gvec + col0 + bj * HALF + 4 * n);
#pragma unroll
        for (int ai = 0; ai < 2; ++ai)
#pragma unroll
            for (int m = 0; m < 4; ++m) {
                const int r = ai * HALF + wr * 64 + m * 16 + fr; const float rs = S[r];
                const size_t off = (size_t)(u.pm * BM + r) * DM + col0;
                float sq = 0.f;
#pragma unroll
                for (int bj = 0; bj < 2; ++bj) {
                    const u32x4 bw = bpre[ai][m][bj];
                    const f32x4 b0 = {bf_lo(bw.x), bf_hi(bw.x), bf_lo(bw.y), bf_hi(bw.y)}, b1 = {bf_lo(bw.z), bf_hi(bw.z), bf_lo(bw.w), bf_hi(bw.w)};
                    const f32x4 o0 = b0 + acc[ai][bj][m][0] * rs * gv[bj][0], o1 = b1 + acc[ai][bj][m][1] * rs * gv[bj][1];
                    sq += ((o0[0] * o0[0] + o0[1] * o0[1]) + (o0[2] * o0[2] + o0[3] * o0[3])) + ((o1[0] * o1[0] + o1[1] * o1[1]) + (o1[2] * o1[2] + o1[3] * o1[3]));
                    u32x4 w; w.x = cvt_pk_bf16(o0[0], o0[1]); w.y = cvt_pk_bf16(o0[2], o0[3]); w.z = cvt_pk_bf16(o1[0], o1[1]); w.w = cvt_pk_bf16(o1[2], o1[3]);
                    *(u32x4*)(hb + off + bj * HALF) = w;
                }
                sq += x16f(sq); sq += x32f(sq);
                if (fq == 0) sso[(size_t)(u.pm * BM + r) * 16 + u.pn * 4 + wc] = sq;
            }
    }
};

template <class Epi, class Sched, bool ALIGN_EPI>
__device__ __forceinline__ void gemm_phase(PG8_LAS unsigned char* lds, const Gemm g, const Sched& S, const Epi& E) {
    int tid_;
    {   int ln_; asm volatile("v_mbcnt_lo_u32_b32 %0, -1, 0\n\tv_mbcnt_hi_u32_b32 %0, -1, %0" : "=v"(ln_));
        const unsigned hw_ = (unsigned)__builtin_amdgcn_s_getreg((5 << 11) | 4) & 63u; unsigned to_ = LDS_WTAB; asm volatile("" : "+v"(to_));
        int wv_ = (int)((const PG8_LAS unsigned*)(lds + to_))[hw_]; wv_ = __builtin_amdgcn_readfirstlane(wv_); tid_ = wv_ * 64 + ln_; }
    asm volatile("" : "+v"(tid_));
    const int tid = tid_, wid = __builtin_amdgcn_readfirstlane(tid >> 6), lane = tid & 63, wr = wid >> 2, wc = wid & 3, fr = lane & 15, fq = lane >> 4;
    const int K = g.K, nt = K / BK;
    unsigned voffA[2], voffB[2];
#pragma unroll
    for (int i = 0; i < 2; ++i) { int R, C; stage_rc(tid * 16 + i * 8192, R, C); const int Rb = Epi::PERM ? ((R & ~31) + perm32(R & 31)) : R;
        voffA[i] = (unsigned)(R * g.lda + C) * 2u; voffB[i] = (unsigned)(Rb * g.ldb + C) * 2u; }
    const size_t kstepA = (size_t)g.a_kstep, hstepA = (size_t)g.a_hstep, tstepA = (size_t)g.a_tstep;
    const size_t kstepB = (size_t)(BK * 2), hstepB = (size_t)HALF * g.ldb * 2, tstepB = 2 * hstepB;
    const unsigned ldsw = (unsigned)wid * 1024u;
    const int aoff = lds_byte(wr * 64 + fr, fq * 8), boff = lds_byte(wc * 32 + fr, fq * 8);
#define PG8_SA(b, h) (((b) * 2 + (h)) * HTB)
#define PG8_SB(b, h) ((4 + (b) * 2 + (h)) * HTB)
#define PG8_STAGE(bufoff, gbase, voff) do { _Pragma("unroll") for (int _i = 0; _i < 2; ++_i) \
        __builtin_amdgcn_global_load_lds((const unsigned*)((const char*)(gbase) + (voff)[_i]), (PG8_LAS unsigned*)(lds + (bufoff) + ldsw + _i * 8192), 16, 0, 0); } while (0)
#define PG8_LDA(dst, b, h) do { _Pragma("unroll") for (int m = 0; m < 4; ++m) _Pragma("unroll") for (int k = 0; k < 2; ++k) dst[m][k] = *(const PG8_LAS bf16x8*)(lds + PG8_SA(b, h) + aoff + m * 2048 + k * 1024); } while (0)
#define PG8_LDB(dst, b, h) do { _Pragma("unroll") for (int n = 0; n < 2; ++n) _Pragma("unroll") for (int k = 0; k < 2; ++k) dst[n][k] = *(const PG8_LAS bf16x8*)(lds + PG8_SB(b, h) + boff + n * 2048 + k * 1024); } while (0)
#define PG8_MMA(ai, bj, At, Bt) do { __builtin_amdgcn_s_setprio(1); _Pragma("unroll") for (int m = 0; m < 4; ++m) _Pragma("unroll") for (int n = 0; n < 2; ++n) _Pragma("unroll") for (int k = 0; k < 2; ++k) \
        acc[ai][bj][m][n] = __builtin_amdgcn_mfma_f32_16x16x32_bf16(Bt[n][k], At[m][k], acc[ai][bj][m][n], 0, 0, 0); __builtin_amdgcn_s_setprio(0); } while (0)
#define PG8_WAIT_V(n) asm volatile("s_waitcnt vmcnt(" #n ")" ::: "memory")
#define PG8_WAIT_L(n) asm volatile("s_waitcnt lgkmcnt(" #n ")" ::: "memory")
#define PG8_BAR __builtin_amdgcn_s_barrier()
#define PG8_SCHED __builtin_amdgcn_sched_barrier(0)
    Unit cur, nxt; int ui = 0;
    if (!S.next(0, cur)) return;
    f32x4 acc[2][2][4][2];
#pragma unroll
    for (int a = 0; a < 2; ++a)
#pragma unroll
        for (int b = 0; b < 2; ++b)
#pragma unroll
            for (int m = 0; m < 4; ++m)
#pragma unroll
                for (int n = 0; n < 2; ++n) acc[a][b][m][n] = (f32x4){0.f, 0.f, 0.f, 0.f};
    bf16x8 At[4][2], B0[2][2], B1[2][2];
    const char* cA = (const char*)g.A + (size_t)cur.pm * tstepA; const char* cB = (const char*)g.Bt + (size_t)cur.pn * tstepB;
    PG8_STAGE(PG8_SB(0, 0), cB, voffB); PG8_STAGE(PG8_SB(0, 1), cB + hstepB, voffB); PG8_STAGE(PG8_SA(0, 0), cA, voffA); PG8_STAGE(PG8_SA(0, 1), cA + hstepA, voffA);
    if (wr == 1) PG8_BAR;
    PG8_WAIT_V(2); PG8_BAR;
    PG8_STAGE(PG8_SB(1, 0), cB + kstepB, voffB); PG8_STAGE(PG8_SA(1, 0), cA + kstepA, voffA); PG8_STAGE(PG8_SB(1, 1), cB + hstepB + kstepB, voffB);
    PG8_WAIT_V(6); PG8_BAR;
    for (;;) {
        const bool has_next = S.next(ui + 1, nxt);
        const char* nA = has_next ? (const char*)g.A + (size_t)nxt.pm * tstepA : cA; const char* nB = has_next ? (const char*)g.Bt + (size_t)nxt.pn * tstepB : cB;
        for (int t = 0; t < nt; t += 2) {
            const bool last = (t == nt - 2);
            const char* a1 = cA + (size_t)(t + 1) * kstepA;
            const char* a2 = last ? nA : cA + (size_t)(t + 2) * kstepA; const char* b2 = last ? nB : cB + (size_t)(t + 2) * kstepB;
            const char* a3 = a2 + kstepA; const char* b3 = b2 + kstepB;
            PG8_LDB(B0, 0, 0); PG8_LDB(B1, 0, 1); PG8_SCHED; PG8_LDA(At, 0, 0); PG8_STAGE(PG8_SA(1, 1), a1 + hstepA, voffA);
            PG8_WAIT_V(8); PG8_WAIT_L(0); PG8_BAR; PG8_MMA(0, 0, At, B0); PG8_MMA(0, 1, At, B1); PG8_BAR; PG8_SCHED;
            PG8_LDA(At, 0, 1); PG8_STAGE(PG8_SB(0, 0), b2, voffB); PG8_STAGE(PG8_SB(0, 1), b2 + hstepB, voffB); PG8_STAGE(PG8_SA(0, 0), a2, voffA);
            PG8_WAIT_V(8); PG8_WAIT_L(0); PG8_BAR; PG8_MMA(1, 0, At, B0); PG8_MMA(1, 1, At, B1); PG8_BAR; PG8_SCHED;
            PG8_LDB(B0, 1, 0); PG8_LDB(B1, 1, 1); PG8_SCHED; PG8_LDA(At, 1, 0); PG8_STAGE(PG8_SA(0, 1), a2 + hstepA, voffA);
            PG8_WAIT_V(8); PG8_WAIT_L(0); PG8_BAR; PG8_MMA(0, 0, At, B0); PG8_MMA(0, 1, At, B1); PG8_BAR; PG8_SCHED;
            PG8_LDA(At, 1, 1); PG8_STAGE(PG8_SB(1, 0), b3, voffB); PG8_STAGE(PG8_SB(1, 1), b3 + hstepB, voffB); PG8_STAGE(PG8_SA(1, 0), a3, voffA);
            PG8_WAIT_V(8); PG8_WAIT_L(0); PG8_BAR; PG8_MMA(1, 0, At, B0); PG8_MMA(1, 1, At, B1); PG8_BAR; PG8_SCHED;
        }
        if constexpr (ALIGN_EPI) { if (wr == 0) PG8_BAR; }
        if constexpr (!Epi::AFTER_DRAIN) { E(acc, cur, ui, wr, wc, fr, fq); }
        if (!has_next) break;
#pragma unroll
        for (int a = 0; a < 2; ++a)
#pragma unroll
            for (int b = 0; b < 2; ++b)
#pragma unroll
                for (int m = 0; m < 4; ++m)
#pragma unroll
                    for (int n = 0; n < 2; ++n) acc[a][b][m][n] = (f32x4){0.f, 0.f, 0.f, 0.f};
        cur = nxt; cA = nA; cB = nB; ++ui;
        if constexpr (ALIGN_EPI) { if (wr == 1) PG8_BAR; }
    }
    PG8_WAIT_V(0);
    if constexpr (!ALIGN_EPI) { if (wr == 0) PG8_BAR; }
    PG8_BAR;
    if constexpr (Epi::AFTER_DRAIN) { E.fused(acc, cur, wr, wc, fr, fq, lds, wid, lane); }
#undef PG8_SA
#undef PG8_SB
#undef PG8_STAGE
#undef PG8_LDA
#undef PG8_LDB
#undef PG8_MMA
#undef PG8_WAIT_V
#undef PG8_WAIT_L
#undef PG8_BAR
#undef PG8_SCHED
}
}

#define XB_TMO      128
#define XB_XCNT(j)  (256  + 64 * (j))
#define XB_XSUB(j)  (1280 + 64 * (j))
#define XB_XGEN(j)  (2304 + 64 * (j))
#define XB_TOP      3328
#define XB_TOPGEN   3392
#define XCD_BAR_WORDS 3456
#define XB_SPIN_CAP (1u << 20)
__device__ __forceinline__ unsigned xb_ld(unsigned* p)              { return __hip_atomic_load(p, __ATOMIC_RELAXED, __HIP_MEMORY_SCOPE_AGENT); }
__device__ __forceinline__ unsigned xb_add(unsigned* p, unsigned v) { return __hip_atomic_fetch_add(p, v, __ATOMIC_RELAXED, __HIP_MEMORY_SCOPE_AGENT); }
__device__ __forceinline__ unsigned xb_xcc_id() { return (unsigned)__builtin_amdgcn_s_getreg((3 << 11) | 20) & 0xFu; }
#define XB_SPIN(cond, bar) do { unsigned _sp = 0; while (cond) { __builtin_amdgcn_s_sleep(1); \
    if ((++_sp & 255u) == 0u) { if (xb_ld(&(bar)[XB_TMO])) break; if (_sp > XB_SPIN_CAP) { atomicAdd(&(bar)[XB_TMO], 1u); break; } } } } while (0)
__device__ __forceinline__ void xcd_barrier_complete(unsigned* bar, unsigned x, unsigned G, unsigned& nloc, unsigned& nx) {
    unsigned sum, cnt, mine, sp = 0u;
    for (;;) {
        sum = 0u; cnt = 0u; mine = 0u;
#pragma unroll
        for (unsigned j = 0; j < 16; ++j) { const unsigned c = xb_ld(&bar[XB_XCNT(j)]); sum += c; cnt += (c > 0u) ? 1u : 0u; mine = (j == x) ? c : mine; }
        if (sum == G) break;
        __builtin_amdgcn_s_sleep(1);
        if ((++sp & 255u) == 0u) { if (xb_ld(&bar[XB_TMO])) break; if (sp > XB_SPIN_CAP) { atomicAdd(&bar[XB_TMO], 1u); break; } }
    }
    nloc = mine > 0u ? mine : 1u; nx = cnt > 0u ? cnt : 1u;
}
__device__ __forceinline__ void xcd_barrier(unsigned* bar, volatile LAS unsigned* st, bool leader_thread, unsigned G) {
    asm volatile("s_waitcnt vmcnt(0)" ::: "memory");
    __syncthreads();
    if (leader_thread) {
        const unsigned x = xb_xcc_id();
        __builtin_amdgcn_s_waitcnt(0);
        unsigned nloc = st[0], nx = st[1];
        if (nloc == 0u) { xcd_barrier_complete(bar, x, G, nloc, nx); st[0] = nloc; st[1] = nx; }
        const unsigned old = xb_add(&bar[XB_XSUB(x)], 1u);
        const unsigned gen = old / nloc;
        if (old + 1u == (gen + 1u) * nloc) {
            __builtin_amdgcn_fence(__ATOMIC_RELEASE, "agent");
            asm volatile("s_waitcnt vmcnt(0)" ::: "memory");
            const unsigned og = xb_add(&bar[XB_TOP], 1u);
            const unsigned tg = og / nx;
            if (og + 1u == (tg + 1u) * nx) xb_add(&bar[XB_TOPGEN], 1u);
            else XB_SPIN(xb_ld(&bar[XB_TOPGEN]) == tg, bar);
            __builtin_amdgcn_fence(__ATOMIC_ACQUIRE, "agent");
            xb_add(&bar[XB_XGEN(x)], 1u);
            asm volatile("s_waitcnt vmcnt(0)" ::: "memory");
        } else {
            XB_SPIN(xb_ld(&bar[XB_XGEN(x)]) == gen, bar);
            __builtin_amdgcn_fence(__ATOMIC_ACQUIRE, "agent");
            asm volatile("s_waitcnt vmcnt(0)" ::: "memory");
        }
    }
    __syncthreads();
}

struct Args {
    const float* x; const float* p; const float* w_in; const float* w_out; const float* cmp_pos; const float* cmp_w1; const float* cmp_w2; const float* hg_lb;
    const float* g_pre_mix; const float* g_post_mix; const float* g_pre_mlp; const float* g_post_mlp; const float* w_up; const float* w_down; const float* g_ple;
    const float* w_ple_gate; const float* w_ple_proj;
    float* out; unsigned char* ws; int ph_lo, ph_hi;
};

struct Frame {
    LAS unsigned char* lds;
    int tid, lane, wave, G, bid;
    unsigned char* ws;
};

template <class T> __device__ __forceinline__ T* uptr(T* p) {
    const unsigned long long v = (unsigned long long)p; const unsigned lo = __builtin_amdgcn_readfirstlane((unsigned)v), hi = __builtin_amdgcn_readfirstlane((unsigned)(v >> 32));
    return (T*)(__attribute__((address_space(1))) T*)(((unsigned long long)hi << 32) | lo);
}
__device__ __forceinline__ Frame make_frame(LAS unsigned char* lds, Args& A) {
    Frame G; G.lds = lds;
    int lane; asm volatile("v_mbcnt_lo_u32_b32 %0, -1, 0\n\tv_mbcnt_hi_u32_b32 %0, -1, %0" : "=v"(lane));
    const unsigned hw = (unsigned)__builtin_amdgcn_s_getreg((5 << 11) | 4) & 63u;
    unsigned aoff = LDS_ARGS; asm volatile("" : "+v"(aoff));
    int wave = (int)((const LAS unsigned*)(lds + aoff + (LDS_WTAB - LDS_ARGS)))[hw];
    wave = __builtin_amdgcn_readfirstlane(wave);
    asm volatile("" : "+s"(wave));
    G.lane = lane; G.wave = wave; G.tid = wave * 64 + lane;
    int bid = blockIdx.x, gg = gridDim.x; asm volatile("" : "+s"(bid), "+s"(gg));
    G.bid = bid; G.G = gg;
    const LAS Args* la = (const LAS Args*)(lds + aoff);
    A.x = uptr(la->x); A.p = uptr(la->p); A.w_in = uptr(la->w_in); A.w_out = uptr(la->w_out); A.cmp_pos = uptr(la->cmp_pos); A.cmp_w1 = uptr(la->cmp_w1); A.cmp_w2 = uptr(la->cmp_w2);
    A.hg_lb = uptr(la->hg_lb); A.g_pre_mix = uptr(la->g_pre_mix); A.g_post_mix = uptr(la->g_post_mix); A.g_pre_mlp = uptr(la->g_pre_mlp); A.g_post_mlp = uptr(la->g_post_mlp);
    A.w_up = uptr(la->w_up); A.w_down = uptr(la->w_down); A.g_ple = uptr(la->g_ple); A.w_ple_gate = uptr(la->w_ple_gate); A.w_ple_proj = uptr(la->w_ple_proj);
    A.out = uptr(la->out); A.ws = uptr(la->ws); A.ph_lo = 0; A.ph_hi = 0;
    G.ws = A.ws;
    return G;
}
template <class Sched> __device__ __forceinline__ void fill_rstd(const Frame& F, const float* ss, const Sched& S) {
    LAS float* tab = (LAS float*)(F.lds + LDS_RSTD);
    const int half = F.tid >> 8, r = F.tid & 255;
#pragma unroll 1
    for (int i0 = 0; i0 < 8; i0 += 2) {
        pg8::Unit u; if (!S.next(i0 + half, u)) continue;
        tab[(i0 + half) * 256 + r] = pg8::row_rstd16(ss, (long)u.pm * 256 + r);
    }
    __syncthreads();
}
__device__ __forceinline__ void transpose_item(const float* W, int ldw, int col0, int k0, bf16_t* WT, int ldk, int drow0, const float* gsc, int lane) {
    float v[64];
    const float* src = W + (size_t)k0 * ldw + col0 + lane;
#pragma unroll
    for (int k = 0; k < 64; ++k) v[k] = src[(size_t)k * ldw];
    if (gsc) {
#pragma unroll
        for (int k = 0; k < 64; ++k) v[k] *= gsc[k0 + k];
    }
    bf16_t* dst = WT + (size_t)(drow0 + lane) * ldk + k0;
#pragma unroll
    for (int c = 0; c < 8; ++c) { u32x4 o; o.x = pk2(v[8 * c], v[8 * c + 1]); o.y = pk2(v[8 * c + 2], v[8 * c + 3]); o.z = pk2(v[8 * c + 4], v[8 * c + 5]); o.w = pk2(v[8 * c + 6], v[8 * c + 7]); *(u32x4*)(dst + 8 * c) = o; }
}

__device__ __forceinline__ void phase_prologue(const Frame& F, const Args& a) {
    const int gw = F.bid * 8 + F.wave, NGW = F.G * 8;
    {
        constexpr int I_IN1 = 16 * 18, I_IN2 = 16 * 34, I_OUT = 16 * 16, I_UP = 16 * 64, I_DN = 64 * 16, I_G = 16 * 16, I_PJ = 4 * 16, I_C1 = 32 * 4;
        constexpr int I_LAYER = I_IN1 + I_IN2 + I_OUT + I_UP + I_DN + I_G + I_PJ + 2 * I_C1;
        for (int it = gw; it < DEPTH * I_LAYER; it += NGW) {
            const int l = it / I_LAYER; int r = it % I_LAYER;
            const float* W; int ldw, col0, K; bf16_t* WT; int drow0; const float* gsc = nullptr;
            if (r < I_IN1) { W = a.w_in + (size_t)l * DM * IN_TOTAL; ldw = IN_TOTAL; col0 = 0; K = DM; WT = (bf16_t*)(F.ws + WS_WIN) + (size_t)l * NPROJ * DM; drow0 = 0; gsc = a.g_pre_mix + l * DM; }
            else if ((r -= I_IN1) < I_IN2) { W = a.w_in + (size_t)l * DM * IN_TOTAL; ldw = IN_TOTAL; col0 = 1170; K = DM; WT = (bf16_t*)(F.ws + WS_WIN) + (size_t)l * NPROJ * DM; drow0 = 1152; gsc = a.g_pre_mix + l * DM; }
            else if ((r -= I_IN2) < I_OUT) { W = a.w_out + (size_t)l * DM * DM; ldw = DM; col0 = 0; K = DM; WT = (bf16_t*)(F.ws + WS_WOUT) + (size_t)l * DM * DM; drow0 = 0; }
            else if ((r -= I_OUT) < I_UP) { W = a.w_up + (size_t)l * DM * FF; ldw = FF; col0 = 0; K = DM; WT = (bf16_t*)(F.ws + WS_WUP) + (size_t)l * FF * DM; drow0 = 0; gsc = a.g_pre_mlp + l * DM; }
            else if ((r -= I_UP) < I_DN) { W = a.w_down + (size_t)l * FF * DM; ldw = DM; col0 = 0; K = FF; WT = (bf16_t*)(F.ws + WS_WDN) + (size_t)l * DM * FF; drow0 = 0; }
            else if ((r -= I_DN) < I_G) { W = a.w_ple_gate + (size_t)l * DM * DM; ldw = DM; col0 = 0; K = DM; WT = (bf16_t*)(F.ws + WS_WG) + (size_t)l * DM * DM; drow0 = 0; gsc = a.g_ple + l * DM; }
            else if ((r -= I_G) < I_PJ) { W = a.w_ple_proj + (size_t)l * PLE * DM; ldw = DM; col0 = 0; K = PLE; WT = (bf16_t*)(F.ws + WS_WPJ) + (size_t)l * DM * PLE; drow0 = 0; }
            else { r -= I_PJ; const int kv = r / I_C1; r -= kv * I_C1; W = a.cmp_w1 + (size_t)(l * 2 + kv) * 2048 * 256; ldw = 256; col0 = 0; K = 2048; WT = (bf16_t*)(F.ws + WS_W1T) + (size_t)(l * 2 + kv) * 256 * 2048; drow0 = 0; }
            const int nk = K / 64, nb = r / nk, kb = r % nk;
            transpose_item(W, ldw, col0 + 64 * nb, 64 * kb, WT, K, drow0 + 64 * nb, gsc, F.lane);
        }
    }
    for (int l = 0; l < DEPTH; ++l) {
        bf16_t* WIN = (bf16_t*)(F.ws + WS_WIN) + (size_t)l * NPROJ * DM;
        const float* win = a.w_in + (size_t)l * DM * IN_TOTAL; const float* gs = a.g_pre_mix + l * DM;
        for (int idx = F.bid * 512 + F.tid; idx < 256 * DM; idx += F.G * 512) {
            const int r = idx >> 10, k = idx & 1023;
            float v = 0.f; if (r < 18) v = win[(size_t)k * IN_TOTAL + 1152 + r] * gs[k];
            WIN[(size_t)(3328 + r) * DM + k] = (bf16_t)f2bf(v);
        }
    }
    {
        bf16_t* HBB = (bf16_t*)a.out; float* SSB = (float*)(F.ws + WS_SSB);
        for (int m = gw * 2; m < MTOK; m += NGW * 2) {
            const f32x4* xr = (const f32x4*)(a.x + (size_t)m * DM) + F.lane;
            f32x4 v[8]; float s0 = 0.f, s1 = 0.f;
#pragma unroll
            for (int j = 0; j < 8; ++j) v[j] = xr[64 * j];
#pragma unroll
            for (int j = 0; j < 4; ++j) { s0 += (v[j].x * v[j].x + v[j].y * v[j].y) + (v[j].z * v[j].z + v[j].w * v[j].w); s1 += (v[j + 4].x * v[j + 4].x + v[j + 4].y * v[j + 4].y) + (v[j + 4].z * v[j + 4].z + v[j + 4].w * v[j + 4].w); }
            s0 = wave_sum(s0); s1 = wave_sum(s1);
            unsigned long long* o8 = (unsigned long long*)(HBB + (size_t)m * DM) + F.lane;
#pragma unroll
            for (int j = 0; j < 8; ++j) o8[64 * j] = (unsigned long long)pk2(v[j].x, v[j].y) | ((unsigned long long)pk2(v[j].z, v[j].w) << 32);
            if (F.lane < 32) SSB[(size_t)m * 16 + F.lane] = (F.lane == 0) ? s0 : ((F.lane == 16) ? s1 : 0.f);
        }
    }
    {
        float* part = (float*)(F.ws + WS_B1P);
        for (int it = gw; it < 4 * 16 * 4; it += NGW) {
            const int jb = it & 3, c = (it >> 2) & 15, lk = it >> 6;
            const float* pos = a.cmp_pos + (size_t)lk * 2048; const float* w1 = a.cmp_w1 + (size_t)lk * 2048 * 256;
            const int j = jb * 64 + F.lane; float s = 0.f;
#pragma unroll 32
            for (int k = c * 128; k < c * 128 + 128; ++k) s += pos[k] * w1[(size_t)k * 256 + j];
            part[(size_t)(lk * 16 + c) * 256 + j] = s;
        }
    }
}

__device__ __forceinline__ void reduce_bias1(const Frame& F) {
    if (F.bid != 0) return;
    const float* part = (const float*)(F.ws + WS_B1P); float* fin = (float*)(F.ws + WS_B1P + 65536);
    for (int idx = F.tid; idx < 4 * 256; idx += 512) { const int lk = idx >> 8, j = idx & 255; float s = 0.f;
        for (int c = 0; c < 16; ++c) s += part[(size_t)(lk * 16 + c) * 256 + j];
        fin[idx] = s; }
}

__device__ __forceinline__ void convert_p(const Frame& F, const Args& a, int l) {
    const float* src = a.p + (size_t)l * MTOK * PLE; bf16_t* PB = (bf16_t*)(F.ws + WS_PB);
    const size_t n8 = (size_t)MTOK * PLE / 8;
    for (size_t i = (size_t)F.bid * 512 + F.tid; i < n8; i += (size_t)F.G * 512) {
        const f32x4 v0 = *(const f32x4*)(src + i * 8), v1 = *(const f32x4*)(src + i * 8 + 4);
        u32x4 w; w.x = pk2(v0.x, v0.y); w.y = pk2(v0.z, v0.w); w.z = pk2(v1.x, v1.y); w.w = pk2(v1.z, v1.w);
        *(u32x4*)(PB + i * 8) = w;
    }
}

__device__ __forceinline__ void load64(const bf16_t* p, float (&v)[64], float sc) {
    const u32x4* p4 = (const u32x4*)p;
#pragma unroll
    for (int i = 0; i < 8; ++i) { const u32x4 w = p4[i];
        v[8 * i + 0] = bf_lo(w.x) * sc; v[8 * i + 1] = bf_hi(w.x) * sc; v[8 * i + 2] = bf_lo(w.y) * sc; v[8 * i + 3] = bf_hi(w.y) * sc;
        v[8 * i + 4] = bf_lo(w.z) * sc; v[8 * i + 5] = bf_hi(w.z) * sc; v[8 * i + 6] = bf_lo(w.w) * sc; v[8 * i + 7] = bf_hi(w.w) * sc; }
}
__device__ __forceinline__ void stage_bf16(LAS float* dst, const bf16_t* src, int ld, int tid) {
    const int r = tid >> 3, c = tid & 7;
    const u32x4 w = *(const u32x4*)(src + (size_t)r * ld + c * 8);
    const f32x4 v0 = {bf_lo(w.x), bf_hi(w.x), bf_lo(w.y), bf_hi(w.y)}, v1 = {bf_lo(w.z), bf_hi(w.z), bf_lo(w.w), bf_hi(w.w)};
    *(LAS f32x4*)(dst + r * 64 + c * 8) = v0; *(LAS f32x4*)(dst + r * 64 + c * 8 + 4) = v1;
}
__device__ __forceinline__ void stage_f32(LAS float* dst, const float* src, int tid) {
    const int r = tid >> 3, c = tid & 7;
    const f32x4 v0 = *(const f32x4*)(src + r * 64 + c * 8), v1 = *(const f32x4*)(src + r * 64 + c * 8 + 4);
    *(LAS f32x4*)(dst + r * 64 + c * 8) = v0; *(LAS f32x4*)(dst + r * 64 + c * 8 + 4) = v1;
}
__device__ __forceinline__ float dot64(const LAS float* kr, const float (&q)[64]) {
    float s0 = 0.f, s1 = 0.f, s2 = 0.f, s3 = 0.f;
#pragma unroll
    for (int d = 0; d < 64; d += 4) { const f32x4 kv = *(const LAS f32x4*)(kr + d); s0 += q[d] * kv.x; s1 += q[d + 1] * kv.y; s2 += q[d + 2] * kv.z; s3 += q[d + 3] * kv.w; }
    return (s0 + s1) + (s2 + s3);
}
template <class FN>
__device__ __forceinline__ void attend64(const LAS float* Kt, const LAS float* Vt, const float (&q)[64], float (&o)[64], float& m, float& l, FN fn) {
#pragma unroll 1
    for (int j = 0; j < 64; ++j) {
        float bias; if (!fn(j, bias)) continue;
        const float s = dot64(Kt + j * 64, q) + bias;
        if (s > m) { const float c = __expf(m - s); l *= c;
#pragma unroll
            for (int d = 0; d < 64; ++d) o[d] *= c;
            m = s; }
        const float pr = __expf(s - m); l += pr;
#pragma unroll
        for (int d = 0; d < 64; d += 4) { const f32x4 vv = *(const LAS f32x4*)(Vt + j * 64 + d); o[d] += pr * vv.x; o[d + 1] += pr * vv.y; o[d + 2] += pr * vv.z; o[d + 3] += pr * vv.w; }
    }
}
__device__ __forceinline__ float nsa_slope(int h) {
    const int idx = (h >> 1) * 4 + 2 + (h & 1);
    return exp2f(-2.0f * (float)(idx + 1) / 3.0f);
}
__device__ __forceinline__ float dil_slope(int h) {
    const int idx = (h >> 1) * 4 + (h & 1);
    return exp2f(-2.0f * (float)(idx + 1) / 3.0f);
}

namespace att {
typedef short bf16x8 __attribute__((ext_vector_type(8)));
typedef short v4i16 __attribute__((ext_vector_type(4)));
typedef __bf16 bf16x2_t __attribute__((ext_vector_type(2)));
constexpr float NEG = -1e30f, MFLOOR = -1e20f, LOG2E = 1.4426950408889634f, LN2 = 0.6931471805599453f;
constexpr int TILE_BYTES = 8192;
__device__ __forceinline__ int k_off(int row, int ch) { return row * 128 + ((ch ^ ((row >> 1) & 7)) << 4); }
__device__ __forceinline__ int v_off(int row, int byte) { return row * 128 + (byte ^ (((row >> 1) & 3) << 5)); }
__device__ __forceinline__ unsigned cvtpk(float lo, float hi) { f32x2 v = {lo, hi}; bf16x2_t b = __builtin_convertvector(v, bf16x2_t); return __builtin_bit_cast(unsigned, b); }

template <int NH> struct State { f32x4 O[NH][4]; float m[NH], l[NH]; };
template <int NH> __device__ __forceinline__ void state_reset(State<NH>& st, float m0 = MFLOOR) {
#pragma unroll
    for (int g = 0; g < NH; ++g) { st.m[g] = m0; st.l[g] = 0.f;
#pragma unroll
        for (int nt = 0; nt < 4; ++nt) st.O[g][nt] = (f32x4){0.f, 0.f, 0.f, 0.f}; }
}
struct Lane { int c, grp; int kb0, kb1; int vb[4]; };
__device__ __forceinline__ Lane make_lane(int lane) {
    Lane L; L.c = lane & 15; L.grp = lane >> 4;
    L.kb0 = k_off(L.c, L.grp); L.kb1 = k_off(L.c, 4 + L.grp);
    const int i = L.c, sw = ((L.grp & 1) << 1) | (i >> 3);
#pragma unroll
    for (int nt = 0; nt < 4; ++nt) L.vb[nt] = (4 * L.grp + (i >> 2)) * 128 + ((32 * nt + 8 * (i & 3)) ^ (sw << 5));
    return L;
}
struct StageRegs { u32x4 k, v; };
__device__ __forceinline__ void stage_load(StageRegs& r, const bf16_t* srcK, const bf16_t* srcV, long ld, int tid) {
    const int R = tid >> 3, ch = tid & 7;
    r.k = *(const u32x4*)(srcK + (size_t)R * ld + ch * 8); r.v = *(const u32x4*)(srcV + (size_t)R * ld + ch * 8);
}
__device__ __forceinline__ void stage_store(const StageRegs& r, LAS unsigned char* Kt, LAS unsigned char* Vt, int tid) {
    const int R = tid >> 3, ch = tid & 7;
    *(LAS u32x4*)(Kt + k_off(R, ch)) = r.k; *(LAS u32x4*)(Vt + v_off(R, ch * 16)) = r.v;
}
template <int NH> __device__ __forceinline__ void scores(const LAS unsigned char* Kt, const Lane& L, const bf16x8 (&qf)[NH][2], const float (&slope)[NH], float brel, f32x4 (&S)[NH][4]) {
#pragma unroll
    for (int g = 0; g < NH; ++g) { const float sb = slope[g] * brel;
#pragma unroll
        for (int kt = 0; kt < 4; ++kt)
#pragma unroll
            for (int r = 0; r < 4; ++r) S[g][kt][r] = __builtin_fmaf(slope[g], (float)(16 * kt + r), sb); }
#pragma unroll
    for (int kt = 0; kt < 4; ++kt) {
        const bf16x8 k0 = *(const LAS bf16x8*)(Kt + L.kb0 + kt * 2048), k1 = *(const LAS bf16x8*)(Kt + L.kb1 + kt * 2048);
#pragma unroll
        for (int g = 0; g < NH; ++g) {
            S[g][kt] = __builtin_amdgcn_mfma_f32_16x16x32_bf16(k0, qf[g][0], S[g][kt], 0, 0, 0);
            S[g][kt] = __builtin_amdgcn_mfma_f32_16x16x32_bf16(k1, qf[g][1], S[g][kt], 0, 0, 0);
        }
    }
}
template <int NH> __device__ __forceinline__ void scores_lds(const LAS unsigned char* Kt, const Lane& L, const LAS unsigned char* qlds, int lane, const float (&slope)[NH], float brel, f32x4 (&S)[NH][4]) {
    bf16x8 kf[4][2];
#pragma unroll
    for (int kt = 0; kt < 4; ++kt) { kf[kt][0] = *(const LAS bf16x8*)(Kt + L.kb0 + kt * 2048); kf[kt][1] = *(const LAS bf16x8*)(Kt + L.kb1 + kt * 2048); }
#pragma unroll
    for (int g = 0; g < NH; ++g) {
        const bf16x8 q0 = *(const LAS bf16x8*)(qlds + ((g * 2 + 0) * 64 + lane) * 16), q1 = *(const LAS bf16x8*)(qlds + ((g * 2 + 1) * 64 + lane) * 16);
        const float sb = slope[g] * brel;
#pragma unroll
        for (int kt = 0; kt < 4; ++kt) {
#pragma unroll
            for (int r = 0; r < 4; ++r) S[g][kt][r] = __builtin_fmaf(slope[g], (float)(16 * kt + r), sb);
            S[g][kt] = __builtin_amdgcn_mfma_f32_16x16x32_bf16(kf[kt][0], q0, S[g][kt], 0, 0, 0);
            S[g][kt] = __builtin_amdgcn_mfma_f32_16x16x32_bf16(kf[kt][1], q1, S[g][kt], 0, 0, 0);
        }
    }
}
template <int NH> __device__ __forceinline__ void mask(f32x4 (&S)[NH][4], int drel, int dlo, bool row_on) {
#pragma unroll
    for (int kt = 0; kt < 4; ++kt)
#pragma unroll
        for (int r = 0; r < 4; ++r) { const int dl = drel + 16 * kt + r; const bool ok = row_on && dl <= 0 && dl >= dlo;
#pragma unroll
            for (int g = 0; g < NH; ++g) S[g][kt][r] = ok ? S[g][kt][r] : NEG; }
}
template <int NH> __device__ __forceinline__ void online(f32x4 (&S)[NH][4], State<NH>& st) {
#pragma unroll
    for (int g = 0; g < NH; ++g) {
        float mx = fmaxf(fmaxf(S[g][0][0], S[g][0][1]), fmaxf(S[g][0][2], S[g][0][3]));
#pragma unroll
        for (int kt = 1; kt < 4; ++kt) mx = fmaxf(mx, fmaxf(fmaxf(S[g][kt][0], S[g][kt][1]), fmaxf(S[g][kt][2], S[g][kt][3])));
        mx = fmaxf(mx, x16f(mx)); mx = fmaxf(mx, x32f(mx));
        const float mnew = fmaxf(st.m[g], mx);
        const float alpha = __builtin_amdgcn_exp2f(st.m[g] - mnew);
        st.m[g] = mnew; st.l[g] *= alpha;
#pragma unroll
        for (int nt = 0; nt < 4; ++nt) st.O[g][nt] = st.O[g][nt] * alpha;
        float ls = 0.f;
#pragma unroll
        for (int kt = 0; kt < 4; ++kt)
#pragma unroll
            for (int r = 0; r < 4; ++r) { const float pr = __builtin_amdgcn_exp2f(S[g][kt][r] - mnew); S[g][kt][r] = pr; ls += pr; }
        st.l[g] += ls;
    }
}
template <int NH> __device__ __forceinline__ void pv(const LAS unsigned char* Vt, const Lane& L, const f32x4 (&P)[NH][4], State<NH>& st) {
#pragma unroll
    for (int s2 = 0; s2 < 2; ++s2) {
        bf16x8 pf[NH];
#pragma unroll
        for (int g = 0; g < NH; ++g) { u32x4 w; w.x = cvtpk(P[g][2 * s2][0], P[g][2 * s2][1]); w.y = cvtpk(P[g][2 * s2][2], P[g][2 * s2][3]);
            w.z = cvtpk(P[g][2 * s2 + 1][0], P[g][2 * s2 + 1][1]); w.w = cvtpk(P[g][2 * s2 + 1][2], P[g][2 * s2 + 1][3]); pf[g] = __builtin_bit_cast(bf16x8, w); }
#pragma unroll
        for (int nt = 0; nt < 4; ++nt) {
            const v4i16 lo = __builtin_amdgcn_ds_read_tr16_b64_v4i16((LAS v4i16*)(Vt + L.vb[nt] + 4096 * s2));
            const v4i16 hi = __builtin_amdgcn_ds_read_tr16_b64_v4i16((LAS v4i16*)(Vt + L.vb[nt] + 4096 * s2 + 2048));
            const bf16x8 vf = {lo[0], lo[1], lo[2], lo[3], hi[0], hi[1], hi[2], hi[3]};
#pragma unroll
            for (int g = 0; g < NH; ++g) st.O[g][nt] = __builtin_amdgcn_mfma_f32_16x16x32_bf16(vf, pf[g], st.O[g][nt], 0, 0, 0);
        }
    }
}
constexpr float BIGD = 1e30f, RTHR = 8.0f;
template <int NH, int MODE> __device__ __forceinline__ void tile_heads(const LAS unsigned char* Kt, const LAS unsigned char* Vt, const Lane& L, const LAS unsigned char* qlds, int lane,
        const float (&slope)[NH], float brel, int drel, int dlo, bool row_on, bool need_mask, State<NH>& st, const float (&mfix)[NH], const float (&ilfix)[NH], float (&impm)[4], float (&impn)[4]) {
    f32x4 S[NH][4];
    {
        f32x4 dm[4];
#pragma unroll
        for (int kt = 0; kt < 4; ++kt)
#pragma unroll
            for (int r = 0; r < 4; ++r) dm[kt][r] = brel + (float)(16 * kt + r);
        if (need_mask) {
#pragma unroll
            for (int kt = 0; kt < 4; ++kt)
#pragma unroll
                for (int r = 0; r < 4; ++r) { const int dl = drel + 16 * kt + r; dm[kt][r] = (row_on && dl <= 0 && dl >= dlo) ? dm[kt][r] : -BIGD; }
        }
        bf16x8 kf[4][2];
#pragma unroll
        for (int kt = 0; kt < 4; ++kt) { kf[kt][0] = *(const LAS bf16x8*)(Kt + L.kb0 + kt * 2048); kf[kt][1] = *(const LAS bf16x8*)(Kt + L.kb1 + kt * 2048); }
        __builtin_amdgcn_s_setprio(1);
#pragma unroll
        for (int g = 0; g < NH; ++g) {
            const bf16x8 q0 = *(const LAS bf16x8*)(qlds + ((g * 2 + 0) * 64 + lane) * 16), q1 = *(const LAS bf16x8*)(qlds + ((g * 2 + 1) * 64 + lane) * 16);
            float mref = st.m[g]; asm volatile("" : "+v"(mref));
#pragma unroll
            for (int kt = 0; kt < 4; ++kt) {
                S[g][kt] = (MODE == 0) ? dm[kt] * slope[g] - mref : dm[kt] * slope[g];
                S[g][kt] = __builtin_amdgcn_mfma_f32_16x16x32_bf16(kf[kt][0], q0, S[g][kt], 0, 0, 0);
                S[g][kt] = __builtin_amdgcn_mfma_f32_16x16x32_bf16(kf[kt][1], q1, S[g][kt], 0, 0, 0);
            }
        }
        __builtin_amdgcn_s_setprio(0);
    }
    bf16x8 pf[NH][2];
#pragma unroll
    for (int g = 0; g < NH; ++g) {
        if (MODE == 2) {
#pragma unroll
            for (int kt = 0; kt < 4; ++kt) {
#pragma unroll
                for (int r = 0; r < 4; ++r) S[g][kt][r] = __builtin_amdgcn_exp2f(S[g][kt][r] - mfix[g]) * ilfix[g];
                impm[kt] += (S[g][kt][0] + S[g][kt][1]) + (S[g][kt][2] + S[g][kt][3]); impn[kt] += S[g][kt][3];
            }
        } else if (MODE == 0) {
            float mg = st.m[g], lg = st.l[g];
            float ls = 0.f; u32x4 w0, w1;
#define TH_EXPPACK(dl_) do { float p_[4][4]; ls = 0.f; \
                _Pragma("unroll") for (int kt = 0; kt < 4; ++kt) _Pragma("unroll") for (int r = 0; r < 4; ++r) { p_[kt][r] = __builtin_amdgcn_exp2f(S[g][kt][r] - (dl_)); ls += p_[kt][r]; } \
                w0.x = cvtpk(p_[0][0], p_[0][1]); w0.y = cvtpk(p_[0][2], p_[0][3]); w0.z = cvtpk(p_[1][0], p_[1][1]); w0.w = cvtpk(p_[1][2], p_[1][3]); \
                w1.x = cvtpk(p_[2][0], p_[2][1]); w1.y = cvtpk(p_[2][2], p_[2][3]); w1.z = cvtpk(p_[3][0], p_[3][1]); w1.w = cvtpk(p_[3][2], p_[3][3]); } while (0)
            {   float p_[4][4];
#pragma unroll
                for (int kt = 0; kt < 4; ++kt)
#pragma unroll
                    for (int r = 0; r < 4; ++r) { p_[kt][r] = __builtin_amdgcn_exp2f(S[g][kt][r]); ls += p_[kt][r]; }
                w0.x = cvtpk(p_[0][0], p_[0][1]); w0.y = cvtpk(p_[0][2], p_[0][3]); w0.z = cvtpk(p_[1][0], p_[1][1]); w0.w = cvtpk(p_[1][2], p_[1][3]);
                w1.x = cvtpk(p_[2][0], p_[2][1]); w1.y = cvtpk(p_[2][2], p_[2][3]); w1.z = cvtpk(p_[3][0], p_[3][1]); w1.w = cvtpk(p_[3][2], p_[3][3]); }
            if (__builtin_expect(__any(!(ls < 4096.f)), 0)) {
                float mx = __builtin_fmaxf(__builtin_fmaxf(S[g][0][0], S[g][0][1]), S[g][0][2]);
                mx = __builtin_fmaxf(__builtin_fmaxf(mx, S[g][0][3]), S[g][1][0]); mx = __builtin_fmaxf(__builtin_fmaxf(mx, S[g][1][1]), S[g][1][2]);
                mx = __builtin_fmaxf(__builtin_fmaxf(mx, S[g][1][3]), S[g][2][0]); mx = __builtin_fmaxf(__builtin_fmaxf(mx, S[g][2][1]), S[g][2][2]);
                mx = __builtin_fmaxf(__builtin_fmaxf(mx, S[g][2][3]), S[g][3][0]); mx = __builtin_fmaxf(__builtin_fmaxf(mx, S[g][3][1]), S[g][3][2]);
                mx = __builtin_fmaxf(mx, S[g][3][3]);
                mx = fmaxf(mx, x16f(mx)); mx = fmaxf(mx, x32f(mx));
                const float dl = fmaxf(mx, 0.f);
                const float alpha = __builtin_amdgcn_exp2f(-dl);
                mg += dl; lg *= alpha;
#pragma unroll
                for (int nt = 0; nt < 4; ++nt) st.O[g][nt] = st.O[g][nt] * alpha;
                TH_EXPPACK(dl);
            }
#undef TH_EXPPACK
            st.m[g] = mg; st.l[g] = lg + ls;
            pf[g][0] = __builtin_bit_cast(bf16x8, w0); pf[g][1] = __builtin_bit_cast(bf16x8, w1);
        } else {
            float mx = fmaxf(fmaxf(S[g][0][0], S[g][0][1]), fmaxf(S[g][0][2], S[g][0][3]));
#pragma unroll
            for (int kt = 1; kt < 4; ++kt) mx = fmaxf(mx, fmaxf(fmaxf(S[g][kt][0], S[g][kt][1]), fmaxf(S[g][kt][2], S[g][kt][3])));
            mx = fmaxf(mx, x16f(mx)); mx = fmaxf(mx, x32f(mx));
            const float mnew = fmaxf(st.m[g], mx);
            const float alpha = __builtin_amdgcn_exp2f(st.m[g] - mnew);
            st.m[g] = mnew; st.l[g] *= alpha;
            float ls = 0.f;
#pragma unroll
            for (int kt = 0; kt < 4; ++kt)
#pragma unroll
                for (int r = 0; r < 4; ++r) { const float pr = __builtin_amdgcn_exp2f(S[g][kt][r] - mnew); S[g][kt][r] = pr; ls += pr; }
            st.l[g] += ls;
        }
        if (MODE == 2) {
#pragma unroll
            for (int s2 = 0; s2 < 2; ++s2) {
                u32x4 wv; wv.x = cvtpk(S[g][2 * s2][0], S[g][2 * s2][1]); wv.y = cvtpk(S[g][2 * s2][2], S[g][2 * s2][3]); wv.z = cvtpk(S[g][2 * s2 + 1][0], S[g][2 * s2 + 1][1]); wv.w = cvtpk(S[g][2 * s2 + 1][2], S[g][2 * s2 + 1][3]);
                pf[g][s2] = __builtin_bit_cast(bf16x8, wv);
            }
        }
    }
    if (MODE != 1) {
        typedef int v2i __attribute__((ext_vector_type(2))); typedef int v4i __attribute__((ext_vector_type(4)));
        const unsigned vbase_ = (unsigned)(unsigned long)Vt;
        const unsigned va0 = vbase_ + L.vb[0], va1 = vbase_ + L.vb[1], va2 = vbase_ + L.vb[2], va3 = vbase_ + L.vb[3];
        v2i lo0, hi0, lo1, hi1;
#define TRRD(lo_, hi_, a_, o0_, o1_) asm volatile("ds_read_b64_tr_b16 %0, %2 offset:" #o0_ "\n\tds_read_b64_tr_b16 %1, %2 offset:" #o1_ : "=&v"(lo_), "=&v"(hi_) : "v"(a_) : "memory")
#define TRWAIT(n_, lo_, hi_) asm volatile("s_waitcnt lgkmcnt(" #n_ ")" : "+v"(lo_), "+v"(hi_))
#define TRPV(lo_, hi_, nt_, s2_) do { const v4i v4_ = {lo_[0], lo_[1], hi_[0], hi_[1]}; const bf16x8 vf_ = __builtin_bit_cast(bf16x8, v4_); \
            _Pragma("unroll") for (int g = 0; g < NH; ++g) st.O[g][nt_] = __builtin_amdgcn_mfma_f32_16x16x32_bf16(vf_, pf[g][s2_], st.O[g][nt_], 0, 0, 0); } while (0)
        __builtin_amdgcn_s_setprio(1);
        TRRD(lo0, hi0, va0, 0, 2048);
        TRRD(lo1, hi1, va1, 0, 2048);    TRWAIT(2, lo0, hi0); TRPV(lo0, hi0, 0, 0);
        TRRD(lo0, hi0, va2, 0, 2048);    TRWAIT(2, lo1, hi1); TRPV(lo1, hi1, 1, 0);
        TRRD(lo1, hi1, va3, 0, 2048);    TRWAIT(2, lo0, hi0); TRPV(lo0, hi0, 2, 0);
        TRRD(lo0, hi0, va0, 4096, 6144); TRWAIT(2, lo1, hi1); TRPV(lo1, hi1, 3, 0);
        TRRD(lo1, hi1, va1, 4096, 6144); TRWAIT(2, lo0, hi0); TRPV(lo0, hi0, 0, 1);
        TRRD(lo0, hi0, va2, 4096, 6144); TRWAIT(2, lo1, hi1); TRPV(lo1, hi1, 1, 1);
        TRRD(lo1, hi1, va3, 4096, 6144); TRWAIT(2, lo0, hi0); TRPV(lo0, hi0, 2, 1);
        TRWAIT(0, lo1, hi1); TRPV(lo1, hi1, 3, 1);
        __builtin_amdgcn_s_setprio(0);
#undef TRRD
#undef TRWAIT
#undef TRPV
    }
}
__device__ __forceinline__ void scale_q(const u32x4 (&qw)[2], float sc, bf16x8 (&qf)[2]) {
#pragma unroll
    for (int ks = 0; ks < 2; ++ks) { const u32x4 w = qw[ks]; u32x4 o;
        o.x = cvtpk(bf_lo(w.x) * sc, bf_hi(w.x) * sc); o.y = cvtpk(bf_lo(w.y) * sc, bf_hi(w.y) * sc); o.z = cvtpk(bf_lo(w.z) * sc, bf_hi(w.z) * sc); o.w = cvtpk(bf_lo(w.w) * sc, bf_hi(w.w) * sc);
        qf[ks] = __builtin_bit_cast(bf16x8, o); }
}
__device__ __forceinline__ void load_q(const bf16_t* qrow, int grp, float sc, bf16x8 (&qf)[2]) {
#pragma unroll
    for (int ks = 0; ks < 2; ++ks) { const u32x4 w = *(const u32x4*)(qrow + 32 * ks + 8 * grp); u32x4 o;
        o.x = cvtpk(bf_lo(w.x) * sc, bf_hi(w.x) * sc); o.y = cvtpk(bf_lo(w.y) * sc, bf_hi(w.y) * sc); o.z = cvtpk(bf_lo(w.z) * sc, bf_hi(w.z) * sc); o.w = cvtpk(bf_lo(w.w) * sc, bf_hi(w.w) * sc);
        qf[ks] = __builtin_bit_cast(bf16x8, o); }
}
}

struct DilUnit { int dd, rho, jb, hd, b, T0, nT; };
__device__ __forceinline__ DilUnit dil_decode(int unit) {
    DilUnit U; const int g3 = unit >> 9, rem = unit & 511; U.b = rem >> 5; const int hh = (rem >> 4) & 1;
    if (g3 == 0) { U.dd = 1; U.rho = 0; U.jb = rem & 15; } else if (g3 == 1) { U.dd = 4; U.rho = (rem >> 2) & 3; U.jb = rem & 3; } else { U.dd = 16; U.rho = rem & 15; U.jb = 0; }
    U.hd = 2 * g3 + hh;
    const int tau0 = 128 * U.jb; U.T0 = (tau0 >= 128) ? (tau0 >> 6) - 2 : 0; U.nT = (tau0 >> 6) + 2 - U.T0;
    return U;
}
struct DilStage { u32x4 k[4], v[4], q[2]; };
__device__ __forceinline__ void dil_load(DilStage& sr, const bf16_t* PROJ, const DilUnit& U, int tid) {
    const int R = tid >> 3, ch = tid & 7; const long ld = (long)U.dd * NPROJ;
    const bf16_t* kb = PROJ + (size_t)((long)U.b * SEQ + U.rho) * NPROJ + C_DK + U.hd * 64 + ch * 8; const bf16_t* vb = PROJ + (size_t)((long)U.b * SEQ + U.rho) * NPROJ + C_DV + U.hd * 64 + ch * 8;
#pragma unroll
    for (int i = 0; i < 4; ++i) if (i < U.nT) { const size_t off = (size_t)(64 * (U.T0 + i) + R) * ld; sr.k[i] = *(const u32x4*)(kb + off); sr.v[i] = *(const u32x4*)(vb + off); }
    {
        const int lane = tid & 63, w = tid >> 6; const long qrow = (long)U.b * SEQ + U.rho + (long)U.dd * (128 * U.jb + 16 * w + (lane & 15));
        const bf16_t* qp = PROJ + (size_t)qrow * NPROJ + C_DQ + U.hd * 64 + 8 * (lane >> 4);
        sr.q[0] = *(const u32x4*)(qp); sr.q[1] = *(const u32x4*)(qp + 32); }
}
__device__ __forceinline__ void dil_store(const DilStage& sr, LAS unsigned char* buf, const DilUnit& U, int tid) {
    const int R = tid >> 3, ch = tid & 7;
#pragma unroll
    for (int i = 0; i < 4; ++i) if (i < U.nT) { *(LAS u32x4*)(buf + i * 2 * att::TILE_BYTES + att::k_off(R, ch)) = sr.k[i]; *(LAS u32x4*)(buf + (i * 2 + 1) * att::TILE_BYTES + att::v_off(R, ch * 16)) = sr.v[i]; }
}
__device__ __forceinline__ void dil_compute(const Frame& F, const DilUnit& U, const LAS unsigned char* buf, const u32x4 (&qw)[2]) {
    const int lane = F.lane, w = F.wave;
    const bf16_t* PROJ = (const bf16_t*)(F.ws + WS_PROJ); bf16_t* MIX = (bf16_t*)(F.ws + WS_MIX); float* LSE = (float*)(F.ws + WS_LSE);
    const att::Lane L = att::make_lane(lane);
    const int tauw = 128 * U.jb + 16 * w, tau = tauw + L.c;
    const long row = (long)U.b * SEQ + U.rho + (long)U.dd * tau;
    att::bf16x8 qf[1][2];
    att::scale_q(qw, 0.125f * att::LOG2E, qf[0]);
    const float slope[1] = {dil_slope(U.hd) * (float)U.dd * att::LOG2E};
    att::State<1> st; att::state_reset(st);
#pragma unroll 1
    for (int i = 0; i < U.nT; ++i) {
        const int T = U.T0 + i;
        const LAS unsigned char* Kt = buf + i * 2 * att::TILE_BYTES; const LAS unsigned char* Vt = Kt + att::TILE_BYTES;
        const bool skip = (64 * T > tauw + 15) || (64 * T + 63 < tauw - 128);
        if (!skip) {
            const bool need_mask = !(64 * T + 63 <= tauw && 64 * T >= tauw + 15 - 128);
            const int drel = 64 * T + 4 * L.grp - tau;
            f32x4 S[1][4];
            att::scores<1>(Kt, L, qf, slope, (float)drel, S);
            if (need_mask) att::mask<1>(S, drel, -128, true);
            att::online<1>(S, st);
            att::pv<1>(Vt, L, S, st);
        }
    }
    float lt = st.l[0]; lt += x16f(lt); lt += x32f(lt);
    const float il = rcpf_(lt);
    bf16_t* orow = MIX + (size_t)row * DM + 384 + U.hd * 64 + 4 * L.grp;
#pragma unroll
    for (int nt = 0; nt < 4; ++nt) { const f32x4 o = st.O[0][nt] * il; u32x2 wv; wv.x = att::cvtpk(o[0], o[1]); wv.y = att::cvtpk(o[2], o[3]); *(u32x2*)(orow + 16 * nt) = wv; }
    if (L.grp == 0) LSE[(size_t)row * 8 + U.hd] = (st.m[0] + __log2f(lt)) * att::LN2;
}
__device__ __forceinline__ void dil_units(const Frame& F, int first, int stride) {
    const bf16_t* PROJ = (const bf16_t*)(F.ws + WS_PROJ);
    if (first >= 1536) return;
    DilStage sr;
    DilUnit U = dil_decode(first);
    dil_load(sr, PROJ, U, F.tid); dil_store(sr, F.lds, U, F.tid);
    u32x4 qc[2] = {sr.q[0], sr.q[1]};
    int cur = 0;
#pragma unroll 1
    for (int u = first; u < 1536; u += stride) {
        const bool has_next = u + stride < 1536;
        DilUnit Un = U;
        if (has_next) { Un = dil_decode(u + stride); dil_load(sr, PROJ, Un, F.tid); }
        __syncthreads();
        dil_compute(F, U, F.lds + cur * 65536, qc);
        if (has_next) { dil_store(sr, F.lds + (cur ^ 1) * 65536, Un, F.tid); qc[0] = sr.q[0]; qc[1] = sr.q[1]; }
        cur ^= 1; U = Un;
    }
    __syncthreads();
}
__device__ __forceinline__ void dil_fixup(const Frame& F) {
    bf16_t* MIX = (bf16_t*)(F.ws + WS_MIX); const float* LSE = (const float*)(F.ws + WS_LSE);
    for (int idx = F.bid * 512 + F.tid; idx < MTOK * 48; idx += F.G * 512) {
        const int ch = idx & 7, hd = (idx >> 3) % 6, row = idx / 48, hh = hd & 1, g3 = hd >> 1;
        const float l0 = LSE[(size_t)row * 8 + hh], l1 = LSE[(size_t)row * 8 + 2 + hh], l2 = LSE[(size_t)row * 8 + 4 + hh];
        const float mx = fmaxf(l0, fmaxf(l1, l2));
        const float e0 = __expf(l0 - mx), e1 = __expf(l1 - mx), e2 = __expf(l2 - mx);
        const float al = ((g3 == 0) ? e0 : ((g3 == 1) ? e1 : e2)) * rcpf_((e0 + e1) + e2);
        u32x4* p = (u32x4*)(MIX + (size_t)row * DM + 384 + hd * 64 + ch * 8);
        const u32x4 w = *p; u32x4 o;
        o.x = pk2(bf_lo(w.x) * al, bf_hi(w.x) * al); o.y = pk2(bf_lo(w.y) * al, bf_hi(w.y) * al); o.z = pk2(bf_lo(w.z) * al, bf_hi(w.z) * al); o.w = pk2(bf_lo(w.w) * al, bf_hi(w.w) * al);
        *p = o;
    }
}

struct NsaCtx { int tid, lane, w, t, tw; long row; att::Lane L; float slope[3]; };
__device__ __forceinline__ NsaCtx nsa_ctx(const Frame& F, int b, int kvh, int jb) {
    NsaCtx C; int tid = F.tid, lane = F.lane, w = F.wave;
    asm volatile("" : "+v"(tid), "+v"(lane)); asm volatile("" : "+s"(w));
    C.tid = tid; C.lane = lane; C.w = w; C.L = att::make_lane(lane);
    C.tw = 128 * jb + 16 * w; C.t = C.tw + C.L.c; C.row = (long)b * SEQ + C.t;
#pragma unroll
    for (int g = 0; g < 3; ++g) C.slope[g] = nsa_slope(kvh * 3 + g) * att::LOG2E;
    return C;
}
#define NSA_FIN_ADD(first_, g_, nt_, v_) do { const f32x4 v__ = (v_); u32x2* p__ = (u32x2*)(MIXo + (size_t)C.row * DM + (kvh * 3 + (g_)) * 64 + 4 * L.grp + 16 * (nt_)); u32x2 f__ = (u32x2){0u, 0u}; if (!(first_)) f__ = *p__; u32x2 o__; \
        o__.x = att::cvtpk(bf_lo(f__.x) + v__[0], bf_hi(f__.x) + v__[1]); o__.y = att::cvtpk(bf_lo(f__.y) + v__[2], bf_hi(f__.y) + v__[3]); *p__ = o__; } while (0)
__device__ __forceinline__ float nsa_gate(const bf16_t* PROJ, long row, int kvh, int g, int br) { return sigmoidf_(bf_lo((unsigned)PROJ[(size_t)row * NPROJ + C_GATE + (kvh * 3 + g) * 3 + br])); }

__device__ __forceinline__ unsigned nsa_cmp_topk(const Frame& F, int b, int kvh, int jb) {
    bf16_t* MIXo = (bf16_t*)(F.ws + WS_MIX);
    const NsaCtx C = nsa_ctx(F, b, kvh, jb);
    const att::Lane& L = C.L; const int lane = C.lane, tid = C.tid, w = C.w, t = C.t, tw = C.tw;
    const bf16_t* PROJ = (const bf16_t*)(F.ws + WS_PROJ);
    const bf16_t* KCMP = (const bf16_t*)(F.ws + WS_KCMP) + (size_t)(b * 2 + kvh) * 128 * 64; const bf16_t* VCMP = (const bf16_t*)(F.ws + WS_VCMP) + (size_t)(b * 2 + kvh) * 128 * 64;
    LAS unsigned char* cbuf = F.lds;
    LAS float* impM = (LAS float*)(F.lds + 32768) + w * 1056;
    LAS float* impN = impM + 528;
    LAS unsigned* uni = (LAS unsigned*)(F.lds + 32768 + 8 * 4224);
    LAS unsigned char* qlds = F.lds + 32768 + 8 * 4224 + 256 + w * 6144;
    unsigned graw0[3];
#pragma unroll
    for (int g = 0; g < 3; ++g) graw0[g] = (unsigned)PROJ[(size_t)C.row * NPROJ + C_GATE + (kvh * 3 + g) * 3 + 0];
    float slopec[3];
#pragma unroll
    for (int g = 0; g < 3; ++g) {
        slopec[g] = 16.0f * C.slope[g];
        att::bf16x8 qf[2]; att::load_q(PROJ + (size_t)C.row * NPROJ + C_NQ + (kvh * 3 + g) * 64, L.grp, 0.125f * att::LOG2E, qf);
        *(LAS att::bf16x8*)(qlds + ((g * 2 + 0) * 64 + lane) * 16) = qf[0]; *(LAS att::bf16x8*)(qlds + ((g * 2 + 1) * 64 + lane) * 16) = qf[1];
    }
    {
        att::StageRegs s0, s1;
        att::stage_load(s0, KCMP, VCMP, 64, tid); att::stage_load(s1, KCMP + 4096, VCMP + 4096, 64, tid);
        att::stage_store(s0, cbuf, cbuf + att::TILE_BYTES, tid); att::stage_store(s1, cbuf + 2 * att::TILE_BYTES, cbuf + 3 * att::TILE_BYTES, tid);
        for (int i2 = lane; i2 < 1056; i2 += 64) impM[i2] = 0.f;
    }
    __syncthreads();
    const int nmax = (t >= 31) ? ((t - 31) >> 4) : -1, nmaxw = (tw >= 31) ? ((tw - 31) >> 4) : -1, nmaxw_hi = (tw + 15 >= 31) ? ((tw + 15 - 31) >> 4) : -1;
    const float tcf = ((float)t - 15.5f) * (1.0f / 16.0f);
    att::State<3> st; att::state_reset(st);
    {
        f32x4 S[2][3][4];
#pragma unroll
        for (int T = 0; T < 2; ++T) {
            const LAS unsigned char* Kt = cbuf + T * 2 * att::TILE_BYTES;
            const float brel = (float)(64 * T + 4 * L.grp) - tcf; const int drel = 64 * T + 4 * L.grp - nmax;
            f32x4 dm[4];
#pragma unroll
            for (int kt = 0; kt < 4; ++kt)
#pragma unroll
                for (int r = 0; r < 4; ++r) dm[kt][r] = (drel + 16 * kt + r <= 0) ? brel + (float)(16 * kt + r) : -att::BIGD;
            att::bf16x8 kf[4][2];
#pragma unroll
            for (int kt = 0; kt < 4; ++kt) { kf[kt][0] = *(const LAS att::bf16x8*)(Kt + L.kb0 + kt * 2048); kf[kt][1] = *(const LAS att::bf16x8*)(Kt + L.kb1 + kt * 2048); }
#pragma unroll
            for (int g = 0; g < 3; ++g) {
                const att::bf16x8 q0 = *(const LAS att::bf16x8*)(qlds + ((g * 2 + 0) * 64 + lane) * 16), q1 = *(const LAS att::bf16x8*)(qlds + ((g * 2 + 1) * 64 + lane) * 16);
#pragma unroll
                for (int kt = 0; kt < 4; ++kt) {
                    S[T][g][kt] = dm[kt] * slopec[g];
                    S[T][g][kt] = __builtin_amdgcn_mfma_f32_16x16x32_bf16(kf[kt][0], q0, S[T][g][kt], 0, 0, 0);
                    S[T][g][kt] = __builtin_amdgcn_mfma_f32_16x16x32_bf16(kf[kt][1], q1, S[T][g][kt], 0, 0, 0);
                }
            }
        }
        att::bf16x8 pf[3][2][2];
        float impm[2][4], impn[2][4];
#pragma unroll
        for (int T = 0; T < 2; ++T)
#pragma unroll
            for (int kt = 0; kt < 4; ++kt) { impm[T][kt] = 0.f; impn[T][kt] = 0.f; }
#pragma unroll
        for (int g = 0; g < 3; ++g) {
            float mx = att::MFLOOR;
#pragma unroll
            for (int T = 0; T < 2; ++T)
#pragma unroll
                for (int kt = 0; kt < 4; ++kt) mx = fmaxf(mx, fmaxf(fmaxf(S[T][g][kt][0], S[T][g][kt][1]), fmaxf(S[T][g][kt][2], S[T][g][kt][3])));
            mx = fmaxf(mx, x16f(mx)); mx = fmaxf(mx, x32f(mx));
            float ls = 0.f;
#pragma unroll
            for (int T = 0; T < 2; ++T)
#pragma unroll
                for (int kt = 0; kt < 4; ++kt)
#pragma unroll
                    for (int r = 0; r < 4; ++r) { const float e = __builtin_amdgcn_exp2f(S[T][g][kt][r] - mx); S[T][g][kt][r] = e; ls += e; }
            ls += x16f(ls); ls += x32f(ls);
            const float il = (ls > 0.f) ? rcpf_(ls) : 0.f;
#pragma unroll
            for (int T = 0; T < 2; ++T) {
#pragma unroll
                for (int kt = 0; kt < 4; ++kt) { S[T][g][kt] = S[T][g][kt] * il; impm[T][kt] += (S[T][g][kt][0] + S[T][g][kt][1]) + (S[T][g][kt][2] + S[T][g][kt][3]); impn[T][kt] += S[T][g][kt][3]; }
#pragma unroll
                for (int s2 = 0; s2 < 2; ++s2) { u32x4 wv; wv.x = att::cvtpk(S[T][g][2 * s2][0], S[T][g][2 * s2][1]); wv.y = att::cvtpk(S[T][g][2 * s2][2], S[T][g][2 * s2][3]);
                    wv.z = att::cvtpk(S[T][g][2 * s2 + 1][0], S[T][g][2 * s2 + 1][1]); wv.w = att::cvtpk(S[T][g][2 * s2 + 1][2], S[T][g][2 * s2 + 1][3]); pf[g][T][s2] = __builtin_bit_cast(att::bf16x8, wv); }
            }
        }
#pragma unroll
        for (int T = 0; T < 2; ++T)
#pragma unroll
            for (int kt = 0; kt < 4; ++kt) { const int mb = 16 * T + 4 * kt + L.grp; impM[L.c * 33 + mb] = impm[T][kt]; impN[L.c * 33 + mb + 1] = impn[T][kt]; }
#pragma unroll
        for (int T = 0; T < 2; ++T) {
            const LAS unsigned char* Vt = cbuf + T * 2 * att::TILE_BYTES + att::TILE_BYTES;
#pragma unroll
            for (int s2 = 0; s2 < 2; ++s2)
#pragma unroll
                for (int nt = 0; nt < 4; ++nt) {
                    const att::v4i16 lo = __builtin_amdgcn_ds_read_tr16_b64_v4i16((LAS att::v4i16*)(Vt + L.vb[nt] + 4096 * s2));
                    const att::v4i16 hi = __builtin_amdgcn_ds_read_tr16_b64_v4i16((LAS att::v4i16*)(Vt + L.vb[nt] + 4096 * s2 + 2048));
                    const att::bf16x8 vf = {lo[0], lo[1], lo[2], lo[3], hi[0], hi[1], hi[2], hi[3]};
#pragma unroll
                    for (int g = 0; g < 3; ++g) st.O[g][nt] = __builtin_amdgcn_mfma_f32_16x16x32_bf16(vf, pf[g][T][s2], st.O[g][nt], 0, 0, 0);
                }
        }
    }
#pragma unroll
    for (int g = 0; g < 3; ++g) { const float gt = sigmoidf_(bf_lo(graw0[g]));
#pragma unroll
        for (int nt = 0; nt < 4; ++nt) NSA_FIN_ADD(true, g, nt, st.O[g][nt] * gt); }
    asm volatile("s_waitcnt vmcnt(0)" ::: "memory");
    asm volatile("s_waitcnt lgkmcnt(0)" ::: "memory");
    const int cur = t >> 6, hi = cur - 2;
    unsigned mk = 0u;
    {
        float wv[32]; wv[0] = -1.0f;
#pragma unroll
        for (int m2 = 1; m2 < 32; ++m2) { const float w2 = impM[L.c * 33 + m2] + impN[L.c * 33 + m2]; wv[m2] = (m2 <= hi) ? w2 : -1.0f; }
#pragma unroll
        for (int jj = 0; jj < 8; ++jj) {
            const float v = (L.grp == 0) ? wv[4 * jj] : ((L.grp == 1) ? wv[4 * jj + 1] : ((L.grp == 2) ? wv[4 * jj + 2] : wv[4 * jj + 3]));
            int rank = 0;
#pragma unroll
            for (int m2 = 1; m2 < 32; ++m2) {
                const int d = m2 - 4 * jj; bool cnd;
                if (d < 0) cnd = wv[m2] >= v; else if (d >= 3) cnd = wv[m2] > v; else cnd = (wv[m2] > v) || (wv[m2] == v && L.grp > d);
                rank += cnd ? 1 : 0;
            }
            const int mm = L.grp + 4 * jj;
            if (mm >= 1 && mm <= hi && rank < 5) mk |= 1u << mm;
        }
    }
    mk |= x16u(mk); mk |= x32u(mk);
    mk |= 1u | (1u << cur); if (cur >= 1) mk |= 1u << (cur - 1);
    unsigned um = row_or16(mk);
    if (lane == 0) uni[w] = um;
    __syncthreads();
    return mk;
}
template <int BR, bool DISCARD = false> __device__ __forceinline__ void nsa_branch(const Frame& F, int b, int kvh, int jb, unsigned selmask) {
    bf16_t* MIXo = (bf16_t*)(F.ws + WS_MIX);
    const NsaCtx C = nsa_ctx(F, b, kvh, jb);
    const att::Lane& L = C.L; const int lane = C.lane, w = C.w, t = C.t, tw = C.tw;
    const bf16_t* PROJ = (const bf16_t*)(F.ws + WS_PROJ);
    const LAS unsigned* uni = (const LAS unsigned*)(F.lds + 32768 + 8 * 4224);
    const LAS unsigned char* qlds = F.lds + 32768 + 8 * 4224 + 256 + w * 6144;
    const int R = 8 * w + (lane >> 3), pch = lane & 7;
    const bf16_t* ksrc = PROJ + (size_t)((long)b * SEQ + R) * NPROJ + (BR == 1 ? C_KS : C_KW) + kvh * 64 + 8 * (pch ^ ((R >> 1) & 7));
    const bf16_t* vsrc = PROJ + (size_t)((long)b * SEQ + R) * NPROJ + (BR == 1 ? C_VS : C_VW) + kvh * 64 + 8 * (pch ^ (((R >> 1) & 3) << 1));
#define NSA_DMA(T_, slot_) do { const size_t to_ = (size_t)(64 * (T_)) * NPROJ; LAS unsigned* d_ = (LAS unsigned*)(F.lds + (slot_) * 16384 + w * 1024); \
        __builtin_amdgcn_global_load_lds((const unsigned*)(ksrc + to_), d_, 16, 0, 0); __builtin_amdgcn_global_load_lds((const unsigned*)(vsrc + to_), (LAS unsigned*)((LAS unsigned char*)d_ + 8192), 16, 0, 0); } while (0)
    float dummy3[3] = {0.f, 0.f, 0.f}, dummy4[4] = {0.f, 0.f, 0.f, 0.f};
    float m0 = 0.f; asm volatile("" : "+v"(m0));
    att::State<3> st; att::state_reset(st, m0);
    unsigned rem = 0u; int Tlast = 0, T0, T1, T2;
    if (BR == 1) { unsigned um = 0u;
#pragma unroll
        for (int i2 = 0; i2 < 8; ++i2) um |= uni[i2];
        rem = __builtin_amdgcn_readfirstlane(um); }
#define NSA_NEXT(dst_, prev_) do { if (BR == 1) { if (rem != 0u) { dst_ = __builtin_ctz(rem); rem &= rem - 1; } else dst_ = -1; } else { dst_ = ((prev_) >= 0 && (prev_) < Tlast) ? (prev_) + 1 : -1; } } while (0)
    if (BR == 1) { T0 = __builtin_ctz(rem); rem &= rem - 1; } else { T0 = (2 * jb >= 8) ? 2 * jb - 8 : 0; Tlast = 2 * jb + 1; }
    NSA_NEXT(T1, T0); NSA_NEXT(T2, T1);
    asm volatile("s_waitcnt lgkmcnt(0)" ::: "memory"); __builtin_amdgcn_s_barrier();
    NSA_DMA(T0, 0);
    if (T1 >= 0) { NSA_DMA(T1, 1); asm volatile("s_waitcnt vmcnt(2)" ::: "memory"); } else { asm volatile("s_waitcnt vmcnt(0)" ::: "memory"); }
    __builtin_amdgcn_s_barrier();
    unsigned graw[3];
#pragma unroll
    for (int g = 0; g < 3; ++g) graw[g] = (unsigned)PROJ[(size_t)C.row * NPROJ + C_GATE + (kvh * 3 + g) * 3 + BR];
    int slot = 0;
#pragma unroll 1
    for (;;) {
        if (T2 >= 0) { const int s2_ = (slot >= 1) ? slot - 1 : 2; NSA_DMA(T2, s2_); }
        const LAS unsigned char* Kt = F.lds + slot * 16384; const LAS unsigned char* Vt = Kt + att::TILE_BYTES;
        const int T = T0, drel = 64 * T + 4 * L.grp - t;
        if (BR == 1) {
            const bool row_on = (selmask >> T) & 1u;
            if (__any(row_on)) att::tile_heads<3, 0>(Kt, Vt, L, qlds, lane, C.slope, (float)drel, drel, -1000000, row_on, !(__all(row_on) && 64 * T + 63 <= tw), st, dummy3, dummy3, dummy4, dummy4);
        } else {
            const bool skip = (64 * T > tw + 15) || (64 * T + 63 < tw - 511);
            if (!skip) att::tile_heads<3, 0>(Kt, Vt, L, qlds, lane, C.slope, (float)drel, drel, -511, true, !(64 * T + 63 <= tw && 64 * T >= tw + 15 - 511), st, dummy3, dummy3, dummy4, dummy4);
        }
        if (T2 >= 0) { asm volatile("s_waitcnt vmcnt(2) lgkmcnt(0)" ::: "memory"); } else { asm volatile("s_waitcnt vmcnt(0) lgkmcnt(0)" ::: "memory"); }
        __builtin_amdgcn_s_barrier();
        if (T1 < 0) break;
        T0 = T1; T1 = T2; NSA_NEXT(T2, T1); slot = (slot == 2) ? 0 : slot + 1;
    }
#undef NSA_DMA
#undef NSA_NEXT
    u32x2 fold[3][4];
#pragma unroll
    for (int g = 0; g < 3; ++g)
#pragma unroll
        for (int nt = 0; nt < 4; ++nt) fold[g][nt] = DISCARD ? (u32x2){0u, 0u} : *(const u32x2*)(MIXo + (size_t)C.row * DM + (kvh * 3 + g) * 64 + 4 * L.grp + 16 * nt);
#pragma unroll
    for (int g = 0; g < 3; ++g) { float lt = st.l[g]; lt += x16f(lt); lt += x32f(lt); const float sc = (lt > 0.f) ? sigmoidf_(bf_lo(graw[g])) * rcpf_(lt) : 0.f;
#pragma unroll
        for (int nt = 0; nt < 4; ++nt) { const f32x4 v = st.O[g][nt] * sc;
            if (DISCARD) { asm volatile("" :: "v"(v[0]), "v"(v[1]), "v"(v[2]), "v"(v[3])); }
            else { u32x2 o; o.x = att::cvtpk(bf_lo(fold[g][nt].x) + v[0], bf_hi(fold[g][nt].x) + v[1]); o.y = att::cvtpk(bf_lo(fold[g][nt].y) + v[2], bf_hi(fold[g][nt].y) + v[3]);
                   *(u32x2*)(MIXo + (size_t)C.row * DM + (kvh * 3 + g) * 64 + 4 * L.grp + 16 * nt) = o; } } }
    asm volatile("s_waitcnt vmcnt(0)" ::: "memory");
}
__device__ __forceinline__ void nsa_unit2(const Frame& F, int b, int kvh, int jb) {
    unsigned selmask = nsa_cmp_topk(F, b, kvh, jb);
#if REP_CMP > 1
    selmask = nsa_cmp_topk(F, b, kvh, jb);
#endif
#if REP_SEL > 1
    nsa_branch<1, true>(F, b, kvh, jb, selmask);
#endif
#if REP_WIN > 1
    nsa_branch<2, true>(F, b, kvh, jb, selmask);
#endif
    nsa_branch<1>(F, b, kvh, jb, selmask);
    nsa_branch<2>(F, b, kvh, jb, selmask);
}
#undef NSA_FIN_ADD

__device__ __forceinline__ void hgrn_local(const Frame& F, const Args& a, int l, int u) {
    typedef short bf16x8 __attribute__((ext_vector_type(8)));
    typedef short v4i16 __attribute__((ext_vector_type(4)));
    const int c = u & 31, bh = u >> 5, b = bh >> 2, h = bh & 3, lane = F.lane, l15 = lane & 15, grp = lane >> 4;
    const bf16_t* PROJ = (const bf16_t*)(F.ws + WS_PROJ);
    bf16_t* OLOC = (bf16_t*)(F.ws + WS_OLOC); bf16_t* QE = (bf16_t*)(F.ws + WS_QE); bf16_t* HU = (bf16_t*)(F.ws + WS_HU); float* HD = (float*)(F.ws + WS_HD);
    LAS unsigned char* QS = F.lds + F.wave * 16384;
    LAS unsigned char* KS = QS + 2048;
    LAS unsigned char* VV = QS + 4096;
    LAS float* GF = (LAS float*)(QS + 6144);
    float lb = 0.f;
    if (l == 1) lb = sigmoidf_(a.hg_lb[256 + h * 64 + lane] - a.hg_lb[h * 64 + lane]);
    const float omlb = 1.0f - lb;
    f32x4 Sacc[4][4];
#pragma unroll
    for (int dt = 0; dt < 4; ++dt)
#pragma unroll
        for (int et = 0; et < 4; ++et) Sacc[dt][et] = (f32x4){0.f, 0.f, 0.f, 0.f};
    float e0 = 1.0f;
    const long row0 = (long)b * SEQ + c * 64;
    const int qs_w = (lane >> 3), qs_wb = (lane & 7) * 2;
    const int tr_row = 4 * grp + (l15 >> 2), tr_col = 8 * (l15 & 3);
    LAS unsigned char* RQ = QS + 6400;
    LAS unsigned char* RF = QS + 8448;
    LAS unsigned char* OST = QS + 6400;
    LAS unsigned char* QEST = QS + 10752;
    const int wrow = lane >> 3, wch = lane & 7;
    const bf16_t* gin = PROJ + (size_t)(row0 + wrow) * NPROJ + h * 64 + wch * 8;
    u32x4 rq[2], rf[2], rv[2];
#pragma unroll
    for (int i = 0; i < 2; ++i) { const bf16_t* r = gin + (size_t)(8 * i) * NPROJ; rq[i] = *(const u32x4*)(r + C_HQ); rf[i] = *(const u32x4*)(r + C_HF); rv[i] = *(const u32x4*)(r + C_HI); }
#pragma unroll 1
    for (int I = 0; I < 4; ++I) {
        asm volatile("s_waitcnt lgkmcnt(0)" ::: "memory");
#pragma unroll
        for (int i = 0; i < 2; ++i) { *(LAS u32x4*)(RQ + (wrow + 8 * i) * 128 + wch * 16) = rq[i]; *(LAS u32x4*)(RF + (wrow + 8 * i) * 128 + wch * 16) = rf[i]; *(LAS u32x4*)(VV + att::v_off(wrow + 8 * i, wch * 16)) = rv[i]; }
        {
            const int In = (I < 3) ? I + 1 : I;
#pragma unroll
            for (int i = 0; i < 2; ++i) { const bf16_t* r = gin + (size_t)(16 * In + 8 * i) * NPROJ; rq[i] = *(const u32x4*)(r + C_HQ); rf[i] = *(const u32x4*)(r + C_HF); rv[i] = *(const u32x4*)(r + C_HI); }
        }
        asm volatile("s_waitcnt lgkmcnt(0)" ::: "memory");
        float ex = 1.0f;
#pragma unroll
        for (int t = 0; t < 16; ++t) {
            const float qv = bf_lo((unsigned)*(const LAS bf16_t*)(RQ + t * 128 + lane * 2)), fv = bf_lo((unsigned)*(const LAS bf16_t*)(RF + t * 128 + lane * 2));
            const float sg = sigmoidf_(fv);
            const float f = lb + omlb * sg, kk = omlb * (1.0f - sg);
            ex = fmaxf(ex * f, 1e-35f);
            const float qs = qv * ex;
            *(LAS bf16_t*)(QS + att::k_off(t, qs_w) + qs_wb) = (bf16_t)f2bf(qs);
            *(LAS bf16_t*)(KS + att::v_off(t, lane * 2)) = (bf16_t)f2bf(kk * rcpf_(ex));
            *(LAS bf16_t*)(QEST + t * 128 + lane * 2) = (bf16_t)f2bf(qs * e0);
        }
        GF[lane] = ex; e0 *= ex;
        asm volatile("s_waitcnt lgkmcnt(0)" ::: "memory");
#pragma unroll
        for (int i = 0; i < 2; ++i) *(u32x4*)(QE + (size_t)(row0 + I * 16 + wrow + 8 * i) * 256 + h * 64 + wch * 8) = *(const LAS u32x4*)(QEST + (wrow + 8 * i) * 128 + wch * 16);
        f32x4 Oacc[4];
#pragma unroll
        for (int et = 0; et < 4; ++et) Oacc[et] = (f32x4){0.f, 0.f, 0.f, 0.f};
#pragma unroll
        for (int ks = 0; ks < 2; ++ks) {
            const u32x2 lo = *(const LAS u32x2*)(QS + att::k_off(l15, 4 * ks + (grp >> 1)) + 8 * (grp & 1));
            const u32x2 hi = *(const LAS u32x2*)(QS + att::k_off(l15, 4 * ks + 2 + (grp >> 1)) + 8 * (grp & 1));
            u32x4 aw; aw.x = lo.x; aw.y = lo.y; aw.z = hi.x; aw.w = hi.y;
            const bf16x8 af = __builtin_bit_cast(bf16x8, aw);
#pragma unroll
            for (int et = 0; et < 4; ++et) {
                u32x4 bw; bw.x = att::cvtpk(Sacc[2 * ks][et][0], Sacc[2 * ks][et][1]); bw.y = att::cvtpk(Sacc[2 * ks][et][2], Sacc[2 * ks][et][3]);
                bw.z = att::cvtpk(Sacc[2 * ks + 1][et][0], Sacc[2 * ks + 1][et][1]); bw.w = att::cvtpk(Sacc[2 * ks + 1][et][2], Sacc[2 * ks + 1][et][3]);
                Oacc[et] = __builtin_amdgcn_mfma_f32_16x16x32_bf16(af, __builtin_bit_cast(bf16x8, bw), Oacc[et], 0, 0, 0);
            }
        }
        f32x4 AT = (f32x4){0.f, 0.f, 0.f, 0.f};
#pragma unroll
        for (int ks = 0; ks < 2; ++ks) {
            const bf16x8 ka = *(const LAS bf16x8*)(KS + att::v_off(l15, (4 * ks + grp) * 16));
            const bf16x8 qb = *(const LAS bf16x8*)(QS + att::k_off(l15, 4 * ks + grp));
            AT = __builtin_amdgcn_mfma_f32_16x16x32_bf16(ka, qb, AT, 0, 0, 0);
        }
#pragma unroll
        for (int r = 0; r < 4; ++r) AT[r] = (4 * grp + r <= l15) ? AT[r] : 0.f;
        u32x4 atw; atw.x = att::cvtpk(AT[0], AT[1]); atw.y = att::cvtpk(AT[2], AT[3]); atw.z = 0u; atw.w = 0u;
        const bf16x8 atf = __builtin_bit_cast(bf16x8, atw);
        bf16x8 vf[4];
#pragma unroll
        for (int et = 0; et < 4; ++et) { const v4i16 tv = __builtin_amdgcn_ds_read_tr16_b64_v4i16((LAS v4i16*)(VV + att::v_off(tr_row, 32 * et + tr_col)));
            vf[et] = (bf16x8){tv[0], tv[1], tv[2], tv[3], 0, 0, 0, 0}; }
#pragma unroll
        for (int et = 0; et < 4; ++et) Oacc[et] = __builtin_amdgcn_mfma_f32_16x16x32_bf16(atf, vf[et], Oacc[et], 0, 0, 0);
#pragma unroll
        for (int et = 0; et < 4; ++et)
#pragma unroll
            for (int r = 0; r < 4; ++r) *(LAS float*)(OST + (4 * grp + r) * 272 + (16 * et + l15) * 4) = Oacc[et][r];
        asm volatile("s_waitcnt lgkmcnt(0)" ::: "memory");
#pragma unroll
        for (int i = 0; i < 4; ++i) { const f32x4 ov = *(const LAS f32x4*)(OST + (grp + 4 * i) * 272 + l15 * 16); u32x2 ow; ow.x = att::cvtpk(ov[0], ov[1]); ow.y = att::cvtpk(ov[2], ov[3]);
            *(u32x2*)(OLOC + (size_t)(row0 + I * 16 + grp + 4 * i) * 256 + h * 64 + 4 * l15) = ow; }
#pragma unroll
        for (int dt = 0; dt < 4; ++dt) {
            const v4i16 tk = __builtin_amdgcn_ds_read_tr16_b64_v4i16((LAS v4i16*)(KS + att::v_off(tr_row, 32 * dt + tr_col)));
            const bf16x8 kf = (bf16x8){tk[0], tk[1], tk[2], tk[3], 0, 0, 0, 0};
            const f32x4 g4 = *(const LAS f32x4*)(GF + 16 * dt + 4 * grp);
#pragma unroll
            for (int et = 0; et < 4; ++et) { Sacc[dt][et] = __builtin_amdgcn_mfma_f32_16x16x32_bf16(kf, vf[et], Sacc[dt][et], 0, 0, 0); Sacc[dt][et] = Sacc[dt][et] * g4; }
        }
    }
#pragma unroll
    for (int dt = 0; dt < 4; ++dt)
#pragma unroll
        for (int et = 0; et < 4; ++et) { u32x2 w2; w2.x = att::cvtpk(Sacc[dt][et][0], Sacc[dt][et][1]); w2.y = att::cvtpk(Sacc[dt][et][2], Sacc[dt][et][3]); *(u32x2*)(HU + (size_t)u * 4096 + (16 * et + l15) * 64 + 16 * dt + 4 * grp) = w2; }
    HD[(size_t)u * 64 + lane] = e0;
    asm volatile("s_waitcnt lgkmcnt(0)" ::: "memory");
}
__device__ __forceinline__ void hgrn_scan(const Frame& F) {
    const bf16_t* HU = (const bf16_t*)(F.ws + WS_HU); const float* HD = (const float*)(F.ws + WS_HD); bf16_t* HUS = (bf16_t*)(F.ws + WS_HUS);
    for (int idx = F.bid * 512 + F.tid; idx < 64 * 4096; idx += F.G * 512) {
        const int bh = idx >> 12, ed = idx & 4095, d = ed & 63;
        float S = 0.f;
        float uv[32], dv[32];
#pragma unroll
        for (int c = 0; c < 32; ++c) { uv[c] = bf_lo((unsigned)HU[(size_t)(bh * 32 + c) * 4096 + ed]); dv[c] = HD[(size_t)(bh * 32 + c) * 64 + d]; }
#pragma unroll
        for (int c = 0; c < 32; ++c) { HUS[(size_t)(bh * 32 + c) * 4096 + ed] = (bf16_t)f2bf(S); S = dv[c] * S + uv[c]; }
    }
}
__device__ __forceinline__ void hgrn_final(const Frame& F, int u) {
    typedef short bf16x8 __attribute__((ext_vector_type(8)));
    const int c = u & 31, bh = u >> 5, b = bh >> 2, h = bh & 3, lane = F.lane, l15 = lane & 15, grp = lane >> 4;
    const bf16_t* PROJ = (const bf16_t*)(F.ws + WS_PROJ); bf16_t* MIX = (bf16_t*)(F.ws + WS_MIX);
    const bf16_t* OLOC = (const bf16_t*)(F.ws + WS_OLOC); const bf16_t* QE = (const bf16_t*)(F.ws + WS_QE); const bf16_t* HUS = (const bf16_t*)(F.ws + WS_HUS);
    const long row0 = (long)b * SEQ + c * 64;
    bf16x8 af[4][2];
#pragma unroll
    for (int et = 0; et < 4; ++et)
#pragma unroll
        for (int ks = 0; ks < 2; ++ks) af[et][ks] = *(const bf16x8*)(HUS + (size_t)u * 4096 + (16 * et + l15) * 64 + 32 * ks + 8 * grp);
#pragma unroll 1
    for (int tt = 0; tt < 4; ++tt) {
        const long row = row0 + 16 * tt + l15;
        const bf16x8 b0 = *(const bf16x8*)(QE + (size_t)row * 256 + h * 64 + 8 * grp), b1 = *(const bf16x8*)(QE + (size_t)row * 256 + h * 64 + 32 + 8 * grp);
        f32x4 acc[4]; float sq = 0.f;
#pragma unroll
        for (int et = 0; et < 4; ++et) {
            { const u32x2 ow = *(const u32x2*)(OLOC + (size_t)row * 256 + h * 64 + 16 * et + 4 * grp); acc[et] = (f32x4){bf_lo(ow.x), bf_hi(ow.x), bf_lo(ow.y), bf_hi(ow.y)}; }
            acc[et] = __builtin_amdgcn_mfma_f32_16x16x32_bf16(af[et][0], b0, acc[et], 0, 0, 0);
            acc[et] = __builtin_amdgcn_mfma_f32_16x16x32_bf16(af[et][1], b1, acc[et], 0, 0, 0);
        }
#pragma unroll
        for (int et = 0; et < 4; ++et) sq += (acc[et][0] * acc[et][0] + acc[et][1] * acc[et][1]) + (acc[et][2] * acc[et][2] + acc[et][3] * acc[et][3]);
        sq += x16f(sq); sq += x32f(sq);
        const float rs = rsqrtf(sq * (1.0f / 64.0f) + EPS);
#pragma unroll
        for (int et = 0; et < 4; ++et) {
            const u32x2 gw = *(const u32x2*)(PROJ + (size_t)row * NPROJ + C_HG + h * 64 + 16 * et + 4 * grp);
            const float g0 = bf_lo(gw.x), g1 = bf_hi(gw.x), g2 = bf_lo(gw.y), g3 = bf_hi(gw.y);
            u32x2 o; o.x = pk2(acc[et][0] * rs * (g0 * sigmoidf_(g0)), acc[et][1] * rs * (g1 * sigmoidf_(g1))); o.y = pk2(acc[et][2] * rs * (g2 * sigmoidf_(g2)), acc[et][3] * rs * (g3 * sigmoidf_(g3)));
            *(u32x2*)(MIX + (size_t)row * DM + 768 + h * 64 + 16 * et + 4 * grp) = o;
        }
    }
}

__device__ __forceinline__ void phase_cmp2(const Frame& F, const Args& a, int l) {
    const int kv = F.bid >> 7, rbase = (F.bid & 127) * 32, lane = F.lane;
    LAS float* w2s = (LAS float*)F.lds;
    LAS float* hids = (LAS float*)(F.lds + 65536) + F.wave * 256;
    const float* bias = (const float*)(F.ws + WS_B1P + 65536) + (l * 2 + kv) * 256;
    const f32x4 bv = *(const f32x4*)(bias + 4 * lane);
    bf16_t* dstb = (bf16_t*)(F.ws + (kv == 0 ? WS_KCMP : WS_VCMP));
    f32x4 hs4[4];
#pragma unroll
    for (int rr = 0; rr < 4; ++rr) { const int rowi = rbase + F.wave * 4 + rr; f32x4 t4 = bv;
#pragma unroll
        for (int ks = 0; ks < 2; ++ks) t4 = t4 + *(const f32x4*)((const float*)(F.ws + ws_slab(kv, ks)) + (size_t)rowi * 256 + 4 * lane);
        hs4[rr] = t4; }
    { const float* w2 = a.cmp_w2 + (size_t)(l * 2 + kv) * 256 * 64;
#pragma unroll
      for (int i = 0; i < 8; ++i) *(LAS f32x4*)(w2s + (F.tid + 512 * i) * 4) = *(const f32x4*)(w2 + (F.tid + 512 * i) * 4); }
    __syncthreads();
#pragma unroll
    for (int rr = 0; rr < 4; ++rr) {
        const int rowi = rbase + F.wave * 4 + rr;
        f32x4 hsum = hs4[rr];
#pragma unroll
        for (int e = 0; e < 4; ++e) hsum[e] = hsum[e] * sigmoidf_(hsum[e]);
        asm volatile("s_waitcnt lgkmcnt(0)" ::: "memory");
        *(LAS f32x4*)(hids + 4 * lane) = hsum;
        asm volatile("s_waitcnt lgkmcnt(0)" ::: "memory");
        float s0 = 0.f, s1 = 0.f;
#pragma unroll 8
        for (int j = 0; j < 256; j += 4) { const f32x4 h4 = *(const LAS f32x4*)(hids + j);
            s0 += h4.x * w2s[(j + 0) * 64 + lane] + h4.z * w2s[(j + 2) * 64 + lane]; s1 += h4.y * w2s[(j + 1) * 64 + lane] + h4.w * w2s[(j + 3) * 64 + lane]; }
        dstb[(size_t)rowi * 64 + lane] = ((rowi & 127) == 127) ? (bf16_t)0 : (bf16_t)f2bf(s0 + s1);
    }
    __syncthreads();
}

constexpr int NPH = 1 + 8 * DEPTH;

template <int KF> __device__ __forceinline__ constexpr bool kf_on(int kind) { return KF < 0 || kind == KF || (kind >= 10 && kind / 10 == KF) || (KF >= 10 && KF / 10 == kind); }
template <int KF> __device__ __forceinline__ void mega_body(const Args& args_in) {
    extern __shared__ __attribute__((aligned(16))) unsigned char lds_raw[];
    LAS unsigned char* const lds = (LAS unsigned char*)lds_raw;
    {
        const int tid0 = threadIdx.x;
        const unsigned hw0 = (unsigned)__builtin_amdgcn_s_getreg((5 << 11) | 4) & 63u;
        if ((tid0 & 63) == 0) ((LAS unsigned*)(lds + LDS_WTAB))[hw0] = (unsigned)(tid0 >> 6);
        if (tid0 == 0) { ((LAS unsigned*)(lds + LDS_XBST))[0] = 0u; ((LAS unsigned*)(lds + LDS_XBST))[1] = 0u;
#if MK_ONE_LAUNCH
            (void)xb_add((unsigned*)(args_in.ws + WS_CTL) + CW_BAR + XB_XCNT(xb_xcc_id()), 1u);
#endif
        }
        if (tid0 == 0) { LAS Args* la = (LAS Args*)(lds + LDS_ARGS);
            la->x = args_in.x; la->p = args_in.p; la->w_in = args_in.w_in; la->w_out = args_in.w_out; la->cmp_pos = args_in.cmp_pos; la->cmp_w1 = args_in.cmp_w1; la->cmp_w2 = args_in.cmp_w2; la->hg_lb = args_in.hg_lb;
            la->g_pre_mix = args_in.g_pre_mix; la->g_post_mix = args_in.g_post_mix; la->g_pre_mlp = args_in.g_pre_mlp; la->g_post_mlp = args_in.g_post_mlp; la->w_up = args_in.w_up; la->w_down = args_in.w_down;
            la->g_ple = args_in.g_ple; la->w_ple_gate = args_in.w_ple_gate; la->w_ple_proj = args_in.w_ple_proj; la->out = args_in.out; la->ws = args_in.ws; }
        __syncthreads();
    }
#if MK_ONE_LAUNCH
    const int lo = 0, hi = NPH;
#else
    const int lo = args_in.ph_lo, hi = args_in.ph_hi;
#endif
#define PHASE_KIND_FILTER(kind) kf_on<KF>(kind)
#define INK(kind, k) (PHASE_KIND_FILTER(kind) && lo <= (k) && (k) < hi)
#define IN(k) (lo <= (k) && (k) < hi)
#define SEAM(k) do { if (IN(k) && IN((k) + 1)) { if ((k) == 0) { cg::this_grid().sync(); } else { Args a_; const Frame Fb = make_frame(lds, a_); \
        xcd_barrier((unsigned*)(Fb.ws + WS_CTL) + CW_BAR, (volatile LAS unsigned*)(lds + LDS_XBST), Fb.tid == 0, (unsigned)Fb.G); } } } while (0)
#define PHASE_BEGIN Args args; const Frame F = make_frame(lds, args); \
    unsigned* const ctl = (unsigned*)(F.ws + WS_CTL); bf16_t* const PROJ = (bf16_t*)(F.ws + WS_PROJ); bf16_t* const MIX = (bf16_t*)(F.ws + WS_MIX); bf16_t* const HBA = (bf16_t*)(F.ws + WS_HBA); bf16_t* const HBB = (bf16_t*)args.out; \
    bf16_t* const U = (bf16_t*)(F.ws + WS_U); bf16_t* const PP = (bf16_t*)(F.ws + WS_PP); bf16_t* const PB = (bf16_t*)(F.ws + WS_PB); float* const SSA = (float*)(F.ws + WS_SSA); float* const SSB = (float*)(F.ws + WS_SSB); float* const XBUF = (float*)(F.ws + WS_XBUF); \
    (void)ctl; (void)PROJ; (void)MIX; (void)HBA; (void)HBB; (void)U; (void)PP; (void)PB; (void)SSA; (void)SSB; (void)XBUF;

    for (int rep_ = 0; rep_ < REP_P0; ++rep_) if (INK(0, 0)) { PHASE_BEGIN phase_prologue(F, args); }
    SEAM(0);

#pragma unroll 1
    for (int l = 0; l < DEPTH; ++l) {
        const int pb = 1 + 8 * l;
        for (int rep_ = 0; rep_ < REP_G1; ++rep_) if (INK(1, pb + 0)) { PHASE_BEGIN
            if (l == 0) reduce_bias1(F);
            pg8::Gemm g = pg8::make_gemm(HBB, (const bf16_t*)(F.ws + WS_WIN) + (size_t)l * NPROJ * DM, DM);
            pg8::StaticOrder S; S.init(MTOK, NPROJ, F.G, F.bid);
            fill_rstd(F, SSB, S);
            pg8::EpiBf<1> E{PROJ, NPROJ, (const LAS float*)(F.lds + LDS_RSTD), nullptr};
            pg8::gemm_phase<pg8::EpiBf<1>, pg8::StaticOrder, true>(F.lds, g, S, E);
        }
        SEAM(pb + 0);
        for (int rep_ = 0; rep_ < REP_P2; ++rep_) if (INK(2, pb + 1)) { PHASE_BEGIN
            for (int r2_ = 0; r2_ < REP_HL; ++r2_) if (PHASE_KIND_FILTER(21)) { hgrn_local(F, args, l, F.bid * 8 + F.wave); __syncthreads(); }
            for (int r2_ = 0; r2_ < REP_CG; ++r2_) if (F.bid < 64 && PHASE_KIND_FILTER(20)) {
                const int ks = F.bid & 1, bb = (F.bid >> 1) & 15, kv = F.bid >> 5;
                pg8::Gemm g; g.A = PROJ + (kv == 0 ? C_KC : C_VC) + (size_t)(16 * ks) * NPROJ; g.Bt = (const bf16_t*)(F.ws + WS_W1T) + (size_t)(l * 2 + kv) * 256 * 2048 + 1024 * ks; g.K = 1024; g.ldb = 2048;
                asm volatile("" : "+s"(g.K));
                g.lda = 16 * NPROJ; g.a_kstep = (long)NPROJ * 2; g.a_hstep = 128; g.a_tstep = (long)SEQ * NPROJ * 2;
                pg8::OneFixed S; S.u0.pm = bb; S.u0.pn = 0; S.valid = true;
                pg8::EpiF32P E{(float*)(F.ws + ws_slab(kv, ks)), 256};
                pg8::gemm_phase<pg8::EpiF32P, pg8::OneFixed, false>(F.lds, g, S, E);
                __syncthreads();
            }
            if (F.bid >= 64) {
                for (int r2_ = 0; r2_ < REP_DL; ++r2_) if (PHASE_KIND_FILTER(22)) dil_units(F, F.bid - 64, 192);
            }
        }
        SEAM(pb + 1);
        if (INK(3, pb + 2)) { PHASE_BEGIN for (int r2_ = 0; r2_ < REP_C2; ++r2_) phase_cmp2(F, args, l); for (int r2_ = 0; r2_ < REP_SC; ++r2_) hgrn_scan(F); dil_fixup(F); }
        SEAM(pb + 2);
        for (int rep_ = 0; rep_ < REP_P4; ++rep_) if (INK(4, pb + 3)) { PHASE_BEGIN
            for (int r2_ = 0; r2_ < REP_HF; ++r2_) { hgrn_final(F, F.bid * 8 + F.wave); __syncthreads(); }
            {
                unsigned* qhead = ctl + CW_NSAQ + 64 * l;
                LAS unsigned* qw = (LAS unsigned*)(F.lds + LDS_QW);
#pragma unroll 1
                for (;;) {
                    __syncthreads();
                    if (F.tid == 0) *qw = __hip_atomic_fetch_add(qhead, 1u, __ATOMIC_RELAXED, __HIP_MEMORY_SCOPE_AGENT);
                    __syncthreads();
                    const unsigned idx = (unsigned)__builtin_amdgcn_readfirstlane((int)*qw);
                    if (idx >= 512u) break;
                    const int jb = 15 - (int)(idx >> 5), kvh = (int)(idx & 1u), bb = (int)((idx >> 1) & 15u);
                    nsa_unit2(F, bb, kvh, jb);
                }
            }
        }
        SEAM(pb + 3);
        if (INK(5, pb + 4)) { PHASE_BEGIN
            convert_p(F, args, l);
            pg8::Gemm g = pg8::make_gemm(MIX, (const bf16_t*)(F.ws + WS_WOUT) + (size_t)l * DM * DM, DM);
            pg8::StaticOrder S; S.init(MTOK, DM, F.G, F.bid);
            pg8::EpiPost E{HBB, HBA, args.g_post_mix + l * DM, SSA, XBUF, ctl + CW_CNT + ((l * 2 + 0) * 128) * 64, ctl + CW_TMO, F.lds + LDS_RSTD};
            pg8::gemm_phase<pg8::EpiPost, pg8::StaticOrder, true>(F.lds, g, S, E);
        }
        SEAM(pb + 4);
        for (int rep_ = 0; rep_ < REP_G3; ++rep_) if (INK(6, pb + 5)) { PHASE_BEGIN
            if (PHASE_KIND_FILTER(60)) {
                pg8::Gemm g = pg8::make_gemm(HBA, (const bf16_t*)(F.ws + WS_WUP) + (size_t)l * FF * DM, DM);
                pg8::StaticOrder S; S.init(MTOK, FF, F.G, F.bid);
                fill_rstd(F, SSA, S);
                pg8::EpiBf<2> E{U, FF, (const LAS float*)(F.lds + LDS_RSTD), nullptr};
                pg8::gemm_phase<pg8::EpiBf<2>, pg8::StaticOrder, true>(F.lds, g, S, E);
            }
        }
        SEAM(pb + 5);
        if (INK(7, pb + 6)) { PHASE_BEGIN
            pg8::Gemm g = pg8::make_gemm(U, (const bf16_t*)(F.ws + WS_WDN) + (size_t)l * DM * FF, FF);
            pg8::StaticOrder S; S.init(MTOK, DM, F.G, F.bid);
            pg8::EpiPost E{HBA, HBA, args.g_post_mlp + l * DM, SSA, XBUF, ctl + CW_CNT + ((l * 2 + 1) * 128) * 64, ctl + CW_TMO, F.lds + LDS_RSTD};
            pg8::gemm_phase<pg8::EpiPost, pg8::StaticOrder, true>(F.lds, g, S, E);
        }
        SEAM(pb + 6);
        if (INK(8, pb + 7)) { PHASE_BEGIN
            {
                pg8::Gemm gp = pg8::make_gemm(PB, (const bf16_t*)(F.ws + WS_WPJ) + (size_t)l * DM * PLE, PLE);
                pg8::StaticOrder Sp; Sp.init(MTOK, DM, F.G, F.bid);
                pg8::EpiBf<0> Ep{PP, DM, nullptr, nullptr};
                pg8::gemm_phase<pg8::EpiBf<0>, pg8::StaticOrder, true>(F.lds, gp, Sp, Ep);
                asm volatile("s_waitcnt vmcnt(0)" ::: "memory");
                __syncthreads();
            }
            pg8::Gemm g = pg8::make_gemm(HBA, (const bf16_t*)(F.ws + WS_WG) + (size_t)l * DM * DM, DM);
            pg8::StaticOrder S; S.init(MTOK, DM, F.G, F.bid);
            fill_rstd(F, SSA, S);
            pg8::EpiPle E{(const LAS float*)(F.lds + LDS_RSTD), PP, HBA, (l == DEPTH - 1) ? args.out : (float*)nullptr, HBB, SSB};
            pg8::gemm_phase<pg8::EpiPle, pg8::StaticOrder, true>(F.lds, g, S, E);
        }
        SEAM(pb + 7);
    }
#undef IN
#undef SEAM
#undef INK
#undef PHASE_KIND_FILTER
#undef PHASE_BEGIN
}
template <int KF> __global__ void __launch_bounds__(512, 2) mega_k(Args args) { mega_body<KF>(args); }

template <int KF> static bool setup_kernel() {
    return hipFuncSetAttribute((const void*)mega_k<KF>, hipFuncAttributeMaxDynamicSharedMemorySize, LDS_BYTES) == hipSuccess;
}
template <int KF> static void launch_phase(int grid, const Args& a, hipStream_t stream) {
    hipLaunchKernelGGL(mega_k<KF>, dim3(grid), dim3(512), LDS_BYTES, stream, a);
}
extern "C" void kernel_launch(void* const* d_in, const int* in_sizes, int n_in, void* d_out, int out_size, void* d_ws, size_t ws_size, hipStream_t stream) {
    static int grid = 0;
    if (grid == 0) {
        if (n_in != 17 || in_sizes[0] != MTOK * DM || out_size != MTOK * DM || ws_size < WS_END) {
            fprintf(stderr, "kernel_launch: unexpected problem (n_in %d, in0 %d, out %d, ws %zu)\n", n_in, n_in > 0 ? in_sizes[0] : -1, out_size, ws_size); grid = -1; return; }
        int dev = 0, cus = 0, per_cu = 0;
        (void)hipGetDevice(&dev); (void)hipDeviceGetAttribute(&cus, hipDeviceAttributeMultiprocessorCount, dev);
        bool ok = true;
#if MK_ONE_LAUNCH
        ok = setup_kernel<-1>();
        if (hipOccupancyMaxActiveBlocksPerMultiprocessor(&per_cu, (const void*)mega_k<-1>, 512, LDS_BYTES) != hipSuccess || per_cu < 1) { fprintf(stderr, "kernel_launch: occupancy query says %d\n", per_cu); }
#else
        ok = setup_kernel<0>() && setup_kernel<1>() && setup_kernel<20>() && setup_kernel<21>() && setup_kernel<22>() && setup_kernel<3>() && setup_kernel<4>() && setup_kernel<5>() && setup_kernel<6>() && setup_kernel<7>() && setup_kernel<8>();
#endif
        if (!ok) { fprintf(stderr, "kernel_launch: hipFuncSetAttribute failed\n"); grid = -1; return; }
        (void)hipGetLastError();
        grid = cus;
        if (grid != 256) fprintf(stderr, "kernel_launch: %d CUs; this kernel is built for 256\n", grid);
    }
    if (grid < 0) return;
    (void)hipMemsetAsync((char*)d_ws + WS_CTL, 0, CTL_BYTES, stream);
    Args a{};
    a.x = (const float*)d_in[0]; a.p = (const float*)d_in[1]; a.w_in = (const float*)d_in[2]; a.w_out = (const float*)d_in[3]; a.cmp_pos = (const float*)d_in[4];
    a.cmp_w1 = (const float*)d_in[5]; a.cmp_w2 = (const float*)d_in[6]; a.hg_lb = (const float*)d_in[7]; a.g_pre_mix = (const float*)d_in[8]; a.g_post_mix = (const float*)d_in[9];
    a.g_pre_mlp = (const float*)d_in[10]; a.g_post_mlp = (const float*)d_in[11]; a.w_up = (const float*)d_in[12]; a.w_down = (const float*)d_in[13]; a.g_ple = (const float*)d_in[14];
    a.w_ple_gate = (const float*)d_in[15]; a.w_ple_proj = (const float*)d_in[16];
    a.out = (float*)d_out; a.ws = (unsigned char*)d_ws;
#if MK_ONE_LAUNCH
    a.ph_lo = 0; a.ph_hi = NPH;
    void* kargs[] = {&a};
    hipError_t e = hipLaunchCooperativeKernel((const void*)mega_k<-1>, dim3(grid), dim3(512), kargs, LDS_BYTES, stream);
    if (e != hipSuccess) fprintf(stderr, "kernel_launch: cooperative launch failed: %s\n", hipGetErrorString(e));
#else
    for (int ph = 0; ph < NPH; ++ph) {
        a.ph_lo = ph; a.ph_hi = ph + 1;
        const int kind = (ph == 0) ? 0 : ((ph - 1) % 8) + 1;
        switch (kind) {
            case 0: launch_phase<0>(grid, a, stream); break;
            case 1: launch_phase<1>(grid, a, stream); break;
            case 2: launch_phase<20>(grid, a, stream); launch_phase<21>(grid, a, stream); launch_phase<22>(grid, a, stream); break;
            case 3: launch_phase<3>(grid, a, stream); break;
            case 4: launch_phase<4>(grid, a, stream); break;
            case 5: launch_phase<5>(grid, a, stream); break;
            case 6: launch_phase<6>(grid, a, stream); break;
            case 7: launch_phase<7>(grid, a, stream); break;
            default: launch_phase<8>(grid, a, stream); break;
        }
    }
#endif
}
```

```cpp
#include <hip/hip_runtime.h>
#include <hip/hip_cooperative_groups.h>
#include <cstdio>
#include <cstdint>
namespace cg = cooperative_groups;

#ifndef REP_P0
#define REP_P0 1
#endif
#ifndef REP_HL
#define REP_HL 1
#endif
#ifndef REP_CG
#define REP_CG 1
#endif
#ifndef REP_DL
#define REP_DL 1
#endif
#ifndef REP_HF
#define REP_HF 1
#endif
#ifndef REP_NSA
#define REP_NSA 1
#endif
#ifndef REP_CMP
#define REP_CMP 1
#endif
#ifndef REP_SEL
#define REP_SEL 1
#endif
#ifndef REP_WIN
#define REP_WIN 1
#endif
#ifndef REP_C2
#define REP_C2 1
#endif
#ifndef REP_SC
#define REP_SC 1
#endif
#ifndef REP_G1
#define REP_G1 1
#endif
#ifndef REP_P2
#define REP_P2 1
#endif
#ifndef REP_P4
#define REP_P4 1
#endif
#ifndef REP_G3
#define REP_G3 1
#endif
#ifndef MK_ONE_LAUNCH
#define MK_ONE_LAUNCH 1
#endif

constexpr int BATCH = 16, SEQ = 2048, DM = 1024, MTOK = BATCH * SEQ, DEPTH = 2;
constexpr int FF = 4096, PLE = 256;
constexpr int IN_TOTAL = 3346, NPROJ = 3584;
constexpr int C_NQ = 0, C_KC = 384, C_VC = 512, C_KS = 640, C_VS = 768, C_KW = 896, C_VW = 1024;
constexpr int C_DQ = 1152, C_DK = 1536, C_DV = 1920, C_HQ = 2304, C_HF = 2560, C_HI = 2816, C_HG = 3072, C_GATE = 3328;
constexpr float EPS = 1e-6f;
constexpr float NEGBIG = -1e30f;

constexpr size_t MiB = 1u << 20;
constexpr size_t WS_CTL = 0, CTL_BYTES = 1 * MiB;
constexpr size_t WS_SSA = 1 * MiB;
constexpr size_t WS_SSB = 3 * MiB;
constexpr size_t WS_XBUF = 5 * MiB;
constexpr size_t WS_KCMP = 6 * MiB;
constexpr size_t WS_VCMP = 7 * MiB;
constexpr size_t WS_HID = 8 * MiB;
constexpr size_t WS_WIN = 12 * MiB;
constexpr size_t WS_WOUT = 26 * MiB;
constexpr size_t WS_WUP = 30 * MiB;
constexpr size_t WS_WDN = 46 * MiB;
constexpr size_t WS_WG = 62 * MiB;
constexpr size_t WS_WPJ = 66 * MiB;
constexpr size_t WS_W1T = 67 * MiB;
constexpr size_t WS_B1P = 71 * MiB;
constexpr size_t WS_PB = 72 * MiB;
constexpr size_t WS_HBA = 88 * MiB;
constexpr size_t WS_PP = 152 * MiB;
constexpr size_t WS_PROJ = 216 * MiB;
constexpr size_t WS_MIX = 440 * MiB;
constexpr size_t WS_U = 216 * MiB;
constexpr size_t WS_END = 504 * MiB;
constexpr size_t WS_OLOC = WS_HBA;
constexpr size_t WS_QE = WS_HBA + 32 * MiB;
constexpr size_t WS_HUS = WS_HBA + 48 * MiB;
constexpr size_t WS_HU = WS_PP;
constexpr size_t WS_HD = WS_PP + 32 * MiB;
constexpr size_t WS_LSE = WS_PP + 33 * MiB;
__host__ __device__ constexpr size_t ws_slab(int kv, int ks) { return (kv == 0 ? WS_PB : WS_PP + 48 * MiB) + (size_t)ks * 4 * MiB; }
constexpr int CW_TMO = 0;
constexpr int CW_BAR = 65536;
constexpr int CW_NSAQ = 512;
constexpr int CW_CNT = 1024;

constexpr int RING_BYTES = 131072;
constexpr int MISC_OFF = RING_BYTES;
constexpr int LDS_BYTES = 147456;
constexpr int LDS_ARGS = MISC_OFF + 4096;
constexpr int LDS_XBST = MISC_OFF + 4096 + 256;
constexpr int LDS_QW = MISC_OFF + 4096 + 320;
constexpr int LDS_WTAB = MISC_OFF + 4096 + 512;
constexpr int LDS_RSTD = MISC_OFF + 8192;

#define LAS __attribute__((address_space(3)))
typedef unsigned short bf16_t;
typedef float f32x4 __attribute__((ext_vector_type(4)));
typedef float f32x2 __attribute__((ext_vector_type(2)));
typedef unsigned u32x4 __attribute__((ext_vector_type(4)));
typedef unsigned u32x2 __attribute__((ext_vector_type(2)));

__device__ __forceinline__ float bf_lo(unsigned u) { return __uint_as_float(u << 16); }
__device__ __forceinline__ float bf_hi(unsigned u) { return __uint_as_float(u & 0xffff0000u); }
__device__ __forceinline__ unsigned f2bf(float f) { unsigned u = __float_as_uint(f); return (u + 0x7fffu + ((u >> 16) & 1u)) >> 16; }
__device__ __forceinline__ unsigned pk2(float lo, float hi) { return f2bf(lo) | (f2bf(hi) << 16); }
__device__ __forceinline__ float rcpf_(float x) { return __builtin_amdgcn_rcpf(x); }
__device__ __forceinline__ float sigmoidf_(float x) { return rcpf_(1.0f + __expf(-x)); }
__device__ __forceinline__ unsigned x16u(unsigned v) { auto r = __builtin_amdgcn_permlane16_swap(v, v, false, false); return r[0] ^ r[1] ^ v; }
__device__ __forceinline__ unsigned x32u(unsigned v) { auto r = __builtin_amdgcn_permlane32_swap(v, v, false, false); return r[0] ^ r[1] ^ v; }
__device__ __forceinline__ float x16f(float v) { return __uint_as_float(x16u(__float_as_uint(v))); }
__device__ __forceinline__ float x32f(float v) { return __uint_as_float(x32u(__float_as_uint(v))); }
template <int CTRL> __device__ __forceinline__ unsigned dppu(unsigned v) { return (unsigned)__builtin_amdgcn_update_dpp((int)v, (int)v, CTRL, 0xf, 0xf, false); }
__device__ __forceinline__ float row_sum16(float v) {
    v += __uint_as_float(dppu<0xB1>(__float_as_uint(v))); v += __uint_as_float(dppu<0x4E>(__float_as_uint(v)));
    v += __uint_as_float(dppu<0x141>(__float_as_uint(v))); v += __uint_as_float(dppu<0x140>(__float_as_uint(v))); return v;
}
__device__ __forceinline__ unsigned row_or16(unsigned v) { v |= dppu<0xB1>(v); v |= dppu<0x4E>(v); v |= dppu<0x141>(v); v |= dppu<0x140>(v); return v; }
__device__ __forceinline__ float wave_sum(float v) { v = row_sum16(v); v += x16f(v); v += x32f(v); return v; }

namespace pg8 {
#define PG8_LAS __attribute__((address_space(3)))
typedef short bf16x8 __attribute__((ext_vector_type(8)));
constexpr int BM = 256, BK = 64, HALF = 128, HTB = HALF * BK * 2, STAGE_BYTES = 8 * HTB, NXCD = 8, WGM = 8;

__host__ __device__ __forceinline__ int lds_byte(int r, int c) { const int st = (r >> 4) * 2 + (c >> 5), rr = r & 15, cc = c & 31, ob = rr * 64 + cc * 2; return st * 1024 + (ob ^ (((ob >> 9) & 1) << 5)); }
__host__ __device__ __forceinline__ void stage_rc(int b, int& R, int& C) { const int st = b / 1024, sb = b % 1024, swz = sb ^ (((sb >> 9) & 1) << 5); R = (st >> 1) * 16 + swz / 64; C = (st & 1) * 32 + (swz % 64) / 2; }
__host__ __device__ __forceinline__ int perm32(int rho) { const int n = rho >> 4, i = rho & 15; return 8 * (i >> 2) + 4 * n + (i & 3); }

struct Unit { int pm, pn; };
struct Gemm { const bf16_t* A; const bf16_t* Bt; int K; int lda; long a_kstep, a_hstep, a_tstep; int ldb; };
__device__ __forceinline__ Gemm make_gemm(const bf16_t* A, const bf16_t* Bt, int K) { asm volatile("" : "+s"(K)); Gemm g; g.A = A; g.Bt = Bt; g.K = K; g.lda = K; g.a_kstep = BK * 2; g.a_hstep = (long)HALF * K * 2; g.a_tstep = 2 * g.a_hstep; g.ldb = K; return g; }

struct StaticOrder {
    int nM, nN, nwg, G, c;
    __device__ void init(int M, int N, int G_, int c_) { nM = M / BM; nN = N / BM; nwg = nM * nN; G = G_; c = c_; }
    __device__ bool next(int i, Unit& u) const {
        const long L = (long)i * G + c; if (L >= nwg) return false;
        int wgid = (int)L; { const int q = nwg / NXCD, r = nwg % NXCD, xcd = wgid % NXCD, off = wgid / NXCD; wgid = (xcd < r ? xcd * (q + 1) : r * (q + 1) + (xcd - r) * q) + off; }
        const int nig = WGM * nN, gid = wgid / nig, fm = gid * WGM, gsz = (nM - fm) < WGM ? (nM - fm) : WGM;
        u.pm = fm + ((wgid % nig) % gsz); u.pn = (wgid % nig) / gsz; return true;
    }
};
struct OneOf { StaticOrder S; int i;
    __device__ bool next(int j, Unit& u) const { return j == 0 ? S.next(i, u) : false; } };
struct OneFixed { Unit u0; bool valid;
    __device__ bool next(int j, Unit& u) const { if (j == 0 && valid) { u = u0; return true; } return false; } };

__device__ __forceinline__ unsigned cvt_pk_bf16(float lo, float hi) { unsigned r; asm volatile("v_cvt_pk_bf16_f32 %0, %1, %2" : "=v"(r) : "v"(lo), "v"(hi)); return r; }

__device__ __forceinline__ float row_rstd16(const float* ss, long row) {
    const f32x4* sp = (const f32x4*)(ss + row * 16);
    const f32x4 a = sp[0], b = sp[1], c = sp[2], d = sp[3];
    const float tot = ((a.x + a.y) + (a.z + a.w)) + ((b.x + b.y) + (b.z + b.w)) + ((c.x + c.y) + (c.z + c.w)) + ((d.x + d.y) + (d.z + d.w));
    return rsqrtf(tot * (1.0f / 1024.0f) + EPS);
}

template <int MODE> struct EpiBf {
    static constexpr bool PERM = true, AFTER_DRAIN = false;
    bf16_t* O; int ldc; const PG8_LAS float* rstd; const float* bias;
    __device__ __forceinline__ void operator()(const f32x4 (&acc)[2][2][4][2], const Unit& u, int ui, int wr, int wc, int fr, int fq) const {
        const int row0 = u.pm * BM + wr * 64 + fr; const int col0 = u.pn * BM + wc * 32 + 8 * fq;
        f32x4 bv[2][2];
        if (MODE == 3) {
#pragma unroll
            for (int bj = 0; bj < 2; ++bj)
#pragma unroll
                for (int n = 0; n < 2; ++n) bv[bj][n] = *(const f32x4*)(bias + col0 + bj * HALF + 4 * n);
        }
#pragma unroll
        for (int ai = 0; ai < 2; ++ai)
#pragma unroll
            for (int m = 0; m < 4; ++m) {
                const long row = row0 + ai * HALF + m * 16;
                float rs = 1.0f;
                if (MODE == 1 || MODE == 2) rs = rstd[ui * 256 + wr * 64 + fr + ai * HALF + m * 16];
                bf16_t* rowp = O + (size_t)row * ldc + col0;
#pragma unroll
                for (int bj = 0; bj < 2; ++bj) {
                    f32x4 v0 = acc[ai][bj][m][0], v1 = acc[ai][bj][m][1];
                    if (MODE == 1) { v0 = v0 * rs; v1 = v1 * rs; }
                    if (MODE == 2) {
                        v0 = v0 * rs; v1 = v1 * rs;
#pragma unroll
                        for (int e = 0; e < 4; ++e) { const float a = fmaxf(v0[e], 0.f), b = fmaxf(v1[e], 0.f); v0[e] = a * a; v1[e] = b * b; }
                    }
                    if (MODE == 3) {
                        v0 = v0 + bv[bj][0]; v1 = v1 + bv[bj][1];
#pragma unroll
                        for (int e = 0; e < 4; ++e) { v0[e] = v0[e] * sigmoidf_(v0[e]); v1[e] = v1[e] * sigmoidf_(v1[e]); }
                    }
                    u32x4 w; w.x = cvt_pk_bf16(v0[0], v0[1]); w.y = cvt_pk_bf16(v0[2], v0[3]); w.z = cvt_pk_bf16(v1[0], v1[1]); w.w = cvt_pk_bf16(v1[2], v1[3]);
                    *(u32x4*)(rowp + bj * HALF) = w;
                }
            }
    }
};

struct EpiF32P {
    static constexpr bool PERM = false, AFTER_DRAIN = false;
    float* C; int ldc;
    __device__ __forceinline__ void operator()(const f32x4 (&acc)[2][2][4][2], const Unit& u, int ui, int wr, int wc, int fr, int fq) const {
        const int row0 = u.pm * BM + wr * 64 + fr, col0 = u.pn * BM + wc * 32 + 4 * fq;
#pragma unroll
        for (int ai = 0; ai < 2; ++ai)
#pragma unroll
            for (int m = 0; m < 4; ++m) { float* rowp = C + (size_t)(row0 + ai * HALF + m * 16) * ldc + col0;
#pragma unroll
                for (int bj = 0; bj < 2; ++bj)
#pragma unroll
                    for (int n = 0; n < 2; ++n) *(f32x4*)(rowp + bj * HALF + n * 16) = acc[ai][bj][m][n]; }
    }
};
struct EpiPle {
    static constexpr bool PERM = true, AFTER_DRAIN = false;
    const PG8_LAS float* rstd; const bf16_t* pp; const bf16_t* hin; float* outf; bf16_t* hb; float* sso;
    __device__ __forceinline__ void operator()(const f32x4 (&acc)[2][2][4][2], const Unit& u, int ui, int wr, int wc, int fr, int fq) const {
        const int row0 = u.pm * BM + wr * 64 + fr; const int col0 = u.pn * BM + wc * 32 + 8 * fq;
        u32x4 pw[2][2][2], hw[2][2][2];
#define PLE_LOAD(set_, b_) do { _Pragma("unroll") for (int q_ = 0; q_ < 2; ++q_) { const long row_ = row0 + ((b_) >> 1) * HALF + (((b_) & 1) * 2 + q_) * 16; \
            _Pragma("unroll") for (int bj_ = 0; bj_ < 2; ++bj_) { const size_t off_ = (size_t)row_ * DM + col0 + bj_ * HALF; pw[set_][q_][bj_] = *(const u32x4*)(pp + off_); hw[set_][q_][bj_] = *(const u32x4*)(hin + off_); } } } while (0)
        PLE_LOAD(0, 0); PLE_LOAD(1, 1);
#pragma unroll
        for (int b = 0; b < 4; ++b) {
            const int set = b & 1, ai = b >> 1;
#pragma unroll
            for (int q = 0; q < 2; ++q) {
                const int m = (b & 1) * 2 + q;
                const long row = row0 + ai * HALF + m * 16;
                const float rs = rstd[ui * 256 + wr * 64 + fr + ai * HALF + m * 16];
                float sq = 0.f;
#pragma unroll
                for (int bj = 0; bj < 2; ++bj) {
                    const size_t off = (size_t)row * DM + col0 + bj * HALF;
                    const u32x4 pwv = pw[set][q][bj], hwv = hw[set][q][bj];
                    const f32x4 a0 = acc[ai][bj][m][0] * rs, a1 = acc[ai][bj][m][1] * rs;
                    f32x4 o0, o1;
                    o0[0] = bf_lo(hwv.x) + bf_lo(pwv.x) * sigmoidf_(a0[0]); o0[1] = bf_hi(hwv.x) + bf_hi(pwv.x) * sigmoidf_(a0[1]);
                    o0[2] = bf_lo(hwv.y) + bf_lo(pwv.y) * sigmoidf_(a0[2]); o0[3] = bf_hi(hwv.y) + bf_hi(pwv.y) * sigmoidf_(a0[3]);
                    o1[0] = bf_lo(hwv.z) + bf_lo(pwv.z) * sigmoidf_(a1[0]); o1[1] = bf_hi(hwv.z) + bf_hi(pwv.z) * sigmoidf_(a1[1]);
                    o1[2] = bf_lo(hwv.w) + bf_lo(pwv.w) * sigmoidf_(a1[2]); o1[3] = bf_hi(hwv.w) + bf_hi(pwv.w) * sigmoidf_(a1[3]);
                    if (outf) { *(f32x4*)(outf + off) = o0; *(f32x4*)(outf + off + 4) = o1; }
                    else {
                        sq += (o0[0] * o0[0] + o0[1] * o0[1]) + (o0[2] * o0[2] + o0[3] * o0[3]) + (o1[0] * o1[0] + o1[1] * o1[1]) + (o1[2] * o1[2] + o1[3] * o1[3]);
                        u32x4 w; w.x = cvt_pk_bf16(o0[0], o0[1]); w.y = cvt_pk_bf16(o0[2], o0[3]); w.z = cvt_pk_bf16(o1[0], o1[1]); w.w = cvt_pk_bf16(o1[2], o1[3]);
                        *(u32x4*)(hb + off) = w;
                    }
                }
                if (!outf) { sq += x16f(sq); sq += x32f(sq); if (fq == 0) sso[row * 16 + u.pn * 4 + wc] = sq; }
            }
            if (b + 2 < 4) { if (set == 0) PLE_LOAD(0, b + 2); else PLE_LOAD(1, b + 2); }
        }
#undef PLE_LOAD
    }
};
struct EpiPost {
    static constexpr bool PERM = true, AFTER_DRAIN = false;
    const bf16_t* base; bf16_t* hb; const float* gvec; float* sso; float* xbuf; unsigned* cnt_bank; unsigned* tmo; PG8_LAS unsigned char* tab;
    __device__ __forceinline__ void operator()(const f32x4 (&acc)[2][2][4][2], const Unit& u, int ui, int wr, int wc, int fr, int fq) const {
        const int wid = wr * 4 + wc, lane = fq * 16 + fr;
        unsigned* cnt = cnt_bank + u.pm * 64;
        u32x4 bpre[2][4][2];
        { const int colp = u.pn * BM + wc * 32 + 8 * fq;
#pragma unroll
          for (int ai = 0; ai < 2; ++ai)
#pragma unroll
            for (int m = 0; m < 4; ++m) { const size_t offp = (size_t)(u.pm * BM + ai * HALF + wr * 64 + m * 16 + fr) * DM + colp;
#pragma unroll
                for (int bj = 0; bj < 2; ++bj) bpre[ai][m][bj] = *(const u32x4*)(base + offp + bj * HALF); } }
        PG8_LAS float* P = (PG8_LAS float*)tab;
        PG8_LAS float* S = (PG8_LAS float*)(tab + 4096);
#pragma unroll
        for (int ai = 0; ai < 2; ++ai)
#pragma unroll
            for (int m = 0; m < 4; ++m) {
                float s = 0.f;
#pragma unroll
                for (int bj = 0; bj < 2; ++bj)
#pragma unroll
                    for (int n = 0; n < 2; ++n) { const f32x4 x = acc[ai][bj][m][n]; s += (x[0] * x[0] + x[1] * x[1]) + (x[2] * x[2] + x[3] * x[3]); }
                s += x16f(s); s += x32f(s);
                if (fq == 0) P[(ai * HALF + wr * 64 + m * 16 + fr) * 4 + wc] = s;
            }
        asm volatile("s_waitcnt lgkmcnt(0)" ::: "memory"); __builtin_amdgcn_s_barrier(); asm volatile("" ::: "memory");
        const int row = wid * 32 + (lane & 31);
        if (lane < 32) {
            const float tot = (P[row * 4 + 0] + P[row * 4 + 1]) + (P[row * 4 + 2] + P[row * 4 + 3]);
            __hip_atomic_store(xbuf + ((size_t)(u.pm * BM + row) * 4 + u.pn), tot, __ATOMIC_RELAXED, __HIP_MEMORY_SCOPE_AGENT);
        }
        asm volatile("s_waitcnt vmcnt(0)" ::: "memory");
        if (lane == 0) __hip_atomic_fetch_add(cnt, 1u, __ATOMIC_RELAXED, __HIP_MEMORY_SCOPE_AGENT);
        if (wid == 0) {
            unsigned spins = 0;
            while ((unsigned)__builtin_amdgcn_readfirstlane(__hip_atomic_load(cnt, __ATOMIC_RELAXED, __HIP_MEMORY_SCOPE_AGENT)) < 32u) {
                __builtin_amdgcn_s_sleep(2);
                if (++spins > (1u << 22)) { if (lane == 0) __hip_atomic_store(tmo, 1u, __ATOMIC_RELAXED, __HIP_MEMORY_SCOPE_AGENT); break; }
            }
            __builtin_amdgcn_fence(__ATOMIC_ACQUIRE, "agent");
        }
        asm volatile("s_waitcnt vmcnt(0) lgkmcnt(0)" ::: "memory"); __builtin_amdgcn_s_barrier(); asm volatile("" ::: "memory");
        if (lane < 32) {
            const float* slot = xbuf + (size_t)(u.pm * BM + row) * 4;
            float t0 = __hip_atomic_load(slot + 0, __ATOMIC_RELAXED, __HIP_MEMORY_SCOPE_AGENT);
            float t1 = __hip_atomic_load(slot + 1, __ATOMIC_RELAXED, __HIP_MEMORY_SCOPE_AGENT);
            float t2 = __hip_atomic_load(slot + 2, __ATOMIC_RELAXED, __HIP_MEMORY_SCOPE_AGENT);
            float t3 = __hip_atomic_load(slot + 3, __ATOMIC_RELAXED, __HIP_MEMORY_SCOPE_AGENT);
            S[row] = rsqrtf(((t0 + t1) + (t2 + t3)) * (1.0f / 1024.0f) + EPS);
        }
        asm volatile("s_waitcnt vmcnt(0) lgkmcnt(0)" ::: "memory"); __builtin_amdgcn_s_barrier(); asm volatile("" ::: "memory");
        const int col0 = u.pn * BM + wc * 32 + 8 * fq;
        f32x4 gv[2][2];
#pragma unroll
        for (int bj = 0; bj < 2; ++bj)
#pragma unroll
            for (int n = 0; n < 2; ++n) gv[bj][n] = *(const f32x4*)(gvec + col0 + bj * HALF + 4 * n);
#pragma unroll
        for (int ai = 0; ai < 2; ++ai)
#pragma unroll
            for (int m = 0; m < 4; ++m) {
                const int r = ai * HALF + wr * 64 + m * 16 + fr; const float rs = S[r];
                const size_t off = (size_t)(u.pm * BM + r) * DM + col0;
                float sq = 0.f;
#pragma unroll
                for (int bj = 0; bj < 2; ++bj) {
                    const u32x4 bw = bpre[ai][m][bj];
                    const f32x4 b0 = {bf_lo(bw.x), bf_hi(bw.x), bf_lo(bw.y), bf_hi(bw.y)}, b1 = {bf_lo(bw.z), bf_hi(bw.z), bf_lo(bw.w), bf_hi(bw.w)};
                    const f32x4 o0 = b0 + acc[ai][bj][m][0] * rs * gv[bj][0], o1 = b1 + acc[ai][bj][m][1] * rs * gv[bj][1];
                    sq += ((o0[0] * o0[0] + o0[1] * o0[1]) + (o0[2] * o0[2] + o0[3] * o0[3])) + ((o1[0] * o1[0] + o1[1] * o1[1]) + (o1[2] * o1[2] + o1[3] * o1[3]));
                    u32x4 w; w.x = cvt_pk_bf16(o0[0], o0[1]); w.y = cvt_pk_bf16(o0[2], o0[3]); w.z = cvt_pk_bf16(o1[0], o1[1]); w.w = cvt_pk_bf16(o1[2], o1[3]);
                    *(u32x4*)(hb + off + bj * HALF) = w;
                }
                sq += x16f(sq); sq += x32f(sq);
                if (fq == 0) sso[(size_t)(u.pm * BM + r) * 16 + u.pn * 4 + wc] = sq;
            }
    }
};

template <class Epi, class Sched, bool ALIGN_EPI>
__device__ __forceinline__ void gemm_phase(PG8_LAS unsigned char* lds, const Gemm g, const Sched& S, const Epi& E) {
    int tid_;
    {   int ln_; asm volatile("v_mbcnt_lo_u32_b32 %0, -1, 0\n\tv_mbcnt_hi_u32_b32 %0, -1, %0" : "=v"(ln_));
        const unsigned hw_ = (unsigned)__builtin_amdgcn_s_getreg((5 << 11) | 4) & 63u; unsigned to_ = LDS_WTAB; asm volatile("" : "+v"(to_));
        int wv_ = (int)((const PG8_LAS unsigned*)(lds + to_))[hw_]; wv_ = __builtin_amdgcn_readfirstlane(wv_); tid_ = wv_ * 64 + ln_; }
    asm volatile("" : "+v"(tid_));
    const int tid = tid_, wid = __builtin_amdgcn_readfirstlane(tid >> 6), lane = tid & 63, wr = wid >> 2, wc = wid & 3, fr = lane & 15, fq = lane >> 4;
    const int K = g.K, nt = K / BK;
    unsigned voffA[2], voffB[2];
#pragma unroll
    for (int i = 0; i < 2; ++i) { int R, C; stage_rc(tid * 16 + i * 8192, R, C); const int Rb = Epi::PERM ? ((R & ~31) + perm32(R & 31)) : R;
        voffA[i] = (unsigned)(R * g.lda + C) * 2u; voffB[i] = (unsigned)(Rb * g.ldb + C) * 2u; }
    const size_t kstepA = (size_t)g.a_kstep, hstepA = (size_t)g.a_hstep, tstepA = (size_t)g.a_tstep;
    const size_t kstepB = (size_t)(BK * 2), hstepB = (size_t)HALF * g.ldb * 2, tstepB = 2 * hstepB;
    const unsigned ldsw = (unsigned)wid * 1024u;
    const int aoff = lds_byte(wr * 64 + fr, fq * 8), boff = lds_byte(wc * 32 + fr, fq * 8);
#define PG8_SA(b, h) (((b) * 2 + (h)) * HTB)
#define PG8_SB(b, h) ((4 + (b) * 2 + (h)) * HTB)
#define PG8_STAGE(bufoff, gbase, voff) do { _Pragma("unroll") for (int _i = 0; _i < 2; ++_i) \
        __builtin_amdgcn_global_load_lds((const unsigned*)((const char*)(gbase) + (voff)[_i]), (PG8_LAS unsigned*)(lds + (bufoff) + ldsw + _i * 8192), 16, 0, 0); } while (0)
#define PG8_LDA(dst, b, h) do { _Pragma("unroll") for (int m = 0; m < 4; ++m) _Pragma("unroll") for (int k = 0; k < 2; ++k) dst[m][k] = *(const PG8_LAS bf16x8*)(lds + PG8_SA(b, h) + aoff + m * 2048 + k * 1024); } while (0)
#define PG8_LDB(dst, b, h) do { _Pragma("unroll") for (int n = 0; n < 2; ++n) _Pragma("unroll") for (int k = 0; k < 2; ++k) dst[n][k] = *(const PG8_LAS bf16x8*)(lds + PG8_SB(b, h) + boff + n * 2048 + k * 1024); } while (0)
#define PG8_MMA(ai, bj, At, Bt) do { __builtin_amdgcn_s_setprio(1); _Pragma("unroll") for (int m = 0; m < 4; ++m) _Pragma("unroll") for (int n = 0; n < 2; ++n) _Pragma("unroll") for (int k = 0; k < 2; ++k) \
        acc[ai][bj][m][n] = __builtin_amdgcn_mfma_f32_16x16x32_bf16(Bt[n][k], At[m][k], acc[ai][bj][m][n], 0, 0, 0); __builtin_amdgcn_s_setprio(0); } while (0)
#define PG8_WAIT_V(n) asm volatile("s_waitcnt vmcnt(" #n ")" ::: "memory")
#define PG8_WAIT_L(n) asm volatile("s_waitcnt lgkmcnt(" #n ")" ::: "memory")
#define PG8_BAR __builtin_amdgcn_s_barrier()
#define PG8_SCHED __builtin_amdgcn_sched_barrier(0)
    Unit cur, nxt; int ui = 0;
    if (!S.next(0, cur)) return;
    f32x4 acc[2][2][4][2];
#pragma unroll
    for (int a = 0; a < 2; ++a)
#pragma unroll
        for (int b = 0; b < 2; ++b)
#pragma unroll
            for (int m = 0; m < 4; ++m)
#pragma unroll
                for (int n = 0; n < 2; ++n) acc[a][b][m][n] = (f32x4){0.f, 0.f, 0.f, 0.f};
    bf16x8 At[4][2], B0[2][2], B1[2][2];
    const char* cA = (const char*)g.A + (size_t)cur.pm * tstepA; const char* cB = (const char*)g.Bt + (size_t)cur.pn * tstepB;
    PG8_STAGE(PG8_SB(0, 0), cB, voffB); PG8_STAGE(PG8_SB(0, 1), cB + hstepB, voffB); PG8_STAGE(PG8_SA(0, 0), cA, voffA); PG8_STAGE(PG8_SA(0, 1), cA + hstepA, voffA);
    if (wr == 1) PG8_BAR;
    PG8_WAIT_V(2); PG8_BAR;
    PG8_STAGE(PG8_SB(1, 0), cB + kstepB, voffB); PG8_STAGE(PG8_SA(1, 0), cA + kstepA, voffA); PG8_STAGE(PG8_SB(1, 1), cB + hstepB + kstepB, voffB);
    PG8_WAIT_V(6); PG8_BAR;
    for (;;) {
        const bool has_next = S.next(ui + 1, nxt);
        const char* nA = has_next ? (const char*)g.A + (size_t)nxt.pm * tstepA : cA; const char* nB = has_next ? (const char*)g.Bt + (size_t)nxt.pn * tstepB : cB;
        for (int t = 0; t < nt; t += 2) {
            const bool last = (t == nt - 2);
            const char* a1 = cA + (size_t)(t + 1) * kstepA;
            const char* a2 = last ? nA : cA + (size_t)(t + 2) * kstepA; const char* b2 = last ? nB : cB + (size_t)(t + 2) * kstepB;
            const char* a3 = a2 + kstepA; const char* b3 = b2 + kstepB;
            PG8_LDB(B0, 0, 0); PG8_LDB(B1, 0, 1); PG8_SCHED; PG8_LDA(At, 0, 0); PG8_STAGE(PG8_SA(1, 1), a1 + hstepA, voffA);
            PG8_WAIT_V(8); PG8_WAIT_L(0); PG8_BAR; PG8_MMA(0, 0, At, B0); PG8_MMA(0, 1, At, B1); PG8_BAR; PG8_SCHED;
            PG8_LDA(At, 0, 1); PG8_STAGE(PG8_SB(0, 0), b2, voffB); PG8_STAGE(PG8_SB(0, 1), b2 + hstepB, voffB); PG8_STAGE(PG8_SA(0, 0), a2, voffA);
            PG8_WAIT_V(8); PG8_WAIT_L(0); PG8_BAR; PG8_MMA(1, 0, At, B0); PG8_MMA(1, 1, At, B1); PG8_BAR; PG8_SCHED;
            PG8_LDB(B0, 1, 0); PG8_LDB(B1, 1, 1); PG8_SCHED; PG8_LDA(At, 1, 0); PG8_STAGE(PG8_SA(0, 1), a2 + hstepA, voffA);
            PG8_WAIT_V(8); PG8_WAIT_L(0); PG8_BAR; PG8_MMA(0, 0, At, B0); PG8_MMA(0, 1, At, B1); PG8_BAR; PG8_SCHED;
            PG8_LDA(At, 1, 1); PG8_STAGE(PG8_SB(1, 0), b3, voffB); PG8_STAGE(PG8_SB(1, 1), b3 + hstepB, voffB); PG8_STAGE(PG8_SA(1, 0), a3, voffA);
            PG8_WAIT_V(8); PG8_WAIT_L(0); PG8_BAR; PG8_MMA(1, 0, At, B0); PG8_MMA(1, 1, At, B1); PG8_BAR; PG8_SCHED;
        }
        if constexpr (ALIGN_EPI) { if (wr == 0) PG8_BAR; }
        if constexpr (!Epi::AFTER_DRAIN) { E(acc, cur, ui, wr, wc, fr, fq); }
        if (!has_next) break;
#pragma unroll
        for (int a = 0; a < 2; ++a)
#pragma unroll
            for (int b = 0; b < 2; ++b)
#pragma unroll
                for (int m = 0; m < 4; ++m)
#pragma unroll
                    for (int n = 0; n < 2; ++n) acc[a][b][m][n] = (f32x4){0.f, 0.f, 0.f, 0.f};
        cur = nxt; cA = nA; cB = nB; ++ui;
        if constexpr (ALIGN_EPI) { if (wr == 1) PG8_BAR; }
    }
    PG8_WAIT_V(0);
    if constexpr (!ALIGN_EPI) { if (wr == 0) PG8_BAR; }
    PG8_BAR;
    if constexpr (Epi::AFTER_DRAIN) { E.fused(acc, cur, wr, wc, fr, fq, lds, wid, lane); }
#undef PG8_SA
#undef PG8_SB
#undef PG8_STAGE
#undef PG8_LDA
#undef PG8_LDB
#undef PG8_MMA
#undef PG8_WAIT_V
#undef PG8_WAIT_L
#undef PG8_BAR
#undef PG8_SCHED
}
}

#define XB_TMO      128
#define XB_XCNT(j)  (256  + 64 * (j))
#define XB_XSUB(j)  (1280 + 64 * (j))
#define XB_XGEN(j)  (2304 + 64 * (j))
#define XB_TOP      3328
#define XB_TOPGEN   3392
#define XCD_BAR_WORDS 3456
#define XB_SPIN_CAP (1u << 20)
__device__ __forceinline__ unsigned xb_ld(unsigned* p)              { return __hip_atomic_load(p, __ATOMIC_RELAXED, __HIP_MEMORY_SCOPE_AGENT); }
__device__ __forceinline__ unsigned xb_add(unsigned* p, unsigned v) { return __hip_atomic_fetch_add(p, v, __ATOMIC_RELAXED, __HIP_MEMORY_SCOPE_AGENT); }
__device__ __forceinline__ unsigned xb_xcc_id() { return (unsigned)__builtin_amdgcn_s_getreg((3 << 11) | 20) & 0xFu; }
#define XB_SPIN(cond, bar) do { unsigned _sp = 0; while (cond) { __builtin_amdgcn_s_sleep(1); \
    if ((++_sp & 255u) == 0u) { if (xb_ld(&(bar)[XB_TMO])) break; if (_sp > XB_SPIN_CAP) { atomicAdd(&(bar)[XB_TMO], 1u); break; } } } } while (0)
__device__ __forceinline__ void xcd_barrier_complete(unsigned* bar, unsigned x, unsigned G, unsigned& nloc, unsigned& nx) {
    unsigned sum, cnt, mine, sp = 0u;
    for (;;) {
        sum = 0u; cnt = 0u; mine = 0u;
#pragma unroll
        for (unsigned j = 0; j < 16; ++j) { const unsigned c = xb_ld(&bar[XB_XCNT(j)]); sum += c; cnt += (c > 0u) ? 1u : 0u; mine = (j == x) ? c : mine; }
        if (sum == G) break;
        __builtin_amdgcn_s_sleep(1);
        if ((++sp & 255u) == 0u) { if (xb_ld(&bar[XB_TMO])) break; if (sp > XB_SPIN_CAP) { atomicAdd(&bar[XB_TMO], 1u); break; } }
    }
    nloc = mine > 0u ? mine : 1u; nx = cnt > 0u ? cnt : 1u;
}
__device__ __forceinline__ void xcd_barrier(unsigned* bar, volatile LAS unsigned* st, bool leader_thread, unsigned G) {
    asm volatile("s_waitcnt vmcnt(0)" ::: "memory");
    __syncthreads();
    if (leader_thread) {
        const unsigned x = xb_xcc_id();
        __builtin_amdgcn_s_waitcnt(0);
        unsigned nloc = st[0], nx = st[1];
        if (nloc == 0u) { xcd_barrier_complete(bar, x, G, nloc, nx); st[0] = nloc; st[1] = nx; }
        const unsigned old = xb_add(&bar[XB_XSUB(x)], 1u);
        const unsigned gen = old / nloc;
        if (old + 1u == (gen + 1u) * nloc) {
            __builtin_amdgcn_fence(__ATOMIC_RELEASE, "agent");
            asm volatile("s_waitcnt vmcnt(0)" ::: "memory");
            const unsigned og = xb_add(&bar[XB_TOP], 1u);
            const unsigned tg = og / nx;
            if (og + 1u == (tg + 1u) * nx) xb_add(&bar[XB_TOPGEN], 1u);
            else XB_SPIN(xb_ld(&bar[XB_TOPGEN]) == tg, bar);
            __builtin_amdgcn_fence(__ATOMIC_ACQUIRE, "agent");
            xb_add(&bar[XB_XGEN(x)], 1u);
            asm volatile("s_waitcnt vmcnt(0)" ::: "memory");
        } else {
            XB_SPIN(xb_ld(&bar[XB_XGEN(x)]) == gen, bar);
            __builtin_amdgcn_fence(__ATOMIC_ACQUIRE, "agent");
            asm volatile("s_waitcnt vmcnt(0)" ::: "memory");
        }
    }
    __syncthreads();
}

struct Args {
    const float* x; const float* p; const float* w_in; const float* w_out; const float* cmp_pos; const float* cmp_w1; const float* cmp_w2; const float* hg_lb;
    const float* g_pre_mix; const float* g_post_mix; const float* g_pre_mlp; const float* g_post_mlp; const float* w_up; const float* w_down; const float* g_ple;
    const float* w_ple_gate; const float* w_ple_proj;
    float* out; unsigned char* ws; int ph_lo, ph_hi;
};

struct Frame {
    LAS unsigned char* lds;
    int tid, lane, wave, G, bid;
    unsigned char* ws;
};

template <class T> __device__ __forceinline__ T* uptr(T* p) {
    const unsigned long long v = (unsigned long long)p; const unsigned lo = __builtin_amdgcn_readfirstlane((unsigned)v), hi = __builtin_amdgcn_readfirstlane((unsigned)(v >> 32));
    return (T*)(__attribute__((address_space(1))) T*)(((unsigned long long)hi << 32) | lo);
}
__device__ __forceinline__ Frame make_frame(LAS unsigned char* lds, Args& A) {
    Frame G; G.lds = lds;
    int lane; asm volatile("v_mbcnt_lo_u32_b32 %0, -1, 0\n\tv_mbcnt_hi_u32_b32 %0, -1, %0" : "=v"(lane));
    const unsigned hw = (unsigned)__builtin_amdgcn_s_getreg((5 << 11) | 4) & 63u;
    unsigned aoff = LDS_ARGS; asm volatile("" : "+v"(aoff));
    int wave = (int)((const LAS unsigned*)(lds + aoff + (LDS_WTAB - LDS_ARGS)))[hw];
    wave = __builtin_amdgcn_readfirstlane(wave);
    asm volatile("" : "+s"(wave));
    G.lane = lane; G.wave = wave; G.tid = wave * 64 + lane;
    int bid = blockIdx.x, gg = gridDim.x; asm volatile("" : "+s"(bid), "+s"(gg));
    G.bid = bid; G.G = gg;
    const LAS Args* la = (const LAS Args*)(lds + aoff);
    A.x = uptr(la->x); A.p = uptr(la->p); A.w_in = uptr(la->w_in); A.w_out = uptr(la->w_out); A.cmp_pos = uptr(la->cmp_pos); A.cmp_w1 = uptr(la->cmp_w1); A.cmp_w2 = uptr(la->cmp_w2);
    A.hg_lb = uptr(la->hg_lb); A.g_pre_mix = uptr(la->g_pre_mix); A.g_post_mix = uptr(la->g_post_mix); A.g_pre_mlp = uptr(la->g_pre_mlp); A.g_post_mlp = uptr(la->g_post_mlp);
    A.w_up = uptr(la->w_up); A.w_down = uptr(la->w_down); A.g_ple = uptr(la->g_ple); A.w_ple_gate = uptr(la->w_ple_gate); A.w_ple_proj = uptr(la->w_ple_proj);
    A.out = uptr(la->out); A.ws = uptr(la->ws); A.ph_lo = 0; A.ph_hi = 0;
    G.ws = A.ws;
    return G;
}
template <class Sched> __device__ __forceinline__ void fill_rstd(const Frame& F, const float* ss, const Sched& S) {
    LAS float* tab = (LAS float*)(F.lds + LDS_RSTD);
    const int half = F.tid >> 8, r = F.tid & 255;
#pragma unroll 1
    for (int i0 = 0; i0 < 8; i0 += 2) {
        pg8::Unit u; if (!S.next(i0 + half, u)) continue;
        tab[(i0 + half) * 256 + r] = pg8::row_rstd16(ss, (long)u.pm * 256 + r);
    }
    __syncthreads();
}
__device__ __forceinline__ void transpose_item(const float* W, int ldw, int col0, int k0, bf16_t* WT, int ldk, int drow0, const float* gsc, int lane) {
    float v[64];
    const float* src = W + (size_t)k0 * ldw + col0 + lane;
#pragma unroll
    for (int k = 0; k < 64; ++k) v[k] = src[(size_t)k * ldw];
    if (gsc) {
#pragma unroll
        for (int k = 0; k < 64; ++k) v[k] *= gsc[k0 + k];
    }
    bf16_t* dst = WT + (size_t)(drow0 + lane) * ldk + k0;
#pragma unroll
    for (int c = 0; c < 8; ++c) { u32x4 o; o.x = pk2(v[8 * c], v[8 * c + 1]); o.y = pk2(v[8 * c + 2], v[8 * c + 3]); o.z = pk2(v[8 * c + 4], v[8 * c + 5]); o.w = pk2(v[8 * c + 6], v[8 * c + 7]); *(u32x4*)(dst + 8 * c) = o; }
}

__device__ __forceinline__ void phase_prologue(const Frame& F, const Args& a) {
    const int gw = F.bid * 8 + F.wave, NGW = F.G * 8;
    {
        constexpr int I_IN1 = 16 * 18, I_IN2 = 16 * 34, I_OUT = 16 * 16, I_UP = 16 * 64, I_DN = 64 * 16, I_G = 16 * 16, I_PJ = 4 * 16, I_C1 = 32 * 4;
        constexpr int I_LAYER = I_IN1 + I_IN2 + I_OUT + I_UP + I_DN + I_G + I_PJ + 2 * I_C1;
        for (int it = gw; it < DEPTH * I_LAYER; it += NGW) {
            const int l = it / I_LAYER; int r = it % I_LAYER;
            const float* W; int ldw, col0, K; bf16_t* WT; int drow0; const float* gsc = nullptr;
            if (r < I_IN1) { W = a.w_in + (size_t)l * DM * IN_TOTAL; ldw = IN_TOTAL; col0 = 0; K = DM; WT = (bf16_t*)(F.ws + WS_WIN) + (size_t)l * NPROJ * DM; drow0 = 0; gsc = a.g_pre_mix + l * DM; }
            else if ((r -= I_IN1) < I_IN2) { W = a.w_in + (size_t)l * DM * IN_TOTAL; ldw = IN_TOTAL; col0 = 1170; K = DM; WT = (bf16_t*)(F.ws + WS_WIN) + (size_t)l * NPROJ * DM; drow0 = 1152; gsc = a.g_pre_mix + l * DM; }
            else if ((r -= I_IN2) < I_OUT) { W = a.w_out + (size_t)l * DM * DM; ldw = DM; col0 = 0; K = DM; WT = (bf16_t*)(F.ws + WS_WOUT) + (size_t)l * DM * DM; drow0 = 0; }
            else if ((r -= I_OUT) < I_UP) { W = a.w_up + (size_t)l * DM * FF; ldw = FF; col0 = 0; K = DM; WT = (bf16_t*)(F.ws + WS_WUP) + (size_t)l * FF * DM; drow0 = 0; gsc = a.g_pre_mlp + l * DM; }
            else if ((r -= I_UP) < I_DN) { W = a.w_down + (size_t)l * FF * DM; ldw = DM; col0 = 0; K = FF; WT = (bf16_t*)(F.ws + WS_WDN) + (size_t)l * DM * FF; drow0 = 0; }
            else if ((r -= I_DN) < I_G) { W = a.w_ple_gate + (size_t)l * DM * DM; ldw = DM; col0 = 0; K = DM; WT = (bf16_t*)(F.ws + WS_WG) + (size_t)l * DM * DM; drow0 = 0; gsc = a.g_ple + l * DM; }
            else if ((r -= I_G) < I_PJ) { W = a.w_ple_proj + (size_t)l * PLE * DM; ldw = DM; col0 = 0; K = PLE; WT = (bf16_t*)(F.ws + WS_WPJ) + (size_t)l * DM * PLE; drow0 = 0; }
            else { r -= I_PJ; const int kv = r / I_C1; r -= kv * I_C1; W = a.cmp_w1 + (size_t)(l * 2 + kv) * 2048 * 256; ldw = 256; col0 = 0; K = 2048; WT = (bf16_t*)(F.ws + WS_W1T) + (size_t)(l * 2 + kv) * 256 * 2048; drow0 = 0; }
            const int nk = K / 64, nb = r / nk, kb = r % nk;
            transpose_item(W, ldw, col0 + 64 * nb, 64 * kb, WT, K, drow0 + 64 * nb, gsc, F.lane);
        }
    }
    for (int l = 0; l < DEPTH; ++l) {
        bf16_t* WIN = (bf16_t*)(F.ws + WS_WIN) + (size_t)l * NPROJ * DM;
        const float* win = a.w_in + (size_t)l * DM * IN_TOTAL; const float* gs = a.g_pre_mix + l * DM;
        for (int idx = F.bid * 512 + F.tid; idx < 256 * DM; idx += F.G * 512) {
            const int r = idx >> 10, k = idx & 1023;
            float v = 0.f; if (r < 18) v = win[(size_t)k * IN_TOTAL + 1152 + r] * gs[k];
            WIN[(size_t)(3328 + r) * DM + k] = (bf16_t)f2bf(v);
        }
    }
    {
        bf16_t* HBB = (bf16_t*)a.out; float* SSB = (float*)(F.ws + WS_SSB);
        for (int m = gw * 2; m < MTOK; m += NGW * 2) {
            const f32x4* xr = (const f32x4*)(a.x + (size_t)m * DM) + F.lane;
            f32x4 v[8]; float s0 = 0.f, s1 = 0.f;
#pragma unroll
            for (int j = 0; j < 8; ++j) v[j] = xr[64 * j];
#pragma unroll
            for (int j = 0; j < 4; ++j) { s0 += (v[j].x * v[j].x + v[j].y * v[j].y) + (v[j].z * v[j].z + v[j].w * v[j].w); s1 += (v[j + 4].x * v[j + 4].x + v[j + 4].y * v[j + 4].y) + (v[j + 4].z * v[j + 4].z + v[j + 4].w * v[j + 4].w); }
            s0 = wave_sum(s0); s1 = wave_sum(s1);
            unsigned long long* o8 = (unsigned long long*)(HBB + (size_t)m * DM) + F.lane;
#pragma unroll
            for (int j = 0; j < 8; ++j) o8[64 * j] = (unsigned long long)pk2(v[j].x, v[j].y) | ((unsigned long long)pk2(v[j].z, v[j].w) << 32);
            if (F.lane < 32) SSB[(size_t)m * 16 + F.lane] = (F.lane == 0) ? s0 : ((F.lane == 16) ? s1 : 0.f);
        }
    }
    {
        float* part = (float*)(F.ws + WS_B1P);
        for (int it = gw; it < 4 * 16 * 4; it += NGW) {
            const int jb = it & 3, c = (it >> 2) & 15, lk = it >> 6;
            const float* pos = a.cmp_pos + (size_t)lk * 2048; const float* w1 = a.cmp_w1 + (size_t)lk * 2048 * 256;
            const int j = jb * 64 + F.lane; float s = 0.f;
#pragma unroll 32
            for (int k = c * 128; k < c * 128 + 128; ++k) s += pos[k] * w1[(size_t)k * 256 + j];
            part[(size_t)(lk * 16 + c) * 256 + j] = s;
        }
    }
}

__device__ __forceinline__ void reduce_bias1(const Frame& F) {
    if (F.bid != 0) return;
    const float* part = (const float*)(F.ws + WS_B1P); float* fin = (float*)(F.ws + WS_B1P + 65536);
    for (int idx = F.tid; idx < 4 * 256; idx += 512) { const int lk = idx >> 8, j = idx & 255; float s = 0.f;
        for (int c = 0; c < 16; ++c) s += part[(size_t)(lk * 16 + c) * 256 + j];
        fin[idx] = s; }
}

__device__ __forceinline__ void convert_p(const Frame& F, const Args& a, int l) {
    const float* src = a.p + (size_t)l * MTOK * PLE; bf16_t* PB = (bf16_t*)(F.ws + WS_PB);
    const size_t n8 = (size_t)MTOK * PLE / 8;
    for (size_t i = (size_t)F.bid * 512 + F.tid; i < n8; i += (size_t)F.G * 512) {
        const f32x4 v0 = *(const f32x4*)(src + i * 8), v1 = *(const f32x4*)(src + i * 8 + 4);
        u32x4 w; w.x = pk2(v0.x, v0.y); w.y = pk2(v0.z, v0.w); w.z = pk2(v1.x, v1.y); w.w = pk2(v1.z, v1.w);
        *(u32x4*)(PB + i * 8) = w;
    }
}

__device__ __forceinline__ void load64(const bf16_t* p, float (&v)[64], float sc) {
    const u32x4* p4 = (const u32x4*)p;
#pragma unroll
    for (int i = 0; i < 8; ++i) { const u32x4 w = p4[i];
        v[8 * i + 0] = bf_lo(w.x) * sc; v[8 * i + 1] = bf_hi(w.x) * sc; v[8 * i + 2] = bf_lo(w.y) * sc; v[8 * i + 3] = bf_hi(w.y) * sc;
        v[8 * i + 4] = bf_lo(w.z) * sc; v[8 * i + 5] = bf_hi(w.z) * sc; v[8 * i + 6] = bf_lo(w.w) * sc; v[8 * i + 7] = bf_hi(w.w) * sc; }
}
__device__ __forceinline__ void stage_bf16(LAS float* dst, const bf16_t* src, int ld, int tid) {
    const int r = tid >> 3, c = tid & 7;
    const u32x4 w = *(const u32x4*)(src + (size_t)r * ld + c * 8);
    const f32x4 v0 = {bf_lo(w.x), bf_hi(w.x), bf_lo(w.y), bf_hi(w.y)}, v1 = {bf_lo(w.z), bf_hi(w.z), bf_lo(w.w), bf_hi(w.w)};
    *(LAS f32x4*)(dst + r * 64 + c * 8) = v0; *(LAS f32x4*)(dst + r * 64 + c * 8 + 4) = v1;
}
__device__ __forceinline__ void stage_f32(LAS float* dst, const float* src, int tid) {
    const int r = tid >> 3, c = tid & 7;
    const f32x4 v0 = *(const f32x4*)(src + r * 64 + c * 8), v1 = *(const f32x4*)(src + r * 64 + c * 8 + 4);
    *(LAS f32x4*)(dst + r * 64 + c * 8) = v0; *(LAS f32x4*)(dst + r * 64 + c * 8 + 4) = v1;
}
__device__ __forceinline__ float dot64(const LAS float* kr, const float (&q)[64]) {
    float s0 = 0.f, s1 = 0.f, s2 = 0.f, s3 = 0.f;
#pragma unroll
    for (int d = 0; d < 64; d += 4) { const f32x4 kv = *(const LAS f32x4*)(kr + d); s0 += q[d] * kv.x; s1 += q[d + 1] * kv.y; s2 += q[d + 2] * kv.z; s3 += q[d + 3] * kv.w; }
    return (s0 + s1) + (s2 + s3);
}
template <class FN>
__device__ __forceinline__ void attend64(const LAS float* Kt, const LAS float* Vt, const float (&q)[64], float (&o)[64], float& m, float& l, FN fn) {
#pragma unroll 1
    for (int j = 0; j < 64; ++j) {
        float bias; if (!fn(j, bias)) continue;
        const float s = dot64(Kt + j * 64, q) + bias;
        if (s > m) { const float c = __expf(m - s); l *= c;
#pragma unroll
            for (int d = 0; d < 64; ++d) o[d] *= c;
            m = s; }
        const float pr = __expf(s - m); l += pr;
#pragma unroll
        for (int d = 0; d < 64; d += 4) { const f32x4 vv = *(const LAS f32x4*)(Vt + j * 64 + d); o[d] += pr * vv.x; o[d + 1] += pr * vv.y; o[d + 2] += pr * vv.z; o[d + 3] += pr * vv.w; }
    }
}
__device__ __forceinline__ float nsa_slope(int h) {
    const int idx = (h >> 1) * 4 + 2 + (h & 1);
    return exp2f(-2.0f * (float)(idx + 1) / 3.0f);
}
__device__ __forceinline__ float dil_slope(int h) {
    const int idx = (h >> 1) * 4 + (h & 1);
    return exp2f(-2.0f * (float)(idx + 1) / 3.0f);
}

namespace att {
typedef short bf16x8 __attribute__((ext_vector_type(8)));
typedef short v4i16 __attribute__((ext_vector_type(4)));
typedef __bf16 bf16x2_t __attribute__((ext_vector_type(2)));
constexpr float NEG = -1e30f, MFLOOR = -1e20f, LOG2E = 1.4426950408889634f, LN2 = 0.6931471805599453f;
constexpr int TILE_BYTES = 8192;
__device__ __forceinline__ int k_off(int row, int ch) { return row * 128 + ((ch ^ ((row >> 1) & 7)) << 4); }
__device__ __forceinline__ int v_off(int row, int byte) { return row * 128 + (byte ^ (((row >> 1) & 3) << 5)); }
__device__ __forceinline__ unsigned cvtpk(float lo, float hi) { f32x2 v = {lo, hi}; bf16x2_t b = __builtin_convertvector(v, bf16x2_t); return __builtin_bit_cast(unsigned, b); }

template <int NH> struct State { f32x4 O[NH][4]; float m[NH], l[NH]; };
template <int NH> __device__ __forceinline__ void state_reset(State<NH>& st, float m0 = MFLOOR) {
#pragma unroll
    for (int g = 0; g < NH; ++g) { st.m[g] = m0; st.l[g] = 0.f;
#pragma unroll
        for (int nt = 0; nt < 4; ++nt) st.O[g][nt] = (f32x4){0.f, 0.f, 0.f, 0.f}; }
}
struct Lane { int c, grp; int kb0, kb1; int vb[4]; };
__device__ __forceinline__ Lane make_lane(int lane) {
    Lane L; L.c = lane & 15; L.grp = lane >> 4;
    L.kb0 = k_off(L.c, L.grp); L.kb1 = k_off(L.c, 4 + L.grp);
    const int i = L.c, sw = ((L.grp & 1) << 1) | (i >> 3);
#pragma unroll
    for (int nt = 0; nt < 4; ++nt) L.vb[nt] = (4 * L.grp + (i >> 2)) * 128 + ((32 * nt + 8 * (i & 3)) ^ (sw << 5));
    return L;
}
struct StageRegs { u32x4 k, v; };
__device__ __forceinline__ void stage_load(StageRegs& r, const bf16_t* srcK, const bf16_t* srcV, long ld, int tid) {
    const int R = tid >> 3, ch = tid & 7;
    r.k = *(const u32x4*)(srcK + (size_t)R * ld + ch * 8); r.v = *(const u32x4*)(srcV + (size_t)R * ld + ch * 8);
}
__device__ __forceinline__ void stage_store(const StageRegs& r, LAS unsigned char* Kt, LAS unsigned char* Vt, int tid) {
    const int R = tid >> 3, ch = tid & 7;
    *(LAS u32x4*)(Kt + k_off(R, ch)) = r.k; *(LAS u32x4*)(Vt + v_off(R, ch * 16)) = r.v;
}
template <int NH> __device__ __forceinline__ void scores(const LAS unsigned char* Kt, const Lane& L, const bf16x8 (&qf)[NH][2], const float (&slope)[NH], float brel, f32x4 (&S)[NH][4]) {
#pragma unroll
    for (int g = 0; g < NH; ++g) { const float sb = slope[g] * brel;
#pragma unroll
        for (int kt = 0; kt < 4; ++kt)
#pragma unroll
            for (int r = 0; r < 4; ++r) S[g][kt][r] = __builtin_fmaf(slope[g], (float)(16 * kt + r), sb); }
#pragma unroll
    for (int kt = 0; kt < 4; ++kt) {
        const bf16x8 k0 = *(const LAS bf16x8*)(Kt + L.kb0 + kt * 2048), k1 = *(const LAS bf16x8*)(Kt + L.kb1 + kt * 2048);
#pragma unroll
        for (int g = 0; g < NH; ++g) {
            S[g][kt] = __builtin_amdgcn_mfma_f32_16x16x32_bf16(k0, qf[g][0], S[g][kt], 0, 0, 0);
            S[g][kt] = __builtin_amdgcn_mfma_f32_16x16x32_bf16(k1, qf[g][1], S[g][kt], 0, 0, 0);
        }
    }
}
template <int NH> __device__ __forceinline__ void scores_lds(const LAS unsigned char* Kt, const Lane& L, const LAS unsigned char* qlds, int lane, const float (&slope)[NH], float brel, f32x4 (&S)[NH][4]) {
    bf16x8 kf[4][2];
#pragma unroll
    for (int kt = 0; kt < 4; ++kt) { kf[kt][0] = *(const LAS bf16x8*)(Kt + L.kb0 + kt * 2048); kf[kt][1] = *(const LAS bf16x8*)(Kt + L.kb1 + kt * 2048); }
#pragma unroll
    for (int g = 0; g < NH; ++g) {
        const bf16x8 q0 = *(const LAS bf16x8*)(qlds + ((g * 2 + 0) * 64 + lane) * 16), q1 = *(const LAS bf16x8*)(qlds + ((g * 2 + 1) * 64 + lane) * 16);
        const float sb = slope[g] * brel;
#pragma unroll
        for (int kt = 0; kt < 4; ++kt) {
#pragma unroll
            for (int r = 0; r < 4; ++r) S[g][kt][r] = __builtin_fmaf(slope[g], (float)(16 * kt + r), sb);
            S[g][kt] = __builtin_amdgcn_mfma_f32_16x16x32_bf16(kf[kt][0], q0, S[g][kt], 0, 0, 0);
            S[g][kt] = __builtin_amdgcn_mfma_f32_16x16x32_bf16(kf[kt][1], q1, S[g][kt], 0, 0, 0);
        }
    }
}
template <int NH> __device__ __forceinline__ void mask(f32x4 (&S)[NH][4], int drel, int dlo, bool row_on) {
#pragma unroll
    for (int kt = 0; kt < 4; ++kt)
#pragma unroll
        for (int r = 0; r < 4; ++r) { const int dl = drel + 16 * kt + r; const bool ok = row_on && dl <= 0 && dl >= dlo;
#pragma unroll
            for (int g = 0; g < NH; ++g) S[g][kt][r] = ok ? S[g][kt][r] : NEG; }
}
template <int NH> __device__ __forceinline__ void online(f32x4 (&S)[NH][4], State<NH>& st) {
#pragma unroll
    for (int g = 0; g < NH; ++g) {
        float mx = fmaxf(fmaxf(S[g][0][0], S[g][0][1]), fmaxf(S[g][0][2], S[g][0][3]));
#pragma unroll
        for (int kt = 1; kt < 4; ++kt) mx = fmaxf(mx, fmaxf(fmaxf(S[g][kt][0], S[g][kt][1]), fmaxf(S[g][kt][2], S[g][kt][3])));
        mx = fmaxf(mx, x16f(mx)); mx = fmaxf(mx, x32f(mx));
        const float mnew = fmaxf(st.m[g], mx);
        const float alpha = __builtin_amdgcn_exp2f(st.m[g] - mnew);
        st.m[g] = mnew; st.l[g] *= alpha;
#pragma unroll
        for (int nt = 0; nt < 4; ++nt) st.O[g][nt] = st.O[g][nt] * alpha;
        float ls = 0.f;
#pragma unroll
        for (int kt = 0; kt < 4; ++kt)
#pragma unroll
            for (int r = 0; r < 4; ++r) { const float pr = __builtin_amdgcn_exp2f(S[g][kt][r] - mnew); S[g][kt][r] = pr; ls += pr; }
        st.l[g] += ls;
    }
}
template <int NH> __device__ __forceinline__ void pv(const LAS unsigned char* Vt, const Lane& L, const f32x4 (&P)[NH][4], State<NH>& st) {
#pragma unroll
    for (int s2 = 0; s2 < 2; ++s2) {
        bf16x8 pf[NH];
#pragma unroll
        for (int g = 0; g < NH; ++g) { u32x4 w; w.x = cvtpk(P[g][2 * s2][0], P[g][2 * s2][1]); w.y = cvtpk(P[g][2 * s2][2], P[g][2 * s2][3]);
            w.z = cvtpk(P[g][2 * s2 + 1][0], P[g][2 * s2 + 1][1]); w.w = cvtpk(P[g][2 * s2 + 1][2], P[g][2 * s2 + 1][3]); pf[g] = __builtin_bit_cast(bf16x8, w); }
#pragma unroll
        for (int nt = 0; nt < 4; ++nt) {
            const v4i16 lo = __builtin_amdgcn_ds_read_tr16_b64_v4i16((LAS v4i16*)(Vt + L.vb[nt] + 4096 * s2));
            const v4i16 hi = __builtin_amdgcn_ds_read_tr16_b64_v4i16((LAS v4i16*)(Vt + L.vb[nt] + 4096 * s2 + 2048));
            const bf16x8 vf = {lo[0], lo[1], lo[2], lo[3], hi[0], hi[1], hi[2], hi[3]};
#pragma unroll
            for (int g = 0; g < NH; ++g) st.O[g][nt] = __builtin_amdgcn_mfma_f32_16x16x32_bf16(vf, pf[g], st.O[g][nt], 0, 0, 0);
        }
    }
}
constexpr float BIGD = 1e30f, RTHR = 8.0f;
template <int NH, int MODE> __device__ __forceinline__ void tile_heads(const LAS unsigned char* Kt, const LAS unsigned char* Vt, const Lane& L, const LAS unsigned char* qlds, int lane,
        const float (&slope)[NH], float brel, int drel, int dlo, bool row_on, bool need_mask, State<NH>& st, const float (&mfix)[NH], const float (&ilfix)[NH], float (&impm)[4], float (&impn)[4]) {
    f32x4 S[NH][4];
    {
        f32x4 dm[4];
#pragma unroll
        for (int kt = 0; kt < 4; ++kt)
#pragma unroll
            for (int r = 0; r < 4; ++r) dm[kt][r] = brel + (float)(16 * kt + r);
        if (need_mask) {
#pragma unroll
            for (int kt = 0; kt < 4; ++kt)
#pragma unroll
                for (int r = 0; r < 4; ++r) { const int dl = drel + 16 * kt + r; dm[kt][r] = (row_on && dl <= 0 && dl >= dlo) ? dm[kt][r] : -BIGD; }
        }
        bf16x8 kf[4][2];
#pragma unroll
        for (int kt = 0; kt < 4; ++kt) { kf[kt][0] = *(const LAS bf16x8*)(Kt + L.kb0 + kt * 2048); kf[kt][1] = *(const LAS bf16x8*)(Kt + L.kb1 + kt * 2048); }
        __builtin_amdgcn_s_setprio(1);
#pragma unroll
        for (int g = 0; g < NH; ++g) {
            const bf16x8 q0 = *(const LAS bf16x8*)(qlds + ((g * 2 + 0) * 64 + lane) * 16), q1 = *(const LAS bf16x8*)(qlds + ((g * 2 + 1) * 64 + lane) * 16);
            float mref = st.m[g]; asm volatile("" : "+v"(mref));
#pragma unroll
            for (int kt = 0; kt < 4; ++kt) {
                S[g][kt] = (MODE == 0) ? dm[kt] * slope[g] - mref : dm[kt] * slope[g];
                S[g][kt] = __builtin_amdgcn_mfma_f32_16x16x32_bf16(kf[kt][0], q0, S[g][kt], 0, 0, 0);
                S[g][kt] = __builtin_amdgcn_mfma_f32_16x16x32_bf16(kf[kt][1], q1, S[g][kt], 0, 0, 0);
            }
        }
        __builtin_amdgcn_s_setprio(0);
    }
    bf16x8 pf[NH][2];
#pragma unroll
    for (int g = 0; g < NH; ++g) {
        if (MODE == 2) {
#pragma unroll
            for (int kt = 0; kt < 4; ++kt) {
#pragma unroll
                for (int r = 0; r < 4; ++r) S[g][kt][r] = __builtin_amdgcn_exp2f(S[g][kt][r] - mfix[g]) * ilfix[g];
                impm[kt] += (S[g][kt][0] + S[g][kt][1]) + (S[g][kt][2] + S[g][kt][3]); impn[kt] += S[g][kt][3];
            }
        } else if (MODE == 0) {
            float mg = st.m[g], lg = st.l[g];
            float ls = 0.f; u32x4 w0, w1;
#define TH_EXPPACK(dl_) do { float p_[4][4]; ls = 0.f; \
                _Pragma("unroll") for (int kt = 0; kt < 4; ++kt) _Pragma("unroll") for (int r = 0; r < 4; ++r) { p_[kt][r] = __builtin_amdgcn_exp2f(S[g][kt][r] - (dl_)); ls += p_[kt][r]; } \
                w0.x = cvtpk(p_[0][0], p_[0][1]); w0.y = cvtpk(p_[0][2], p_[0][3]); w0.z = cvtpk(p_[1][0], p_[1][1]); w0.w = cvtpk(p_[1][2], p_[1][3]); \
                w1.x = cvtpk(p_[2][0], p_[2][1]); w1.y = cvtpk(p_[2][2], p_[2][3]); w1.z = cvtpk(p_[3][0], p_[3][1]); w1.w = cvtpk(p_[3][2], p_[3][3]); } while (0)
            {   float p_[4][4];
#pragma unroll
                for (int kt = 0; kt < 4; ++kt)
#pragma unroll
                    for (int r = 0; r < 4; ++r) { p_[kt][r] = __builtin_amdgcn_exp2f(S[g][kt][r]); ls += p_[kt][r]; }
                w0.x = cvtpk(p_[0][0], p_[0][1]); w0.y = cvtpk(p_[0][2], p_[0][3]); w0.z = cvtpk(p_[1][0], p_[1][1]); w0.w = cvtpk(p_[1][2], p_[1][3]);
                w1.x = cvtpk(p_[2][0], p_[2][1]); w1.y = cvtpk(p_[2][2], p_[2][3]); w1.z = cvtpk(p_[3][0], p_[3][1]); w1.w = cvtpk(p_[3][2], p_[3][3]); }
            if (__builtin_expect(__any(!(ls < 4096.f)), 0)) {
                float mx = __builtin_fmaxf(__builtin_fmaxf(S[g][0][0], S[g][0][1]), S[g][0][2]);
                mx = __builtin_fmaxf(__builtin_fmaxf(mx, S[g][0][3]), S[g][1][0]); mx = __builtin_fmaxf(__builtin_fmaxf(mx, S[g][1][1]), S[g][1][2]);
                mx = __builtin_fmaxf(__builtin_fmaxf(mx, S[g][1][3]), S[g][2][0]); mx = __builtin_fmaxf(__builtin_fmaxf(mx, S[g][2][1]), S[g][2][2]);
                mx = __builtin_fmaxf(__builtin_fmaxf(mx, S[g][2][3]), S[g][3][0]); mx = __builtin_fmaxf(__builtin_fmaxf(mx, S[g][3][1]), S[g][3][2]);
                mx = __builtin_fmaxf(mx, S[g][3][3]);
                mx = fmaxf(mx, x16f(mx)); mx = fmaxf(mx, x32f(mx));
                const float dl = fmaxf(mx, 0.f);
                const float alpha = __builtin_amdgcn_exp2f(-dl);
                mg += dl; lg *= alpha;
#pragma unroll
                for (int nt = 0; nt < 4; ++nt) st.O[g][nt] = st.O[g][nt] * alpha;
                TH_EXPPACK(dl);
            }
#undef TH_EXPPACK
            st.m[g] = mg; st.l[g] = lg + ls;
            pf[g][0] = __builtin_bit_cast(bf16x8, w0); pf[g][1] = __builtin_bit_cast(bf16x8, w1);
        } else {
            float mx = fmaxf(fmaxf(S[g][0][0], S[g][0][1]), fmaxf(S[g][0][2], S[g][0][3]));
#pragma unroll
            for (int kt = 1; kt < 4; ++kt) mx = fmaxf(mx, fmaxf(fmaxf(S[g][kt][0], S[g][kt][1]), fmaxf(S[g][kt][2], S[g][kt][3])));
            mx = fmaxf(mx, x16f(mx)); mx = fmaxf(mx, x32f(mx));
            const float mnew = fmaxf(st.m[g], mx);
            const float alpha = __builtin_amdgcn_exp2f(st.m[g] - mnew);
            st.m[g] = mnew; st.l[g] *= alpha;
            float ls = 0.f;
#pragma unroll
            for (int kt = 0; kt < 4; ++kt)
#pragma unroll
                for (int r = 0; r < 4; ++r) { const float pr = __builtin_amdgcn_exp2f(S[g][kt][r] - mnew); S[g][kt][r] = pr; ls += pr; }
            st.l[g] += ls;
        }
        if (MODE == 2) {
#pragma unroll
            for (int s2 = 0; s2 < 2; ++s2) {
                u32x4 wv; wv.x = cvtpk(S[g][2 * s2][0], S[g][2 * s2][1]); wv.y = cvtpk(S[g][2 * s2][2], S[g][2 * s2][3]); wv.z = cvtpk(S[g][2 * s2 + 1][0], S[g][2 * s2 + 1][1]); wv.w = cvtpk(S[g][2 * s2 + 1][2], S[g][2 * s2 + 1][3]);
                pf[g][s2] = __builtin_bit_cast(bf16x8, wv);
            }
        }
    }
    if (MODE != 1) {
        typedef int v2i __attribute__((ext_vector_type(2))); typedef int v4i __attribute__((ext_vector_type(4)));
        const unsigned vbase_ = (unsigned)(unsigned long)Vt;
        const unsigned va0 = vbase_ + L.vb[0], va1 = vbase_ + L.vb[1], va2 = vbase_ + L.vb[2], va3 = vbase_ + L.vb[3];
        v2i lo0, hi0, lo1, hi1;
#define TRRD(lo_, hi_, a_, o0_, o1_) asm volatile("ds_read_b64_tr_b16 %0, %2 offset:" #o0_ "\n\tds_read_b64_tr_b16 %1, %2 offset:" #o1_ : "=&v"(lo_), "=&v"(hi_) : "v"(a_) : "memory")
#define TRWAIT(n_, lo_, hi_) asm volatile("s_waitcnt lgkmcnt(" #n_ ")" : "+v"(lo_), "+v"(hi_))
#define TRPV(lo_, hi_, nt_, s2_) do { const v4i v4_ = {lo_[0], lo_[1], hi_[0], hi_[1]}; const bf16x8 vf_ = __builtin_bit_cast(bf16x8, v4_); \
            _Pragma("unroll") for (int g = 0; g < NH; ++g) st.O[g][nt_] = __builtin_amdgcn_mfma_f32_16x16x32_bf16(vf_, pf[g][s2_], st.O[g][nt_], 0, 0, 0); } while (0)
        __builtin_amdgcn_s_setprio(1);
        TRRD(lo0, hi0, va0, 0, 2048);
        TRRD(lo1, hi1, va1, 0, 2048);    TRWAIT(2, lo0, hi0); TRPV(lo0, hi0, 0, 0);
        TRRD(lo0, hi0, va2, 0, 2048);    TRWAIT(2, lo1, hi1); TRPV(lo1, hi1, 1, 0);
        TRRD(lo1, hi1, va3, 0, 2048);    TRWAIT(2, lo0, hi0); TRPV(lo0, hi0, 2, 0);
        TRRD(lo0, hi0, va0, 4096, 6144); TRWAIT(2, lo1, hi1); TRPV(lo1, hi1, 3, 0);
        TRRD(lo1, hi1, va1, 4096, 6144); TRWAIT(2, lo0, hi0); TRPV(lo0, hi0, 0, 1);
        TRRD(lo0, hi0, va2, 4096, 6144); TRWAIT(2, lo1, hi1); TRPV(lo1, hi1, 1, 1);
        TRRD(lo1, hi1, va3, 4096, 6144); TRWAIT(2, lo0, hi0); TRPV(lo0, hi0, 2, 1);
        TRWAIT(0, lo1, hi1); TRPV(lo1, hi1, 3, 1);
        __builtin_amdgcn_s_setprio(0);
#undef TRRD
#undef TRWAIT
#undef TRPV
    }
}
__device__ __forceinline__ void scale_q(const u32x4 (&qw)[2], float sc, bf16x8 (&qf)[2]) {
#pragma unroll
    for (int ks = 0; ks < 2; ++ks) { const u32x4 w = qw[ks]; u32x4 o;
        o.x = cvtpk(bf_lo(w.x) * sc, bf_hi(w.x) * sc); o.y = cvtpk(bf_lo(w.y) * sc, bf_hi(w.y) * sc); o.z = cvtpk(bf_lo(w.z) * sc, bf_hi(w.z) * sc); o.w = cvtpk(bf_lo(w.w) * sc, bf_hi(w.w) * sc);
        qf[ks] = __builtin_bit_cast(bf16x8, o); }
}
__device__ __forceinline__ void load_q(const bf16_t* qrow, int grp, float sc, bf16x8 (&qf)[2]) {
#pragma unroll
    for (int ks = 0; ks < 2; ++ks) { const u32x4 w = *(const u32x4*)(qrow + 32 * ks + 8 * grp); u32x4 o;
        o.x = cvtpk(bf_lo(w.x) * sc, bf_hi(w.x) * sc); o.y = cvtpk(bf_lo(w.y) * sc, bf_hi(w.y) * sc); o.z = cvtpk(bf_lo(w.z) * sc, bf_hi(w.z) * sc); o.w = cvtpk(bf_lo(w.w) * sc, bf_hi(w.w) * sc);
        qf[ks] = __builtin_bit_cast(bf16x8, o); }
}
}

struct DilUnit { int dd, rho, jb, hd, b, T0, nT; };
__device__ __forceinline__ DilUnit dil_decode(int unit) {
    DilUnit U; const int g3 = unit >> 9, rem = unit & 511; U.b = rem >> 5; const int hh = (rem >> 4) & 1;
    if (g3 == 0) { U.dd = 1; U.rho = 0; U.jb = rem & 15; } else if (g3 == 1) { U.dd = 4; U.rho = (rem >> 2) & 3; U.jb = rem & 3; } else { U.dd = 16; U.rho = rem & 15; U.jb = 0; }
    U.hd = 2 * g3 + hh;
    const int tau0 = 128 * U.jb; U.T0 = (tau0 >= 128) ? (tau0 >> 6) - 2 : 0; U.nT = (tau0 >> 6) + 2 - U.T0;
    return U;
}
struct DilStage { u32x4 k[4], v[4], q[2]; };
__device__ __forceinline__ void dil_load(DilStage& sr, const bf16_t* PROJ, const DilUnit& U, int tid) {
    const int R = tid >> 3, ch = tid & 7; const long ld = (long)U.dd * NPROJ;
    const bf16_t* kb = PROJ + (size_t)((long)U.b * SEQ + U.rho) * NPROJ + C_DK + U.hd * 64 + ch * 8; const bf16_t* vb = PROJ + (size_t)((long)U.b * SEQ + U.rho) * NPROJ + C_DV + U.hd * 64 + ch * 8;
#pragma unroll
    for (int i = 0; i < 4; ++i) if (i < U.nT) { const size_t off = (size_t)(64 * (U.T0 + i) + R) * ld; sr.k[i] = *(const u32x4*)(kb + off); sr.v[i] = *(const u32x4*)(vb + off); }
    {
        const int lane = tid & 63, w = tid >> 6; const long qrow = (long)U.b * SEQ + U.rho + (long)U.dd * (128 * U.jb + 16 * w + (lane & 15));
        const bf16_t* qp = PROJ + (size_t)qrow * NPROJ + C_DQ + U.hd * 64 + 8 * (lane >> 4);
        sr.q[0] = *(const u32x4*)(qp); sr.q[1] = *(const u32x4*)(qp + 32); }
}
__device__ __forceinline__ void dil_store(const DilStage& sr, LAS unsigned char* buf, const DilUnit& U, int tid) {
    const int R = tid >> 3, ch = tid & 7;
#pragma unroll
    for (int i = 0; i < 4; ++i) if (i < U.nT) { *(LAS u32x4*)(buf + i * 2 * att::TILE_BYTES + att::k_off(R, ch)) = sr.k[i]; *(LAS u32x4*)(buf + (i * 2 + 1) * att::TILE_BYTES + att::v_off(R, ch * 16)) = sr.v[i]; }
}
__device__ __forceinline__ void dil_compute(const Frame& F, const DilUnit& U, const LAS unsigned char* buf, const u32x4 (&qw)[2]) {
    const int lane = F.lane, w = F.wave;
    const bf16_t* PROJ = (const bf16_t*)(F.ws + WS_PROJ); bf16_t* MIX = (bf16_t*)(F.ws + WS_MIX); float* LSE = (float*)(F.ws + WS_LSE);
    const att::Lane L = att::make_lane(lane);
    const int tauw = 128 * U.jb + 16 * w, tau = tauw + L.c;
    const long row = (long)U.b * SEQ + U.rho + (long)U.dd * tau;
    att::bf16x8 qf[1][2];
    att::scale_q(qw, 0.125f * att::LOG2E, qf[0]);
    const float slope[1] = {dil_slope(U.hd) * (float)U.dd * att::LOG2E};
    att::State<1> st; att::state_reset(st);
#pragma unroll 1
    for (int i = 0; i < U.nT; ++i) {
        const int T = U.T0 + i;
        const LAS unsigned char* Kt = buf + i * 2 * att::TILE_BYTES; const LAS unsigned char* Vt = Kt + att::TILE_BYTES;
        const bool skip = (64 * T > tauw + 15) || (64 * T + 63 < tauw - 128);
        if (!skip) {
            const bool need_mask = !(64 * T + 63 <= tauw && 64 * T >= tauw + 15 - 128);
            const int drel = 64 * T + 4 * L.grp - tau;
            f32x4 S[1][4];
            att::scores<1>(Kt, L, qf, slope, (float)drel, S);
            if (need_mask) att::mask<1>(S, drel, -128, true);
            att::online<1>(S, st);
            att::pv<1>(Vt, L, S, st);
        }
    }
    float lt = st.l[0]; lt += x16f(lt); lt += x32f(lt);
    const float il = rcpf_(lt);
    bf16_t* orow = MIX + (size_t)row * DM + 384 + U.hd * 64 + 4 * L.grp;
#pragma unroll
    for (int nt = 0; nt < 4; ++nt) { const f32x4 o = st.O[0][nt] * il; u32x2 wv; wv.x = att::cvtpk(o[0], o[1]); wv.y = att::cvtpk(o[2], o[3]); *(u32x2*)(orow + 16 * nt) = wv; }
    if (L.grp == 0) LSE[(size_t)row * 8 + U.hd] = (st.m[0] + __log2f(lt)) * att::LN2;
}
__device__ __forceinline__ void dil_units(const Frame& F, int first, int stride) {
    const bf16_t* PROJ = (const bf16_t*)(F.ws + WS_PROJ);
    if (first >= 1536) return;
    DilStage sr;
    DilUnit U = dil_decode(first);
    dil_load(sr, PROJ, U, F.tid); dil_store(sr, F.lds, U, F.tid);
    u32x4 qc[2] = {sr.q[0], sr.q[1]};
    int cur = 0;
#pragma unroll 1
    for (int u = first; u < 1536; u += stride) {
        const bool has_next = u + stride < 1536;
        DilUnit Un = U;
        if (has_next) { Un = dil_decode(u + stride); dil_load(sr, PROJ, Un, F.tid); }
        __syncthreads();
        dil_compute(F, U, F.lds + cur * 65536, qc);
        if (has_next) { dil_store(sr, F.lds + (cur ^ 1) * 65536, Un, F.tid); qc[0] = sr.q[0]; qc[1] = sr.q[1]; }
        cur ^= 1; U = Un;
    }
    __syncthreads();
}
__device__ __forceinline__ void dil_fixup(const Frame& F) {
    bf16_t* MIX = (bf16_t*)(F.ws + WS_MIX); const float* LSE = (const float*)(F.ws + WS_LSE);
    for (int idx = F.bid * 512 + F.tid; idx < MTOK * 48; idx += F.G * 512) {
        const int ch = idx & 7, hd = (idx >> 3) % 6, row = idx / 48, hh = hd & 1, g3 = hd >> 1;
        const float l0 = LSE[(size_t)row * 8 + hh], l1 = LSE[(size_t)row * 8 + 2 + hh], l2 = LSE[(size_t)row * 8 + 4 + hh];
        const float mx = fmaxf(l0, fmaxf(l1, l2));
        const float e0 = __expf(l0 - mx), e1 = __expf(l1 - mx), e2 = __expf(l2 - mx);
        const float al = ((g3 == 0) ? e0 : ((g3 == 1) ? e1 : e2)) * rcpf_((e0 + e1) + e2);
        u32x4* p = (u32x4*)(MIX + (size_t)row * DM + 384 + hd * 64 + ch * 8);
        const u32x4 w = *p; u32x4 o;
        o.x = pk2(bf_lo(w.x) * al, bf_hi(w.x) * al); o.y = pk2(bf_lo(w.y) * al, bf_hi(w.y) * al); o.z = pk2(bf_lo(w.z) * al, bf_hi(w.z) * al); o.w = pk2(bf_lo(w.w) * al, bf_hi(w.w) * al);
        *p = o;
    }
}

struct NsaCtx { int tid, lane, w, t, tw; long row; att::Lane L; float slope[3]; };
__device__ __forceinline__ NsaCtx nsa_ctx(const Frame& F, int b, int kvh, int jb) {
    NsaCtx C; int tid = F.tid, lane = F.lane, w = F.wave;
    asm volatile("" : "+v"(tid), "+v"(lane)); asm volatile("" : "+s"(w));
    C.tid = tid; C.lane = lane; C.w = w; C.L = att::make_lane(lane);
    C.tw = 128 * jb + 16 * w; C.t = C.tw + C.L.c; C.row = (long)b * SEQ + C.t;
#pragma unroll
    for (int g = 0; g < 3; ++g) C.slope[g] = nsa_slope(kvh * 3 + g) * att::LOG2E;
    return C;
}
#define NSA_FIN_ADD(first_, g_, nt_, v_) do { const f32x4 v__ = (v_); u32x2* p__ = (u32x2*)(MIXo + (size_t)C.row * DM + (kvh * 3 + (g_)) * 64 + 4 * L.grp + 16 * (nt_)); u32x2 f__ = (u32x2){0u, 0u}; if (!(first_)) f__ = *p__; u32x2 o__; \
        o__.x = att::cvtpk(bf_lo(f__.x) + v__[0], bf_hi(f__.x) + v__[1]); o__.y = att::cvtpk(bf_lo(f__.y) + v__[2], bf_hi(f__.y) + v__[3]); *p__ = o__; } while (0)
__device__ __forceinline__ float nsa_gate(const bf16_t* PROJ, long row, int kvh, int g, int br) { return sigmoidf_(bf_lo((unsigned)PROJ[(size_t)row * NPROJ + C_GATE + (kvh * 3 + g) * 3 + br])); }

__device__ __forceinline__ unsigned nsa_cmp_topk(const Frame& F, int b, int kvh, int jb) {
    bf16_t* MIXo = (bf16_t*)(F.ws + WS_MIX);
    const NsaCtx C = nsa_ctx(F, b, kvh, jb);
    const att::Lane& L = C.L; const int lane = C.lane, tid = C.tid, w = C.w, t = C.t, tw = C.tw;
    const bf16_t* PROJ = (const bf16_t*)(F.ws + WS_PROJ);
    const bf16_t* KCMP = (const bf16_t*)(F.ws + WS_KCMP) + (size_t)(b * 2 + kvh) * 128 * 64; const bf16_t* VCMP = (const bf16_t*)(F.ws + WS_VCMP) + (size_t)(b * 2 + kvh) * 128 * 64;
    LAS unsigned char* cbuf = F.lds;
    LAS float* impM = (LAS float*)(F.lds + 32768) + w * 1056;
    LAS float* impN = impM + 528;
    LAS unsigned* uni = (LAS unsigned*)(F.lds + 32768 + 8 * 4224);
    LAS unsigned char* qlds = F.lds + 32768 + 8 * 4224 + 256 + w * 6144;
    unsigned graw0[3];
#pragma unroll
    for (int g = 0; g < 3; ++g) graw0[g] = (unsigned)PROJ[(size_t)C.row * NPROJ + C_GATE + (kvh * 3 + g) * 3 + 0];
    float slopec[3];
#pragma unroll
    for (int g = 0; g < 3; ++g) {
        slopec[g] = 16.0f * C.slope[g];
        att::bf16x8 qf[2]; att::load_q(PROJ + (size_t)C.row * NPROJ + C_NQ + (kvh * 3 + g) * 64, L.grp, 0.125f * att::LOG2E, qf);
        *(LAS att::bf16x8*)(qlds + ((g * 2 + 0) * 64 + lane) * 16) = qf[0]; *(LAS att::bf16x8*)(qlds + ((g * 2 + 1) * 64 + lane) * 16) = qf[1];
    }
    {
        att::StageRegs s0, s1;
        att::stage_load(s0, KCMP, VCMP, 64, tid); att::stage_load(s1, KCMP + 4096, VCMP + 4096, 64, tid);
        att::stage_store(s0, cbuf, cbuf + att::TILE_BYTES, tid); att::stage_store(s1, cbuf + 2 * att::TILE_BYTES, cbuf + 3 * att::TILE_BYTES, tid);
        for (int i2 = lane; i2 < 1056; i2 += 64) impM[i2] = 0.f;
    }
    __syncthreads();
    const int nmax = (t >= 31) ? ((t - 31) >> 4) : -1, nmaxw = (tw >= 31) ? ((tw - 31) >> 4) : -1, nmaxw_hi = (tw + 15 >= 31) ? ((tw + 15 - 31) >> 4) : -1;
    const float tcf = ((float)t - 15.5f) * (1.0f / 16.0f);
    att::State<3> st; att::state_reset(st);
    {
        f32x4 S[2][3][4];
#pragma unroll
        for (int T = 0; T < 2; ++T) {
            const LAS unsigned char* Kt = cbuf + T * 2 * att::TILE_BYTES;
            const float brel = (float)(64 * T + 4 * L.grp) - tcf; const int drel = 64 * T + 4 * L.grp - nmax;
            f32x4 dm[4];
#pragma unroll
            for (int kt = 0; kt < 4; ++kt)
#pragma unroll
                for (int r = 0; r < 4; ++r) dm[kt][r] = (drel + 16 * kt + r <= 0) ? brel + (float)(16 * kt + r) : -att::BIGD;
            att::bf16x8 kf[4][2];
#pragma unroll
            for (int kt = 0; kt < 4; ++kt) { kf[kt][0] = *(const LAS att::bf16x8*)(Kt + L.kb0 + kt * 2048); kf[kt][1] = *(const LAS att::bf16x8*)(Kt + L.kb1 + kt * 2048); }
#pragma unroll
            for (int g = 0; g < 3; ++g) {
                const att::bf16x8 q0 = *(const LAS att::bf16x8*)(qlds + ((g * 2 + 0) * 64 + lane) * 16), q1 = *(const LAS att::bf16x8*)(qlds + ((g * 2 + 1) * 64 + lane) * 16);
#pragma unroll
                for (int kt = 0; kt < 4; ++kt) {
                    S[T][g][kt] = dm[kt] * slopec[g];
                    S[T][g][kt] = __builtin_amdgcn_mfma_f32_16x16x32_bf16(kf[kt][0], q0, S[T][g][kt], 0, 0, 0);
                    S[T][g][kt] = __builtin_amdgcn_mfma_f32_16x16x32_bf16(kf[kt][1], q1, S[T][g][kt], 0, 0, 0);
                }
            }
        }
        att::bf16x8 pf[3][2][2];
        float impm[2][4], impn[2][4];
#pragma unroll
        for (int T = 0; T < 2; ++T)
#pragma unroll
            for (int kt = 0; kt < 4; ++kt) { impm[T][kt] = 0.f; impn[T][kt] = 0.f; }
#pragma unroll
        for (int g = 0; g < 3; ++g) {
            float mx = att::MFLOOR;
#pragma unroll
            for (int T = 0; T < 2; ++T)
#pragma unroll
                for (int kt = 0; kt < 4; ++kt) mx = fmaxf(mx, fmaxf(fmaxf(S[T][g][kt][0], S[T][g][kt][1]), fmaxf(S[T][g][kt][2], S[T][g][kt][3])));
            mx = fmaxf(mx, x16f(mx)); mx = fmaxf(mx, x32f(mx));
            float ls = 0.f;
#pragma unroll
            for (int T = 0; T < 2; ++T)
#pragma unroll
                for (int kt = 0; kt < 4; ++kt)
#pragma unroll
                    for (int r = 0; r < 4; ++r) { const float e = __builtin_amdgcn_exp2f(S[T][g][kt][r] - mx); S[T][g][kt][r] = e; ls += e; }
            ls += x16f(ls); ls += x32f(ls);
            const float il = (ls > 0.f) ? rcpf_(ls) : 0.f;
#pragma unroll
            for (int T = 0; T < 2; ++T) {
#pragma unroll
                for (int kt = 0; kt < 4; ++kt) { S[T][g][kt] = S[T][g][kt] * il; impm[T][kt] += (S[T][g][kt][0] + S[T][g][kt][1]) + (S[T][g][kt][2] + S[T][g][kt][3]); impn[T][kt] += S[T][g][kt][3]; }
#pragma unroll
                for (int s2 = 0; s2 < 2; ++s2) { u32x4 wv; wv.x = att::cvtpk(S[T][g][2 * s2][0], S[T][g][2 * s2][1]); wv.y = att::cvtpk(S[T][g][2 * s2][2], S[T][g][2 * s2][3]);
                    wv.z = att::cvtpk(S[T][g][2 * s2 + 1][0], S[T][g][2 * s2 + 1][1]); wv.w = att::cvtpk(S[T][g][2 * s2 + 1][2], S[T][g][2 * s2 + 1][3]); pf[g][T][s2] = __builtin_bit_cast(att::bf16x8, wv); }
            }
        }
#pragma unroll
        for (int T = 0; T < 2; ++T)
#pragma unroll
            for (int kt = 0; kt < 4; ++kt) { const int mb = 16 * T + 4 * kt + L.grp; impM[L.c * 33 + mb] = impm[T][kt]; impN[L.c * 33 + mb + 1] = impn[T][kt]; }
#pragma unroll
        for (int T = 0; T < 2; ++T) {
            const LAS unsigned char* Vt = cbuf + T * 2 * att::TILE_BYTES + att::TILE_BYTES;
#pragma unroll
            for (int s2 = 0; s2 < 2; ++s2)
#pragma unroll
                for (int nt = 0; nt < 4; ++nt) {
                    const att::v4i16 lo = __builtin_amdgcn_ds_read_tr16_b64_v4i16((LAS att::v4i16*)(Vt + L.vb[nt] + 4096 * s2));
                    const att::v4i16 hi = __builtin_amdgcn_ds_read_tr16_b64_v4i16((LAS att::v4i16*)(Vt + L.vb[nt] + 4096 * s2 + 2048));
                    const att::bf16x8 vf = {lo[0], lo[1], lo[2], lo[3], hi[0], hi[1], hi[2], hi[3]};
#pragma unroll
                    for (int g = 0; g < 3; ++g) st.O[g][nt] = __builtin_amdgcn_mfma_f32_16x16x32_bf16(vf, pf[g][T][s2], st.O[g][nt], 0, 0, 0);
                }
        }
    }
#pragma unroll
    for (int g = 0; g < 3; ++g) { const float gt = sigmoidf_(bf_lo(graw0[g]));
#pragma unroll
        for (int nt = 0; nt < 4; ++nt) NSA_FIN_ADD(true, g, nt, st.O[g][nt] * gt); }
    asm volatile("s_waitcnt lgkmcnt(0)" ::: "memory");
    const int cur = t >> 6, hi = cur - 2;
    unsigned mk = 0u;
    {
        float wv[32]; wv[0] = -1.0f;
#pragma unroll
        for (int m2 = 1; m2 < 32; ++m2) { const float w2 = impM[L.c * 33 + m2] + impN[L.c * 33 + m2]; wv[m2] = (m2 <= hi) ? w2 : -1.0f; }
#pragma unroll
        for (int jj = 0; jj < 8; ++jj) {
            const float v = (L.grp == 0) ? wv[4 * jj] : ((L.grp == 1) ? wv[4 * jj + 1] : ((L.grp == 2) ? wv[4 * jj + 2] : wv[4 * jj + 3]));
            int rank = 0;
#pragma unroll
            for (int m2 = 1; m2 < 32; ++m2) {
                const int d = m2 - 4 * jj; bool cnd;
                if (d < 0) cnd = wv[m2] >= v; else if (d >= 3) cnd = wv[m2] > v; else cnd = (wv[m2] > v) || (wv[m2] == v && L.grp > d);
                rank += cnd ? 1 : 0;
            }
            const int mm = L.grp + 4 * jj;
            if (mm >= 1 && mm <= hi && rank < 5) mk |= 1u << mm;
        }
    }
    mk |= x16u(mk); mk |= x32u(mk);
    mk |= 1u | (1u << cur); if (cur >= 1) mk |= 1u << (cur - 1);
    unsigned um = row_or16(mk);
    if (lane == 0) uni[w] = um;
    __syncthreads();
    return mk;
}
template <int BR, bool DISCARD = false> __device__ __forceinline__ void nsa_branch(const Frame& F, int b, int kvh, int jb, unsigned selmask) {
    bf16_t* MIXo = (bf16_t*)(F.ws + WS_MIX);
    const NsaCtx C = nsa_ctx(F, b, kvh, jb);
    const att::Lane& L = C.L; const int lane = C.lane, w = C.w, t = C.t, tw = C.tw;
    const bf16_t* PROJ = (const bf16_t*)(F.ws + WS_PROJ);
    const LAS unsigned* uni = (const LAS unsigned*)(F.lds + 32768 + 8 * 4224);
    const LAS unsigned char* qlds = F.lds + 32768 + 8 * 4224 + 256 + w * 6144;
    const int R = 8 * w + (lane >> 3), pch = lane & 7;
    const bf16_t* ksrc = PROJ + (size_t)((long)b * SEQ + R) * NPROJ + (BR == 1 ? C_KS : C_KW) + kvh * 64 + 8 * (pch ^ ((R >> 1) & 7));
    const bf16_t* vsrc = PROJ + (size_t)((long)b * SEQ + R) * NPROJ + (BR == 1 ? C_VS : C_VW) + kvh * 64 + 8 * (pch ^ (((R >> 1) & 3) << 1));
#define NSA_DMA(T_, slot_) do { const size_t to_ = (size_t)(64 * (T_)) * NPROJ; LAS unsigned* d_ = (LAS unsigned*)(F.lds + (slot_) * 16384 + w * 1024); \
        __builtin_amdgcn_global_load_lds((const unsigned*)(ksrc + to_), d_, 16, 0, 0); __builtin_amdgcn_global_load_lds((const unsigned*)(vsrc + to_), (LAS unsigned*)((LAS unsigned char*)d_ + 8192), 16, 0, 0); } while (0)
    float dummy3[3] = {0.f, 0.f, 0.f}, dummy4[4] = {0.f, 0.f, 0.f, 0.f};
    float m0 = 0.f; asm volatile("" : "+v"(m0));
    att::State<3> st; att::state_reset(st, m0);
    unsigned rem = 0u; int Tlast = 0, T0, T1, T2;
    if (BR == 1) { unsigned um = 0u;
#pragma unroll
        for (int i2 = 0; i2 < 8; ++i2) um |= uni[i2];
        rem = __builtin_amdgcn_readfirstlane(um); }
#define NSA_NEXT(dst_, prev_) do { if (BR == 1) { if (rem != 0u) { dst_ = __builtin_ctz(rem); rem &= rem - 1; } else dst_ = -1; } else { dst_ = ((prev_) >= 0 && (prev_) < Tlast) ? (prev_) + 1 : -1; } } while (0)
    if (BR == 1) { T0 = __builtin_ctz(rem); rem &= rem - 1; } else { T0 = (2 * jb >= 8) ? 2 * jb - 8 : 0; Tlast = 2 * jb + 1; }
    NSA_NEXT(T1, T0); NSA_NEXT(T2, T1);
    asm volatile("s_waitcnt lgkmcnt(0)" ::: "memory"); __builtin_amdgcn_s_barrier();
    NSA_DMA(T0, 0);
    if (T1 >= 0) { NSA_DMA(T1, 1); asm volatile("s_waitcnt vmcnt(2)" ::: "memory"); } else { asm volatile("s_waitcnt vmcnt(0)" ::: "memory"); }
    __builtin_amdgcn_s_barrier();
    unsigned graw[3];
#pragma unroll
    for (int g = 0; g < 3; ++g) graw[g] = (unsigned)PROJ[(size_t)C.row * NPROJ + C_GATE + (kvh * 3 + g) * 3 + BR];
    int slot = 0;
#pragma unroll 1
    for (;;) {
        if (T2 >= 0) { const int s2_ = (slot >= 1) ? slot - 1 : 2; NSA_DMA(T2, s2_); }
        const LAS unsigned char* Kt = F.lds + slot * 16384; const LAS unsigned char* Vt = Kt + att::TILE_BYTES;
        const int T = T0, drel = 64 * T + 4 * L.grp - t;
        if (BR == 1) {
            const bool row_on = (selmask >> T) & 1u;
            if (__any(row_on)) att::tile_heads<3, 0>(Kt, Vt, L, qlds, lane, C.slope, (float)drel, drel, -1000000, row_on, !(__all(row_on) && 64 * T + 63 <= tw), st, dummy3, dummy3, dummy4, dummy4);
        } else {
            const bool skip = (64 * T > tw + 15) || (64 * T + 63 < tw - 511);
            if (!skip) att::tile_heads<3, 0>(Kt, Vt, L, qlds, lane, C.slope, (float)drel, drel, -511, true, !(64 * T + 63 <= tw && 64 * T >= tw + 15 - 511), st, dummy3, dummy3, dummy4, dummy4);
        }
        if (T2 >= 0) { asm volatile("s_waitcnt vmcnt(2) lgkmcnt(0)" ::: "memory"); } else { asm volatile("s_waitcnt vmcnt(0) lgkmcnt(0)" ::: "memory"); }
        __builtin_amdgcn_s_barrier();
        if (T1 < 0) break;
        T0 = T1; T1 = T2; NSA_NEXT(T2, T1); slot = (slot == 2) ? 0 : slot + 1;
    }
#undef NSA_DMA
#undef NSA_NEXT
    u32x2 fold[3][4];
#pragma unroll
    for (int g = 0; g < 3; ++g)
#pragma unroll
        for (int nt = 0; nt < 4; ++nt) fold[g][nt] = DISCARD ? (u32x2){0u, 0u} : *(const u32x2*)(MIXo + (size_t)C.row * DM + (kvh * 3 + g) * 64 + 4 * L.grp + 16 * nt);
#pragma unroll
    for (int g = 0; g < 3; ++g) { float lt = st.l[g]; lt += x16f(lt); lt += x32f(lt); const float sc = (lt > 0.f) ? sigmoidf_(bf_lo(graw[g])) * rcpf_(lt) : 0.f;
#pragma unroll
        for (int nt = 0; nt < 4; ++nt) { const f32x4 v = st.O[g][nt] * sc;
            if (DISCARD) { asm volatile("" :: "v"(v[0]), "v"(v[1]), "v"(v[2]), "v"(v[3])); }
            else { u32x2 o; o.x = att::cvtpk(bf_lo(fold[g][nt].x) + v[0], bf_hi(fold[g][nt].x) + v[1]); o.y = att::cvtpk(bf_lo(fold[g][nt].y) + v[2], bf_hi(fold[g][nt].y) + v[3]);
                   *(u32x2*)(MIXo + (size_t)C.row * DM + (kvh * 3 + g) * 64 + 4 * L.grp + 16 * nt) = o; } } }
}
__device__ __forceinline__ void nsa_unit2(const Frame& F, int b, int kvh, int jb) {
    unsigned selmask = nsa_cmp_topk(F, b, kvh, jb);
#if REP_CMP > 1
    selmask = nsa_cmp_topk(F, b, kvh, jb);
#endif
#if REP_SEL > 1
    nsa_branch<1, true>(F, b, kvh, jb, selmask);
#endif
#if REP_WIN > 1
    nsa_branch<2, true>(F, b, kvh, jb, selmask);
#endif
    nsa_branch<1>(F, b, kvh, jb, selmask);
    nsa_branch<2>(F, b, kvh, jb, selmask);
}
#undef NSA_FIN_ADD

__device__ __forceinline__ void hgrn_local(const Frame& F, const Args& a, int l, int u) {
    typedef short bf16x8 __attribute__((ext_vector_type(8)));
    typedef short v4i16 __attribute__((ext_vector_type(4)));
    const int c = u & 31, bh = u >> 5, b = bh >> 2, h = bh & 3, lane = F.lane, l15 = lane & 15, grp = lane >> 4;
    const bf16_t* PROJ = (const bf16_t*)(F.ws + WS_PROJ);
    bf16_t* OLOC = (bf16_t*)(F.ws + WS_OLOC); bf16_t* QE = (bf16_t*)(F.ws + WS_QE); bf16_t* HU = (bf16_t*)(F.ws + WS_HU); float* HD = (float*)(F.ws + WS_HD);
    LAS unsigned char* QS = F.lds + F.wave * 16384;
    LAS unsigned char* KS = QS + 2048;
    LAS unsigned char* VV = QS + 4096;
    LAS float* GF = (LAS float*)(QS + 6144);
    float lb = 0.f;
    if (l == 1) lb = sigmoidf_(a.hg_lb[256 + h * 64 + lane] - a.hg_lb[h * 64 + lane]);
    const float omlb = 1.0f - lb;
    f32x4 Sacc[4][4];
#pragma unroll
    for (int dt = 0; dt < 4; ++dt)
#pragma unroll
        for (int et = 0; et < 4; ++et) Sacc[dt][et] = (f32x4){0.f, 0.f, 0.f, 0.f};
    float e0 = 1.0f;
    const long row0 = (long)b * SEQ + c * 64;
    const int qs_w = (lane >> 3), qs_wb = (lane & 7) * 2;
    const int tr_row = 4 * grp + (l15 >> 2), tr_col = 8 * (l15 & 3);
    LAS unsigned char* RQ = QS + 6400;
    LAS unsigned char* RF = QS + 8448;
    LAS unsigned char* OST = QS + 6400;
    LAS unsigned char* QEST = QS + 10752;
    const int wrow = lane >> 3, wch = lane & 7;
    const bf16_t* gin = PROJ + (size_t)(row0 + wrow) * NPROJ + h * 64 + wch * 8;
    u32x4 rq[2], rf[2], rv[2];
#pragma unroll
    for (int i = 0; i < 2; ++i) { const bf16_t* r = gin + (size_t)(8 * i) * NPROJ; rq[i] = *(const u32x4*)(r + C_HQ); rf[i] = *(const u32x4*)(r + C_HF); rv[i] = *(const u32x4*)(r + C_HI); }
#pragma unroll 1
    for (int I = 0; I < 4; ++I) {
        asm volatile("s_waitcnt lgkmcnt(0)" ::: "memory");
#pragma unroll
        for (int i = 0; i < 2; ++i) { *(LAS u32x4*)(RQ + (wrow + 8 * i) * 128 + wch * 16) = rq[i]; *(LAS u32x4*)(RF + (wrow + 8 * i) * 128 + wch * 16) = rf[i]; *(LAS u32x4*)(VV + att::v_off(wrow + 8 * i, wch * 16)) = rv[i]; }
        {
            const int In = (I < 3) ? I + 1 : I;
#pragma unroll
            for (int i = 0; i < 2; ++i) { const bf16_t* r = gin + (size_t)(16 * In + 8 * i) * NPROJ; rq[i] = *(const u32x4*)(r + C_HQ); rf[i] = *(const u32x4*)(r + C_HF); rv[i] = *(const u32x4*)(r + C_HI); }
        }
        asm volatile("s_waitcnt lgkmcnt(0)" ::: "memory");
        float ex = 1.0f;
#pragma unroll
        for (int t = 0; t < 16; ++t) {
            const float qv = bf_lo((unsigned)*(const LAS bf16_t*)(RQ + t * 128 + lane * 2)), fv = bf_lo((unsigned)*(const LAS bf16_t*)(RF + t * 128 + lane * 2));
            const float sg = sigmoidf_(fv);
            const float f = lb + omlb * sg, kk = omlb * (1.0f - sg);
            ex = fmaxf(ex * f, 1e-35f);
            const float qs = qv * ex;
            *(LAS bf16_t*)(QS + att::k_off(t, qs_w) + qs_wb) = (bf16_t)f2bf(qs);
            *(LAS bf16_t*)(KS + att::v_off(t, lane * 2)) = (bf16_t)f2bf(kk * rcpf_(ex));
            *(LAS bf16_t*)(QEST + t * 128 + lane * 2) = (bf16_t)f2bf(qs * e0);
        }
        GF[lane] = ex; e0 *= ex;
        asm volatile("s_waitcnt lgkmcnt(0)" ::: "memory");
#pragma unroll
        for (int i = 0; i < 2; ++i) *(u32x4*)(QE + (size_t)(row0 + I * 16 + wrow + 8 * i) * 256 + h * 64 + wch * 8) = *(const LAS u32x4*)(QEST + (wrow + 8 * i) * 128 + wch * 16);
        f32x4 Oacc[4];
#pragma unroll
        for (int et = 0; et < 4; ++et) Oacc[et] = (f32x4){0.f, 0.f, 0.f, 0.f};
#pragma unroll
        for (int ks = 0; ks < 2; ++ks) {
            const u32x2 lo = *(const LAS u32x2*)(QS + att::k_off(l15, 4 * ks + (grp >> 1)) + 8 * (grp & 1));
            const u32x2 hi = *(const LAS u32x2*)(QS + att::k_off(l15, 4 * ks + 2 + (grp >> 1)) + 8 * (grp & 1));
            u32x4 aw; aw.x = lo.x; aw.y = lo.y; aw.z = hi.x; aw.w = hi.y;
            const bf16x8 af = __builtin_bit_cast(bf16x8, aw);
#pragma unroll
            for (int et = 0; et < 4; ++et) {
                u32x4 bw; bw.x = att::cvtpk(Sacc[2 * ks][et][0], Sacc[2 * ks][et][1]); bw.y = att::cvtpk(Sacc[2 * ks][et][2], Sacc[2 * ks][et][3]);
                bw.z = att::cvtpk(Sacc[2 * ks + 1][et][0], Sacc[2 * ks + 1][et][1]); bw.w = att::cvtpk(Sacc[2 * ks + 1][et][2], Sacc[2 * ks + 1][et][3]);
                Oacc[et] = __builtin_amdgcn_mfma_f32_16x16x32_bf16(af, __builtin_bit_cast(bf16x8, bw), Oacc[et], 0, 0, 0);
            }
        }
        f32x4 AT = (f32x4){0.f, 0.f, 0.f, 0.f};
#pragma unroll
        for (int ks = 0; ks < 2; ++ks) {
            const bf16x8 ka = *(const LAS bf16x8*)(KS + att::v_off(l15, (4 * ks + grp) * 16));
            const bf16x8 qb = *(const LAS bf16x8*)(QS + att::k_off(l15, 4 * ks + grp));
            AT = __builtin_amdgcn_mfma_f32_16x16x32_bf16(ka, qb, AT, 0, 0, 0);
        }
#pragma unroll
        for (int r = 0; r < 4; ++r) AT[r] = (4 * grp + r <= l15) ? AT[r] : 0.f;
        u32x4 atw; atw.x = att::cvtpk(AT[0], AT[1]); atw.y = att::cvtpk(AT[2], AT[3]); atw.z = 0u; atw.w = 0u;
        const bf16x8 atf = __builtin_bit_cast(bf16x8, atw);
        bf16x8 vf[4];
#pragma unroll
        for (int et = 0; et < 4; ++et) { const v4i16 tv = __builtin_amdgcn_ds_read_tr16_b64_v4i16((LAS v4i16*)(VV + att::v_off(tr_row, 32 * et + tr_col)));
            vf[et] = (bf16x8){tv[0], tv[1], tv[2], tv[3], 0, 0, 0, 0}; }
#pragma unroll
        for (int et = 0; et < 4; ++et) Oacc[et] = __builtin_amdgcn_mfma_f32_16x16x32_bf16(atf, vf[et], Oacc[et], 0, 0, 0);
#pragma unroll
        for (int et = 0; et < 4; ++et)
#pragma unroll
            for (int r = 0; r < 4; ++r) *(LAS float*)(OST + (4 * grp + r) * 272 + (16 * et + l15) * 4) = Oacc[et][r];
        asm volatile("s_waitcnt lgkmcnt(0)" ::: "memory");
#pragma unroll
        for (int i = 0; i < 4; ++i) { const f32x4 ov = *(const LAS f32x4*)(OST + (grp + 4 * i) * 272 + l15 * 16); u32x2 ow; ow.x = att::cvtpk(ov[0], ov[1]); ow.y = att::cvtpk(ov[2], ov[3]);
            *(u32x2*)(OLOC + (size_t)(row0 + I * 16 + grp + 4 * i) * 256 + h * 64 + 4 * l15) = ow; }
#pragma unroll
        for (int dt = 0; dt < 4; ++dt) {
            const v4i16 tk = __builtin_amdgcn_ds_read_tr16_b64_v4i16((LAS v4i16*)(KS + att::v_off(tr_row, 32 * dt + tr_col)));
            const bf16x8 kf = (bf16x8){tk[0], tk[1], tk[2], tk[3], 0, 0, 0, 0};
            const f32x4 g4 = *(const LAS f32x4*)(GF + 16 * dt + 4 * grp);
#pragma unroll
            for (int et = 0; et < 4; ++et) { Sacc[dt][et] = __builtin_amdgcn_mfma_f32_16x16x32_bf16(kf, vf[et], Sacc[dt][et], 0, 0, 0); Sacc[dt][et] = Sacc[dt][et] * g4; }
        }
    }
#pragma unroll
    for (int dt = 0; dt < 4; ++dt)
#pragma unroll
        for (int et = 0; et < 4; ++et) { u32x2 w2; w2.x = att::cvtpk(Sacc[dt][et][0], Sacc[dt][et][1]); w2.y = att::cvtpk(Sacc[dt][et][2], Sacc[dt][et][3]); *(u32x2*)(HU + (size_t)u * 4096 + (16 * et + l15) * 64 + 16 * dt + 4 * grp) = w2; }
    HD[(size_t)u * 64 + lane] = e0;
    asm volatile("s_waitcnt lgkmcnt(0)" ::: "memory");
}
__device__ __forceinline__ void hgrn_scan(const Frame& F) {
    const bf16_t* HU = (const bf16_t*)(F.ws + WS_HU); const float* HD = (const float*)(F.ws + WS_HD); bf16_t* HUS = (bf16_t*)(F.ws + WS_HUS);
    for (int idx = F.bid * 512 + F.tid; idx < 64 * 4096; idx += F.G * 512) {
        const int bh = idx >> 12, ed = idx & 4095, d = ed & 63;
        float S = 0.f;
        float uv[32], dv[32];
#pragma unroll
        for (int c = 0; c < 32; ++c) { uv[c] = bf_lo((unsigned)HU[(size_t)(bh * 32 + c) * 4096 + ed]); dv[c] = HD[(size_t)(bh * 32 + c) * 64 + d]; }
#pragma unroll
        for (int c = 0; c < 32; ++c) { HUS[(size_t)(bh * 32 + c) * 4096 + ed] = (bf16_t)f2bf(S); S = dv[c] * S + uv[c]; }
    }
}
__device__ __forceinline__ void hgrn_final(const Frame& F, int u) {
    typedef short bf16x8 __attribute__((ext_vector_type(8)));
    const int c = u & 31, bh = u >> 5, b = bh >> 2, h = bh & 3, lane = F.lane, l15 = lane & 15, grp = lane >> 4;
    const bf16_t* PROJ = (const bf16_t*)(F.ws + WS_PROJ); bf16_t* MIX = (bf16_t*)(F.ws + WS_MIX);
    const bf16_t* OLOC = (const bf16_t*)(F.ws + WS_OLOC); const bf16_t* QE = (const bf16_t*)(F.ws + WS_QE); const bf16_t* HUS = (const bf16_t*)(F.ws + WS_HUS);
    const long row0 = (long)b * SEQ + c * 64;
    bf16x8 af[4][2];
#pragma unroll
    for (int et = 0; et < 4; ++et)
#pragma unroll
        for (int ks = 0; ks < 2; ++ks) af[et][ks] = *(const bf16x8*)(HUS + (size_t)u * 4096 + (16 * et + l15) * 64 + 32 * ks + 8 * grp);
#pragma unroll 1
    for (int tt = 0; tt < 4; ++tt) {
        const long row = row0 + 16 * tt + l15;
        const bf16x8 b0 = *(const bf16x8*)(QE + (size_t)row * 256 + h * 64 + 8 * grp), b1 = *(const bf16x8*)(QE + (size_t)row * 256 + h * 64 + 32 + 8 * grp);
        f32x4 acc[4]; float sq = 0.f;
#pragma unroll
        for (int et = 0; et < 4; ++et) {
            { const u32x2 ow = *(const u32x2*)(OLOC + (size_t)row * 256 + h * 64 + 16 * et + 4 * grp); acc[et] = (f32x4){bf_lo(ow.x), bf_hi(ow.x), bf_lo(ow.y), bf_hi(ow.y)}; }
            acc[et] = __builtin_amdgcn_mfma_f32_16x16x32_bf16(af[et][0], b0, acc[et], 0, 0, 0);
            acc[et] = __builtin_amdgcn_mfma_f32_16x16x32_bf16(af[et][1], b1, acc[et], 0, 0, 0);
        }
#pragma unroll
        for (int et = 0; et < 4; ++et) sq += (acc[et][0] * acc[et][0] + acc[et][1] * acc[et][1]) + (acc[et][2] * acc[et][2] + acc[et][3] * acc[et][3]);
        sq += x16f(sq); sq += x32f(sq);
        const float rs = rsqrtf(sq * (1.0f / 64.0f) + EPS);
#pragma unroll
        for (int et = 0; et < 4; ++et) {
            const u32x2 gw = *(const u32x2*)(PROJ + (size_t)row * NPROJ + C_HG + h * 64 + 16 * et + 4 * grp);
            const float g0 = bf_lo(gw.x), g1 = bf_hi(gw.x), g2 = bf_lo(gw.y), g3 = bf_hi(gw.y);
            u32x2 o; o.x = pk2(acc[et][0] * rs * (g0 * sigmoidf_(g0)), acc[et][1] * rs * (g1 * sigmoidf_(g1))); o.y = pk2(acc[et][2] * rs * (g2 * sigmoidf_(g2)), acc[et][3] * rs * (g3 * sigmoidf_(g3)));
            *(u32x2*)(MIX + (size_t)row * DM + 768 + h * 64 + 16 * et + 4 * grp) = o;
        }
    }
}

__device__ __forceinline__ void phase_cmp2(const Frame& F, const Args& a, int l) {
    const int kv = F.bid >> 7, rbase = (F.bid & 127) * 32, lane = F.lane;
    LAS float* w2s = (LAS float*)F.lds;
    LAS float* hids = (LAS float*)(F.lds + 65536) + F.wave * 256;
    const float* bias = (const float*)(F.ws + WS_B1P + 65536) + (l * 2 + kv) * 256;
    const f32x4 bv = *(const f32x4*)(bias + 4 * lane);
    bf16_t* dstb = (bf16_t*)(F.ws + (kv == 0 ? WS_KCMP : WS_VCMP));
    f32x4 hs4[4];
#pragma unroll
    for (int rr = 0; rr < 4; ++rr) { const int rowi = rbase + F.wave * 4 + rr; f32x4 t4 = bv;
#pragma unroll
        for (int ks = 0; ks < 2; ++ks) t4 = t4 + *(const f32x4*)((const float*)(F.ws + ws_slab(kv, ks)) + (size_t)rowi * 256 + 4 * lane);
        hs4[rr] = t4; }
    { const float* w2 = a.cmp_w2 + (size_t)(l * 2 + kv) * 256 * 64;
#pragma unroll
      for (int i = 0; i < 8; ++i) *(LAS f32x4*)(w2s + (F.tid + 512 * i) * 4) = *(const f32x4*)(w2 + (F.tid + 512 * i) * 4); }
    __syncthreads();
#pragma unroll
    for (int rr = 0; rr < 4; ++rr) {
        const int rowi = rbase + F.wave * 4 + rr;
        f32x4 hsum = hs4[rr];
#pragma unroll
        for (int e = 0; e < 4; ++e) hsum[e] = hsum[e] * sigmoidf_(hsum[e]);
        asm volatile("s_waitcnt lgkmcnt(0)" ::: "memory");
        *(LAS f32x4*)(hids + 4 * lane) = hsum;
        asm volatile("s_waitcnt lgkmcnt(0)" ::: "memory");
        float s0 = 0.f, s1 = 0.f;
#pragma unroll 8
        for (int j = 0; j < 256; j += 4) { const f32x4 h4 = *(const LAS f32x4*)(hids + j);
            s0 += h4.x * w2s[(j + 0) * 64 + lane] + h4.z * w2s[(j + 2) * 64 + lane]; s1 += h4.y * w2s[(j + 1) * 64 + lane] + h4.w * w2s[(j + 3) * 64 + lane]; }
        dstb[(size_t)rowi * 64 + lane] = ((rowi & 127) == 127) ? (bf16_t)0 : (bf16_t)f2bf(s0 + s1);
    }
    __syncthreads();
}

constexpr int NPH = 1 + 8 * DEPTH;

template <int KF> __device__ __forceinline__ constexpr bool kf_on(int kind) { return KF < 0 || kind == KF || (kind >= 10 && kind / 10 == KF) || (KF >= 10 && KF / 10 == kind); }
template <int KF> __device__ __forceinline__ void mega_body(const Args& args_in) {
    extern __shared__ __attribute__((aligned(16))) unsigned char lds_raw[];
    LAS unsigned char* const lds = (LAS unsigned char*)lds_raw;
    {
        const int tid0 = threadIdx.x;
        const unsigned hw0 = (unsigned)__builtin_amdgcn_s_getreg((5 << 11) | 4) & 63u;
        if ((tid0 & 63) == 0) ((LAS unsigned*)(lds + LDS_WTAB))[hw0] = (unsigned)(tid0 >> 6);
        if (tid0 == 0) { ((LAS unsigned*)(lds + LDS_XBST))[0] = 0u; ((LAS unsigned*)(lds + LDS_XBST))[1] = 0u;
#if MK_ONE_LAUNCH
            (void)xb_add((unsigned*)(args_in.ws + WS_CTL) + CW_BAR + XB_XCNT(xb_xcc_id()), 1u);
#endif
        }
        if (tid0 == 0) { LAS Args* la = (LAS Args*)(lds + LDS_ARGS);
            la->x = args_in.x; la->p = args_in.p; la->w_in = args_in.w_in; la->w_out = args_in.w_out; la->cmp_pos = args_in.cmp_pos; la->cmp_w1 = args_in.cmp_w1; la->cmp_w2 = args_in.cmp_w2; la->hg_lb = args_in.hg_lb;
            la->g_pre_mix = args_in.g_pre_mix; la->g_post_mix = args_in.g_post_mix; la->g_pre_mlp = args_in.g_pre_mlp; la->g_post_mlp = args_in.g_post_mlp; la->w_up = args_in.w_up; la->w_down = args_in.w_down;
            la->g_ple = args_in.g_ple; la->w_ple_gate = args_in.w_ple_gate; la->w_ple_proj = args_in.w_ple_proj; la->out = args_in.out; la->ws = args_in.ws; }
        __syncthreads();
    }
#if MK_ONE_LAUNCH
    const int lo = 0, hi = NPH;
#else
    const int lo = args_in.ph_lo, hi = args_in.ph_hi;
#endif
#define PHASE_KIND_FILTER(kind) kf_on<KF>(kind)
#define INK(kind, k) (PHASE_KIND_FILTER(kind) && lo <= (k) && (k) < hi)
#define IN(k) (lo <= (k) && (k) < hi)
#define SEAM(k) do { if (IN(k) && IN((k) + 1)) { if ((k) == 0) { cg::this_grid().sync(); } else { Args a_; const Frame Fb = make_frame(lds, a_); \
        xcd_barrier((unsigned*)(Fb.ws + WS_CTL) + CW_BAR, (volatile LAS unsigned*)(lds + LDS_XBST), Fb.tid == 0, (unsigned)Fb.G); } } } while (0)
#define PHASE_BEGIN Args args; const Frame F = make_frame(lds, args); \
    unsigned* const ctl = (unsigned*)(F.ws + WS_CTL); bf16_t* const PROJ = (bf16_t*)(F.ws + WS_PROJ); bf16_t* const MIX = (bf16_t*)(F.ws + WS_MIX); bf16_t* const HBA = (bf16_t*)(F.ws + WS_HBA); bf16_t* const HBB = (bf16_t*)args.out; \
    bf16_t* const U = (bf16_t*)(F.ws + WS_U); bf16_t* const PP = (bf16_t*)(F.ws + WS_PP); bf16_t* const PB = (bf16_t*)(F.ws + WS_PB); float* const SSA = (float*)(F.ws + WS_SSA); float* const SSB = (float*)(F.ws + WS_SSB); float* const XBUF = (float*)(F.ws + WS_XBUF); \
    (void)ctl; (void)PROJ; (void)MIX; (void)HBA; (void)HBB; (void)U; (void)PP; (void)PB; (void)SSA; (void)SSB; (void)XBUF;

    for (int rep_ = 0; rep_ < REP_P0; ++rep_) if (INK(0, 0)) { PHASE_BEGIN phase_prologue(F, args); }
    SEAM(0);

#pragma unroll 1
    for (int l = 0; l < DEPTH; ++l) {
        const int pb = 1 + 8 * l;
        for (int rep_ = 0; rep_ < REP_G1; ++rep_) if (INK(1, pb + 0)) { PHASE_BEGIN
            if (l == 0) reduce_bias1(F);
            pg8::Gemm g = pg8::make_gemm(HBB, (const bf16_t*)(F.ws + WS_WIN) + (size_t)l * NPROJ * DM, DM);
            pg8::StaticOrder S; S.init(MTOK, NPROJ, F.G, F.bid);
            fill_rstd(F, SSB, S);
            pg8::EpiBf<1> E{PROJ, NPROJ, (const LAS float*)(F.lds + LDS_RSTD), nullptr};
            pg8::gemm_phase<pg8::EpiBf<1>, pg8::StaticOrder, true>(F.lds, g, S, E);
        }
        SEAM(pb + 0);
        for (int rep_ = 0; rep_ < REP_P2; ++rep_) if (INK(2, pb + 1)) { PHASE_BEGIN
            for (int r2_ = 0; r2_ < REP_HL; ++r2_) if (PHASE_KIND_FILTER(21)) { hgrn_local(F, args, l, F.bid * 8 + F.wave); __syncthreads(); }
            for (int r2_ = 0; r2_ < REP_CG; ++r2_) if (F.bid < 64 && PHASE_KIND_FILTER(20)) {
                const int ks = F.bid & 1, bb = (F.bid >> 1) & 15, kv = F.bid >> 5;
                pg8::Gemm g; g.A = PROJ + (kv == 0 ? C_KC : C_VC) + (size_t)(16 * ks) * NPROJ; g.Bt = (const bf16_t*)(F.ws + WS_W1T) + (size_t)(l * 2 + kv) * 256 * 2048 + 1024 * ks; g.K = 1024; g.ldb = 2048;
                asm volatile("" : "+s"(g.K));
                g.lda = 16 * NPROJ; g.a_kstep = (long)NPROJ * 2; g.a_hstep = 128; g.a_tstep = (long)SEQ * NPROJ * 2;
                pg8::OneFixed S; S.u0.pm = bb; S.u0.pn = 0; S.valid = true;
                pg8::EpiF32P E{(float*)(F.ws + ws_slab(kv, ks)), 256};
                pg8::gemm_phase<pg8::EpiF32P, pg8::OneFixed, false>(F.lds, g, S, E);
                __syncthreads();
            }
            if (F.bid >= 64) {
                for (int r2_ = 0; r2_ < REP_DL; ++r2_) if (PHASE_KIND_FILTER(22)) dil_units(F, F.bid - 64, 192);
            }
        }
        SEAM(pb + 1);
        if (INK(3, pb + 2)) { PHASE_BEGIN for (int r2_ = 0; r2_ < REP_C2; ++r2_) phase_cmp2(F, args, l); for (int r2_ = 0; r2_ < REP_SC; ++r2_) hgrn_scan(F); dil_fixup(F); }
        SEAM(pb + 2);
        for (int rep_ = 0; rep_ < REP_P4; ++rep_) if (INK(4, pb + 3)) { PHASE_BEGIN
            for (int r2_ = 0; r2_ < REP_HF; ++r2_) { hgrn_final(F, F.bid * 8 + F.wave); __syncthreads(); }
            {
                unsigned* qhead = ctl + CW_NSAQ + 64 * l;
                LAS unsigned* qw = (LAS unsigned*)(F.lds + LDS_QW);
#pragma unroll 1
                for (;;) {
                    __syncthreads();
                    if (F.tid == 0) *qw = __hip_atomic_fetch_add(qhead, 1u, __ATOMIC_RELAXED, __HIP_MEMORY_SCOPE_AGENT);
                    __syncthreads();
                    const unsigned idx = (unsigned)__builtin_amdgcn_readfirstlane((int)*qw);
                    if (idx >= 512u) break;
                    const int jb = 15 - (int)(idx >> 5), kvh = (int)(idx & 1u), bb = (int)((idx >> 1) & 15u);
                    nsa_unit2(F, bb, kvh, jb);
                }
            }
        }
        SEAM(pb + 3);
        if (INK(5, pb + 4)) { PHASE_BEGIN
            convert_p(F, args, l);
            pg8::Gemm g = pg8::make_gemm(MIX, (const bf16_t*)(F.ws + WS_WOUT) + (size_t)l * DM * DM, DM);
            pg8::StaticOrder S; S.init(MTOK, DM, F.G, F.bid);
            pg8::EpiPost E{HBB, HBA, args.g_post_mix + l * DM, SSA, XBUF, ctl + CW_CNT + ((l * 2 + 0) * 128) * 64, ctl + CW_TMO, F.lds + LDS_RSTD};
            pg8::gemm_phase<pg8::EpiPost, pg8::StaticOrder, true>(F.lds, g, S, E);
        }
        SEAM(pb + 4);
        for (int rep_ = 0; rep_ < REP_G3; ++rep_) if (INK(6, pb + 5)) { PHASE_BEGIN
            if (PHASE_KIND_FILTER(60)) {
                pg8::Gemm g = pg8::make_gemm(HBA, (const bf16_t*)(F.ws + WS_WUP) + (size_t)l * FF * DM, DM);
                pg8::StaticOrder S; S.init(MTOK, FF, F.G, F.bid);
                fill_rstd(F, SSA, S);
                pg8::EpiBf<2> E{U, FF, (const LAS float*)(F.lds + LDS_RSTD), nullptr};
                pg8::gemm_phase<pg8::EpiBf<2>, pg8::StaticOrder, true>(F.lds, g, S, E);
            }
        }
        SEAM(pb + 5);
        if (INK(7, pb + 6)) { PHASE_BEGIN
            pg8::Gemm g = pg8::make_gemm(U, (const bf16_t*)(F.ws + WS_WDN) + (size_t)l * DM * FF, FF);
            pg8::StaticOrder S; S.init(MTOK, DM, F.G, F.bid);
            pg8::EpiPost E{HBA, HBA, args.g_post_mlp + l * DM, SSA, XBUF, ctl + CW_CNT + ((l * 2 + 1) * 128) * 64, ctl + CW_TMO, F.lds + LDS_RSTD};
            pg8::gemm_phase<pg8::EpiPost, pg8::StaticOrder, true>(F.lds, g, S, E);
        }
        SEAM(pb + 6);
        if (INK(8, pb + 7)) { PHASE_BEGIN
            {
                pg8::Gemm gp = pg8::make_gemm(PB, (const bf16_t*)(F.ws + WS_WPJ) + (size_t)l * DM * PLE, PLE);
                pg8::StaticOrder Sp; Sp.init(MTOK, DM, F.G, F.bid);
                pg8::EpiBf<0> Ep{PP, DM, nullptr, nullptr};
                pg8::gemm_phase<pg8::EpiBf<0>, pg8::StaticOrder, true>(F.lds, gp, Sp, Ep);
                asm volatile("s_waitcnt vmcnt(0)" ::: "memory");
                __syncthreads();
            }
            pg8::Gemm g = pg8::make_gemm(HBA, (const bf16_t*)(F.ws + WS_WG) + (size_t)l * DM * DM, DM);
            pg8::StaticOrder S; S.init(MTOK, DM, F.G, F.bid);
            fill_rstd(F, SSA, S);
            pg8::EpiPle E{(const LAS float*)(F.lds + LDS_RSTD), PP, HBA, (l == DEPTH - 1) ? args.out : (float*)nullptr, HBB, SSB};
            pg8::gemm_phase<pg8::EpiPle, pg8::StaticOrder, true>(F.lds, g, S, E);
        }
        SEAM(pb + 7);
    }
#undef IN
#undef SEAM
#undef INK
#undef PHASE_KIND_FILTER
#undef PHASE_BEGIN
}
template <int KF> __global__ void __launch_bounds__(512, 2) mega_k(Args args) { mega_body<KF>(args); }

template <int KF> static bool setup_kernel() {
    return hipFuncSetAttribute((const void*)mega_k<KF>, hipFuncAttributeMaxDynamicSharedMemorySize, LDS_BYTES) == hipSuccess;
}
template <int KF> static void launch_phase(int grid, const Args& a, hipStream_t stream) {
    hipLaunchKernelGGL(mega_k<KF>, dim3(grid), dim3(512), LDS_BYTES, stream, a);
}
extern "C" void kernel_launch(void* const* d_in, const int* in_sizes, int n_in, void* d_out, int out_size, void* d_ws, size_t ws_size, hipStream_t stream) {
    static int grid = 0;
    if (grid == 0) {
        if (n_in != 17 || in_sizes[0] != MTOK * DM || out_size != MTOK * DM || ws_size < WS_END) {
            fprintf(stderr, "kernel_launch: unexpected problem (n_in %d, in0 %d, out %d, ws %zu)\n", n_in, n_in > 0 ? in_sizes[0] : -1, out_size, ws_size); grid = -1; return; }
        int dev = 0, cus = 0, per_cu = 0;
        (void)hipGetDevice(&dev); (void)hipDeviceGetAttribute(&cus, hipDeviceAttributeMultiprocessorCount, dev);
        bool ok = true;
#if MK_ONE_LAUNCH
        ok = setup_kernel<-1>();
        if (hipOccupancyMaxActiveBlocksPerMultiprocessor(&per_cu, (const void*)mega_k<-1>, 512, LDS_BYTES) != hipSuccess || per_cu < 1) { fprintf(stderr, "kernel_launch: occupancy query says %d\n", per_cu); }
#else
        ok = setup_kernel<0>() && setup_kernel<1>() && setup_kernel<20>() && setup_kernel<21>() && setup_kernel<22>() && setup_kernel<3>() && setup_kernel<4>() && setup_kernel<5>() && setup_kernel<6>() && setup_kernel<7>() && setup_kernel<8>();
#endif
        if (!ok) { fprintf(stderr, "kernel_launch: hipFuncSetAttribute failed\n"); grid = -1; return; }
        (void)hipGetLastError();
        grid = cus;
        if (grid != 256) fprintf(stderr, "kernel_launch: %d CUs; this kernel is built for 256\n", grid);
    }
    if (grid < 0) return;
    (void)hipMemsetAsync((char*)d_ws + WS_CTL, 0, CTL_BYTES, stream);
    Args a{};
    a.x = (const float*)d_in[0]; a.p = (const float*)d_in[1]; a.w_in = (const float*)d_in[2]; a.w_out = (const float*)d_in[3]; a.cmp_pos = (const float*)d_in[4];
    a.cmp_w1 = (const float*)d_in[5]; a.cmp_w2 = (const float*)d_in[6]; a.hg_lb = (const float*)d_in[7]; a.g_pre_mix = (const float*)d_in[8]; a.g_post_mix = (const float*)d_in[9];
    a.g_pre_mlp = (const float*)d_in[10]; a.g_post_mlp = (const float*)d_in[11]; a.w_up = (const float*)d_in[12]; a.w_down = (const float*)d_in[13]; a.g_ple = (const float*)d_in[14];
    a.w_ple_gate = (const float*)d_in[15]; a.w_ple_proj = (const float*)d_in[16];
    a.out = (float*)d_out; a.ws = (unsigned char*)d_ws;
#if MK_ONE_LAUNCH
    a.ph_lo = 0; a.ph_hi = NPH;
    void* kargs[] = {&a};
    hipError_t e = hipLaunchCooperativeKernel((const void*)mega_k<-1>, dim3(grid), dim3(512), kargs, LDS_BYTES, stream);
    if (e != hipSuccess) fprintf(stderr, "kernel_launch: cooperative launch failed: %s\n", hipGetErrorString(e));
#else
    for (int ph = 0; ph < NPH; ++ph) {
        a.ph_lo = ph; a.ph_hi = ph + 1;
        const int kind = (ph == 0) ? 0 : ((ph - 1) % 8) + 1;
        switch (kind) {
            case 0: launch_phase<0>(grid, a, stream); break;
            case 1: launch_phase<1>(grid, a, stream); break;
            case 2: launch_phase<20>(grid, a, stream); launch_phase<21>(grid, a, stream); launch_phase<22>(grid, a, stream); break;
            case 3: launch_phase<3>(grid, a, stream); break;
            case 4: launch_phase<4>(grid, a, stream); break;
            case 5: launch_phase<5>(grid, a, stream); break;
            case 6: launch_phase<6>(grid, a, stream); break;
            case 7: launch_phase<7>(grid, a, stream); break;
            default: launch_phase<8>(grid, a, stream); break;
        }
    }
#endif
}
```

```cpp
#include <hip/hip_runtime.h>
#include <hip/hip_cooperative_groups.h>
#include <cstdio>
#include <cstdint>
namespace cg = cooperative_groups;

#ifndef REP_P0
#define REP_P0 1
#endif
#ifndef REP_HL
#define REP_HL 1
#endif
#ifndef REP_CG
#define REP_CG 1
#endif
#ifndef REP_DL
#define REP_DL 1
#endif
#ifndef REP_HF
#define REP_HF 1
#endif
#ifndef REP_NSA
#define REP_NSA 1
#endif
#ifndef REP_CMP
#define REP_CMP 1
#endif
#ifndef REP_SEL
#define REP_SEL 1
#endif
#ifndef REP_WIN
#define REP_WIN 1
#endif
#ifndef REP_C2
#define REP_C2 1
#endif
#ifndef REP_SC
#define REP_SC 1
#endif
#ifndef REP_G1
#define REP_G1 1
#endif
#ifndef REP_P2
#define REP_P2 1
#endif
#ifndef REP_P4
#define REP_P4 1
#endif
#ifndef REP_G3
#define REP_G3 1
#endif
#ifndef MK_ONE_LAUNCH
#define MK_ONE_LAUNCH 1
#endif

constexpr int BATCH = 16, SEQ = 2048, DM = 1024, MTOK = BATCH * SEQ, DEPTH = 2;
constexpr int FF = 4096, PLE = 256;
constexpr int IN_TOTAL = 3346, NPROJ = 3584;
constexpr int C_NQ = 0, C_KC = 384, C_VC = 512, C_KS = 640, C_VS = 768, C_KW = 896, C_VW = 1024;
constexpr int C_DQ = 1152, C_DK = 1536, C_DV = 1920, C_HQ = 2304, C_HF = 2560, C_HI = 2816, C_HG = 3072, C_GATE = 3328;
constexpr float EPS = 1e-6f;
constexpr float NEGBIG = -1e30f;

constexpr size_t MiB = 1u << 20;
constexpr size_t WS_CTL = 0, CTL_BYTES = 1 * MiB;
constexpr size_t WS_SSA = 1 * MiB;
constexpr size_t WS_SSB = 3 * MiB;
constexpr size_t WS_XBUF = 5 * MiB;
constexpr size_t WS_KCMP = 6 * MiB;
constexpr size_t WS_VCMP = 7 * MiB;
constexpr size_t WS_HID = 8 * MiB;
constexpr size_t WS_WIN = 12 * MiB;
constexpr size_t WS_WOUT = 26 * MiB;
constexpr size_t WS_WUP = 30 * MiB;
constexpr size_t WS_WDN = 46 * MiB;
constexpr size_t WS_WG = 62 * MiB;
constexpr size_t WS_WPJ = 66 * MiB;
constexpr size_t WS_W1T = 67 * MiB;
constexpr size_t WS_B1P = 71 * MiB;
constexpr size_t WS_PB = 72 * MiB;
constexpr size_t WS_HBA = 88 * MiB;
constexpr size_t WS_PP = 152 * MiB;
constexpr size_t WS_PROJ = 216 * MiB;
constexpr size_t WS_MIX = 440 * MiB;
constexpr size_t WS_U = 216 * MiB;
constexpr size_t WS_END = 504 * MiB;
constexpr size_t WS_OLOC = WS_HBA;
constexpr size_t WS_QE = WS_HBA + 32 * MiB;
constexpr size_t WS_HUS = WS_HBA + 48 * MiB;
constexpr size_t WS_HU = WS_PP;
constexpr size_t WS_HD = WS_PP + 32 * MiB;
constexpr size_t WS_LSE = WS_PP + 33 * MiB;
__host__ __device__ constexpr size_t ws_slab(int kv, int ks) { return (kv == 0 ? WS_PB : WS_PP + 48 * MiB) + (size_t)ks * 4 * MiB; }
constexpr int CW_TMO = 0;
constexpr int CW_BAR = 65536;
constexpr int CW_NSAQ = 512;
constexpr int CW_CNT = 1024;

constexpr int RING_BYTES = 131072;
constexpr int MISC_OFF = RING_BYTES;
constexpr int LDS_BYTES = 163840;
constexpr int LDS_ARGS = MISC_OFF + 4096;
constexpr int LDS_XBST = MISC_OFF + 4096 + 256;
constexpr int LDS_QW = MISC_OFF + 4096 + 320;
constexpr int LDS_WTAB = MISC_OFF + 4096 + 512;
constexpr int LDS_RSTD = MISC_OFF + 8192;

#define LAS __attribute__((address_space(3)))
typedef unsigned short bf16_t;
typedef float f32x4 __attribute__((ext_vector_type(4)));
typedef float f32x2 __attribute__((ext_vector_type(2)));
typedef unsigned u32x4 __attribute__((ext_vector_type(4)));
typedef unsigned u32x2 __attribute__((ext_vector_type(2)));

__device__ __forceinline__ float bf_lo(unsigned u) { return __uint_as_float(u << 16); }
__device__ __forceinline__ float bf_hi(unsigned u) { return __uint_as_float(u & 0xffff0000u); }
__device__ __forceinline__ unsigned f2bf(float f) { unsigned u = __float_as_uint(f); return (u + 0x7fffu + ((u >> 16) & 1u)) >> 16; }
__device__ __forceinline__ unsigned pk2(float lo, float hi) { return f2bf(lo) | (f2bf(hi) << 16); }
__device__ __forceinline__ float rcpf_(float x) { return __builtin_amdgcn_rcpf(x); }
__device__ __forceinline__ float sigmoidf_(float x) { return rcpf_(1.0f + __expf(-x)); }
__device__ __forceinline__ unsigned x16u(unsigned v) { auto r = __builtin_amdgcn_permlane16_swap(v, v, false, false); return r[0] ^ r[1] ^ v; }
__device__ __forceinline__ unsigned x32u(unsigned v) { auto r = __builtin_amdgcn_permlane32_swap(v, v, false, false); return r[0] ^ r[1] ^ v; }
__device__ __forceinline__ float x16f(float v) { return __uint_as_float(x16u(__float_as_uint(v))); }
__device__ __forceinline__ float x32f(float v) { return __uint_as_float(x32u(__float_as_uint(v))); }
template <int CTRL> __device__ __forceinline__ unsigned dppu(unsigned v) { return (unsigned)__builtin_amdgcn_update_dpp((int)v, (int)v, CTRL, 0xf, 0xf, false); }
__device__ __forceinline__ float row_sum16(float v) {
    v += __uint_as_float(dppu<0xB1>(__float_as_uint(v))); v += __uint_as_float(dppu<0x4E>(__float_as_uint(v)));
    v += __uint_as_float(dppu<0x141>(__float_as_uint(v))); v += __uint_as_float(dppu<0x140>(__float_as_uint(v))); return v;
}
__device__ __forceinline__ unsigned row_or16(unsigned v) { v |= dppu<0xB1>(v); v |= dppu<0x4E>(v); v |= dppu<0x141>(v); v |= dppu<0x140>(v); return v; }
__device__ __forceinline__ float wave_sum(float v) { v = row_sum16(v); v += x16f(v); v += x32f(v); return v; }

__host__ __device__ __forceinline__ constexpr size_t pj_off(long row, int col) { return ((size_t)(col >> 6) * (size_t)(16 * 2048) + (size_t)row) * 64 + (size_t)(col & 63); }
namespace pg8 {
#define PG8_LAS __attribute__((address_space(3)))
typedef short bf16x8 __attribute__((ext_vector_type(8)));
constexpr int BM = 256, BK = 64, HALF = 128, HTB = HALF * BK * 2, STAGE_BYTES = 8 * HTB, NXCD = 8, WGM = 8;

__host__ __device__ __forceinline__ int lds_byte(int r, int c) { const int st = (r >> 4) * 2 + (c >> 5), rr = r & 15, cc = c & 31, ob = rr * 64 + cc * 2; return st * 1024 + (ob ^ (((ob >> 9) & 1) << 5)); }
__host__ __device__ __forceinline__ void stage_rc(int b, int& R, int& C) { const int st = b / 1024, sb = b % 1024, swz = sb ^ (((sb >> 9) & 1) << 5); R = (st >> 1) * 16 + swz / 64; C = (st & 1) * 32 + (swz % 64) / 2; }
__host__ __device__ __forceinline__ int perm32(int rho) { const int n = rho >> 4, i = rho & 15; return 8 * (i >> 2) + 4 * n + (i & 3); }

struct Unit { int pm, pn; };
struct Gemm { const bf16_t* A; const bf16_t* Bt; int K; int lda; long a_kstep, a_hstep, a_tstep; int ldb; long b_kstep, b_hstep, b_tstep; };
__device__ __forceinline__ Gemm make_gemm(const bf16_t* A, const bf16_t* Bt, int K, int N) { asm volatile("" : "+s"(K)); Gemm g; g.A = A; g.Bt = Bt; g.K = K; g.lda = K; g.a_kstep = BK * 2; g.a_hstep = (long)HALF * K * 2; g.a_tstep = 2 * g.a_hstep;
    g.ldb = 64; g.b_kstep = (long)N * 64 * 2; g.b_hstep = (long)HALF * 64 * 2; g.b_tstep = 2 * g.b_hstep; return g; }

struct StaticOrder {
    int nM, nN, nwg, G, c;
    __device__ void init(int M, int N, int G_, int c_) { nM = M / BM; nN = N / BM; nwg = nM * nN; G = G_; c = c_; }
    __device__ bool next(int i, Unit& u) const {
        const long L = (long)i * G + c; if (L >= nwg) return false;
        int wgid = (int)L; { const int q = nwg / NXCD, r = nwg % NXCD, xcd = wgid % NXCD, off = wgid / NXCD; wgid = (xcd < r ? xcd * (q + 1) : r * (q + 1) + (xcd - r) * q) + off; }
        const int nig = WGM * nN, gid = wgid / nig, fm = gid * WGM, gsz = (nM - fm) < WGM ? (nM - fm) : WGM;
        u.pm = fm + ((wgid % nig) % gsz); u.pn = (wgid % nig) / gsz; return true;
    }
};
struct OneOf { StaticOrder S; int i;
    __device__ bool next(int j, Unit& u) const { return j == 0 ? S.next(i, u) : false; } };
struct OneFixed { Unit u0; bool valid;
    __device__ bool next(int j, Unit& u) const { if (j == 0 && valid) { u = u0; return true; } return false; } };

__device__ __forceinline__ unsigned cvt_pk_bf16(float lo, float hi) { unsigned r; asm volatile("v_cvt_pk_bf16_f32 %0, %1, %2" : "=v"(r) : "v"(lo), "v"(hi)); return r; }

__device__ __forceinline__ float row_rstd16(const float* ss, long row) {
    const f32x4* sp = (const f32x4*)(ss + row * 16);
    const f32x4 a = sp[0], b = sp[1], c = sp[2], d = sp[3];
    const float tot = ((a.x + a.y) + (a.z + a.w)) + ((b.x + b.y) + (b.z + b.w)) + ((c.x + c.y) + (c.z + c.w)) + ((d.x + d.y) + (d.z + d.w));
    return rsqrtf(tot * (1.0f / 1024.0f) + EPS);
}

template <int MODE, int BLK = 0> struct EpiBf {
    static constexpr bool PERM = true, AFTER_DRAIN = false;
    bf16_t* O; int ldc; const PG8_LAS float* rstd; const float* bias;
    __device__ __forceinline__ void operator()(const f32x4 (&acc)[2][2][4][2], const Unit& u, int ui, int wr, int wc, int fr, int fq) const {
        const int row0 = u.pm * BM + wr * 64 + fr; const int col0 = u.pn * BM + wc * 32 + 8 * fq;
        f32x4 bv[2][2];
        if (MODE == 3) {
#pragma unroll
            for (int bj = 0; bj < 2; ++bj)
#pragma unroll
                for (int n = 0; n < 2; ++n) bv[bj][n] = *(const f32x4*)(bias + col0 + bj * HALF + 4 * n);
        }
#pragma unroll
        for (int ai = 0; ai < 2; ++ai)
#pragma unroll
            for (int m = 0; m < 4; ++m) {
                const long row = row0 + ai * HALF + m * 16;
                float rs = 1.0f;
                if (MODE == 1 || MODE == 2) rs = rstd[ui * 256 + wr * 64 + fr + ai * HALF + m * 16];
                bf16_t* rowp = O + (size_t)row * ldc + col0;
#pragma unroll
                for (int bj = 0; bj < 2; ++bj) {
                    f32x4 v0 = acc[ai][bj][m][0], v1 = acc[ai][bj][m][1];
                    if (MODE == 1) { v0 = v0 * rs; v1 = v1 * rs; }
                    if (MODE == 2) {
                        v0 = v0 * rs; v1 = v1 * rs;
#pragma unroll
                        for (int e = 0; e < 4; ++e) { const float a = fmaxf(v0[e], 0.f), b = fmaxf(v1[e], 0.f); v0[e] = a * a; v1[e] = b * b; }
                    }
                    if (MODE == 3) {
                        v0 = v0 + bv[bj][0]; v1 = v1 + bv[bj][1];
#pragma unroll
                        for (int e = 0; e < 4; ++e) { v0[e] = v0[e] * sigmoidf_(v0[e]); v1[e] = v1[e] * sigmoidf_(v1[e]); }
                    }
                    u32x4 w; w.x = cvt_pk_bf16(v0[0], v0[1]); w.y = cvt_pk_bf16(v0[2], v0[3]); w.z = cvt_pk_bf16(v1[0], v1[1]); w.w = cvt_pk_bf16(v1[2], v1[3]);
                    if (BLK) *(u32x4*)(O + pj_off(row, col0 + bj * HALF)) = w; else *(u32x4*)(rowp + bj * HALF) = w;
                }
            }
    }
};

struct EpiF32P {
    static constexpr bool PERM = false, AFTER_DRAIN = false;
    float* C; int ldc;
    __device__ __forceinline__ void operator()(const f32x4 (&acc)[2][2][4][2], const Unit& u, int ui, int wr, int wc, int fr, int fq) const {
        const int row0 = u.pm * BM + wr * 64 + fr, col0 = u.pn * BM + wc * 32 + 4 * fq;
#pragma unroll
        for (int ai = 0; ai < 2; ++ai)
#pragma unroll
            for (int m = 0; m < 4; ++m) { float* rowp = C + (size_t)(row0 + ai * HALF + m * 16) * ldc + col0;
#pragma unroll
                for (int bj = 0; bj < 2; ++bj)
#pragma unroll
                    for (int n = 0; n < 2; ++n) *(f32x4*)(rowp + bj * HALF + n * 16) = acc[ai][bj][m][n]; }
    }
};
struct EpiPle {
    static constexpr bool PERM = true, AFTER_DRAIN = false;
    const PG8_LAS float* rstd; const bf16_t* pp; const bf16_t* hin; float* outf; bf16_t* hb; float* sso;
    __device__ __forceinline__ void operator()(const f32x4 (&acc)[2][2][4][2], const Unit& u, int ui, int wr, int wc, int fr, int fq) const {
        const int row0 = u.pm * BM + wr * 64 + fr; const int col0 = u.pn * BM + wc * 32 + 8 * fq;
        u32x4 pw[2][2][2], hw[2][2][2];
#define PLE_LOAD(set_, b_) do { _Pragma("unroll") for (int q_ = 0; q_ < 2; ++q_) { const long row_ = row0 + ((b_) >> 1) * HALF + (((b_) & 1) * 2 + q_) * 16; \
            _Pragma("unroll") for (int bj_ = 0; bj_ < 2; ++bj_) { const size_t off_ = (size_t)row_ * DM + col0 + bj_ * HALF; pw[set_][q_][bj_] = *(const u32x4*)(pp + off_); hw[set_][q_][bj_] = *(const u32x4*)(hin + off_); } } } while (0)
        PLE_LOAD(0, 0); PLE_LOAD(1, 1);
#pragma unroll
        for (int b = 0; b < 4; ++b) {
            const int set = b & 1, ai = b >> 1;
#pragma unroll
            for (int q = 0; q < 2; ++q) {
                const int m = (b & 1) * 2 + q;
                const long row = row0 + ai * HALF + m * 16;
                const float rs = rstd[ui * 256 + wr * 64 + fr + ai * HALF + m * 16];
                float sq = 0.f;
#pragma unroll
                for (int bj = 0; bj < 2; ++bj) {
                    const size_t off = (size_t)row * DM + col0 + bj * HALF;
                    const u32x4 pwv = pw[set][q][bj], hwv = hw[set][q][bj];
                    const f32x4 a0 = acc[ai][bj][m][0] * rs, a1 = acc[ai][bj][m][1] * rs;
                    f32x4 o0, o1;
                    o0[0] = bf_lo(hwv.x) + bf_lo(pwv.x) * sigmoidf_(a0[0]); o0[1] = bf_hi(hwv.x) + bf_hi(pwv.x) * sigmoidf_(a0[1]);
                    o0[2] = bf_lo(hwv.y) + bf_lo(pwv.y) * sigmoidf_(a0[2]); o0[3] = bf_hi(hwv.y) + bf_hi(pwv.y) * sigmoidf_(a0[3]);
                    o1[0] = bf_lo(hwv.z) + bf_lo(pwv.z) * sigmoidf_(a1[0]); o1[1] = bf_hi(hwv.z) + bf_hi(pwv.z) * sigmoidf_(a1[1]);
                    o1[2] = bf_lo(hwv.w) + bf_lo(pwv.w) * sigmoidf_(a1[2]); o1[3] = bf_hi(hwv.w) + bf_hi(pwv.w) * sigmoidf_(a1[3]);
                    if (outf) { *(f32x4*)(outf + off) = o0; *(f32x4*)(outf + off + 4) = o1; }
                    else {
                        sq += (o0[0] * o0[0] + o0[1] * o0[1]) + (o0[2] * o0[2] + o0[3] * o0[3]) + (o1[0] * o1[0] + o1[1] * o1[1]) + (o1[2] * o1[2] + o1[3] * o1[3]);
                        u32x4 w; w.x = cvt_pk_bf16(o0[0], o0[1]); w.y = cvt_pk_bf16(o0[2], o0[3]); w.z = cvt_pk_bf16(o1[0], o1[1]); w.w = cvt_pk_bf16(o1[2], o1[3]);
                        *(u32x4*)(hb + off) = w;
                    }
                }
                if (!outf) { sq += x16f(sq); sq += x32f(sq); if (fq == 0) sso[row * 16 + u.pn * 4 + wc] = sq; }
            }
            if (b + 2 < 4) { if (set == 0) PLE_LOAD(0, b + 2); else PLE_LOAD(1, b + 2); }
        }
#undef PLE_LOAD
    }
};
struct EpiPost {
    static constexpr bool PERM = true, AFTER_DRAIN = false;
    const bf16_t* base; bf16_t* hb; const float* gvec; float* sso; float* xbuf; unsigned* cnt_bank; unsigned* tmo; PG8_LAS unsigned char* tab;
    __device__ __forceinline__ void operator()(const f32x4 (&acc)[2][2][4][2], const Unit& u, int ui, int wr, int wc, int fr, int fq) const {
        const int wid = wr * 4 + wc, lane = fq * 16 + fr;
        unsigned* cnt = cnt_bank + u.pm * 64;
        u32x4 bpre[2][4][2];
        { const int colp = u.pn * BM + wc * 32 + 8 * fq;
#pragma unroll
          for (int ai = 0; ai < 2; ++ai)
#pragma unroll
            for (int m = 0; m < 4; ++m) { const size_t offp = (size_t)(u.pm * BM + ai * HALF + wr * 64 + m * 16 + fr) * DM + colp;
#pragma unroll
                for (int bj = 0; bj < 2; ++bj) bpre[ai][m][bj] = *(const u32x4*)(base + offp + bj * HALF); } }
        PG8_LAS float* P = (PG8_LAS float*)tab;
        PG8_LAS float* S = (PG8_LAS float*)(tab + 4096);
#pragma unroll
        for (int ai = 0; ai < 2; ++ai)
#pragma unroll
            for (int m = 0; m < 4; ++m) {
                float s = 0.f;
#pragma unroll
                for (int bj = 0; bj < 2; ++bj)
#pragma unroll
                    for (int n = 0; n < 2; ++n) { const f32x4 x = acc[ai][bj][m][n]; s += (x[0] * x[0] + x[1] * x[1]) + (x[2] * x[2] + x[3] * x[3]); }
                s += x16f(s); s += x32f(s);
                if (fq == 0) P[(ai * HALF + wr * 64 + m * 16 + fr) * 4 + wc] = s;
            }
        asm volatile("s_waitcnt lgkmcnt(0)" ::: "memory"); __builtin_amdgcn_s_barrier(); asm volatile("" ::: "memory");
        const int row = wid * 32 + (lane & 31);
        if (lane < 32) {
            const float tot = (P[row * 4 + 0] + P[row * 4 + 1]) + (P[row * 4 + 2] + P[row * 4 + 3]);
            __hip_atomic_store(xbuf + ((size_t)(u.pm * BM + row) * 4 + u.pn), tot, __ATOMIC_RELAXED, __HIP_MEMORY_SCOPE_AGENT);
        }
        asm volatile("s_waitcnt vmcnt(0)" ::: "memory");
        if (lane == 0) __hip_atomic_fetch_add(cnt, 1u, __ATOMIC_RELAXED, __HIP_MEMORY_SCOPE_AGENT);
        if (wid == 0) {
            unsigned spins = 0;
            while ((unsigned)__builtin_amdgcn_readfirstlane(__hip_atomic_load(cnt, __ATOMIC_RELAXED, __HIP_MEMORY_SCOPE_AGENT)) < 32u) {
                __builtin_amdgcn_s_sleep(2);
                if (++spins > (1u << 22)) { if (lane == 0) __hip_atomic_store(tmo, 1u, __ATOMIC_RELAXED, __HIP_MEMORY_SCOPE_AGENT); break; }
            }
            __builtin_amdgcn_fence(__ATOMIC_ACQUIRE, "agent");
        }
        asm volatile("s_waitcnt vmcnt(0) lgkmcnt(0)" ::: "memory"); __builtin_amdgcn_s_barrier(); asm volatile("" ::: "memory");
        if (lane < 32) {
            const float* slot = xbuf + (size_t)(u.pm * BM + row) * 4;
            float t0 = __hip_atomic_load(slot + 0, __ATOMIC_RELAXED, __HIP_MEMORY_SCOPE_AGENT);
            float t1 = __hip_atomic_load(slot + 1, __ATOMIC_RELAXED, __HIP_MEMORY_SCOPE_AGENT);
            float t2 = __hip_atomic_load(slot + 2, __ATOMIC_RELAXED, __HIP_MEMORY_SCOPE_AGENT);
            float t3 = __hip_atomic_load(slot + 3, __ATOMIC_RELAXED, __HIP_MEMORY_SCOPE_AGENT);
            S[row] = rsqrtf(((t0 + t1) + (t2 + t3)) * (1.0f / 1024.0f) + EPS);
        }
        asm volatile("s_waitcnt vmcnt(0) lgkmcnt(0)" ::: "memory"); __builtin_amdgcn_s_barrier(); asm volatile("" ::: "memory");
        const int col0 = u.pn * BM + wc * 32 + 8 * fq;
        f32x4 gv[2][2];
#pragma unroll
        for (int bj = 0; bj < 2; ++bj)
#pragma unroll
            for (int n = 0; n < 2; ++n) gv[bj][n] = *(const f32x4*)(gvec + col0 + bj * HALF + 4 * n);
#pragma unroll
        for (int ai = 0; ai < 2; ++ai)
#pragma unroll
            for (int m = 0; m < 4; ++m) {
                const int r = ai * HALF + wr * 64 + m * 16 + fr; const float rs = S[r];
                const size_t off = (size_t)(u.pm * BM + r) * DM + col0;
                float sq = 0.f;
#pragma unroll
                for (int bj = 0; bj < 2; ++bj) {
                    const u32x4 bw = bpre[ai][m][bj];
                    const f32x4 b0 = {bf_lo(bw.x), bf_hi(bw.x), bf_lo(bw.y), bf_hi(bw.y)}, b1 = {bf_lo(bw.z), bf_hi(bw.z), bf_lo(bw.w), bf_hi(bw.w)};
                    const f32x4 o0 = b0 + acc[ai][bj][m][0] * rs * gv[bj][0], o1 = b1 + acc[ai][bj][m][1] * rs * gv[bj][1];
                    sq += ((o0[0] * o0[0] + o0[1] * o0[1]) + (o0[2] * o0[2] + o0[3] * o0[3])) + ((o1[0] * o1[0] + o1[1] * o1[1]) + (o1[2] * o1[2] + o1[3] * o1[3]));
                    u32x4 w; w.x = cvt_pk_bf16(o0[0], o0[1]); w.y = cvt_pk_bf16(o0[2], o0[3]); w.z = cvt_pk_bf16(o1[0], o1[1]); w.w = cvt_pk_bf16(o1[2], o1[3]);
                    *(u32x4*)(hb + off + bj * HALF) = w;
                }
                sq += x16f(sq); sq += x32f(sq);
                if (fq == 0) sso[(size_t)(u.pm * BM + r) * 16 + u.pn * 4 + wc] = sq;
            }
    }
};

template <class Epi, class Sched, bool ALIGN_EPI>
__device__ __forceinline__ void gemm_phase(PG8_LAS unsigned char* lds, const Gemm g, const Sched& S, const Epi& E) {
    int tid_;
    {   int ln_; asm volatile("v_mbcnt_lo_u32_b32 %0, -1, 0\n\tv_mbcnt_hi_u32_b32 %0, -1, %0" : "=v"(ln_));
        const unsigned hw_ = (unsigned)__builtin_amdgcn_s_getreg((5 << 11) | 4) & 63u; unsigned to_ = LDS_WTAB; asm volatile("" : "+v"(to_));
        int wv_ = (int)((const PG8_LAS unsigned*)(lds + to_))[hw_]; wv_ = __builtin_amdgcn_readfirstlane(wv_); tid_ = wv_ * 64 + ln_; }
    asm volatile("" : "+v"(tid_));
    const int tid = tid_, wid = __builtin_amdgcn_readfirstlane(tid >> 6), lane = tid & 63, wr = wid >> 2, wc = wid & 3, fr = lane & 15, fq = lane >> 4;
    const int K = g.K, nt = K / BK;
    unsigned voffA[2], voffB[2];
#pragma unroll
    for (int i = 0; i < 2; ++i) { int R, C; stage_rc(tid * 16 + i * 8192, R, C); const int Rb = Epi::PERM ? ((R & ~31) + perm32(R & 31)) : R;
        voffA[i] = (unsigned)(R * g.lda + C) * 2u; voffB[i] = (unsigned)(Rb * g.ldb + C) * 2u; }
    const size_t kstepA = (size_t)g.a_kstep, hstepA = (size_t)g.a_hstep, tstepA = (size_t)g.a_tstep;
    const size_t kstepB = (size_t)g.b_kstep, hstepB = (size_t)g.b_hstep, tstepB = (size_t)g.b_tstep;
    const unsigned ldsw = (unsigned)wid * 1024u;
    const int aoff = lds_byte(wr * 64 + fr, fq * 8), boff = lds_byte(wc * 32 + fr, fq * 8);
#define PG8_SA(b, h) (((b) * 2 + (h)) * HTB)
#define PG8_SB(b, h) ((4 + (b) * 2 + (h)) * HTB)
#define PG8_STAGE(bufoff, gbase, voff) do { _Pragma("unroll") for (int _i = 0; _i < 2; ++_i) \
        __builtin_amdgcn_global_load_lds((const unsigned*)((const char*)(gbase) + (voff)[_i]), (PG8_LAS unsigned*)(lds + (bufoff) + ldsw + _i * 8192), 16, 0, 0); } while (0)
#define PG8_LDA(dst, b, h) do { _Pragma("unroll") for (int m = 0; m < 4; ++m) _Pragma("unroll") for (int k = 0; k < 2; ++k) dst[m][k] = *(const PG8_LAS bf16x8*)(lds + PG8_SA(b, h) + aoff + m * 2048 + k * 1024); } while (0)
#define PG8_LDB(dst, b, h) do { _Pragma("unroll") for (int n = 0; n < 2; ++n) _Pragma("unroll") for (int k = 0; k < 2; ++k) dst[n][k] = *(const PG8_LAS bf16x8*)(lds + PG8_SB(b, h) + boff + n * 2048 + k * 1024); } while (0)
#define PG8_MMA(ai, bj, At, Bt) do { __builtin_amdgcn_s_setprio(1); _Pragma("unroll") for (int m = 0; m < 4; ++m) _Pragma("unroll") for (int n = 0; n < 2; ++n) _Pragma("unroll") for (int k = 0; k < 2; ++k) \
        acc[ai][bj][m][n] = __builtin_amdgcn_mfma_f32_16x16x32_bf16(Bt[n][k], At[m][k], acc[ai][bj][m][n], 0, 0, 0); __builtin_amdgcn_s_setprio(0); } while (0)
#define PG8_WAIT_V(n) asm volatile("s_waitcnt vmcnt(" #n ")" ::: "memory")
#define PG8_WAIT_L(n) asm volatile("s_waitcnt lgkmcnt(" #n ")" ::: "memory")
#define PG8_BAR __builtin_amdgcn_s_barrier()
#define PG8_SCHED __builtin_amdgcn_sched_barrier(0)
    Unit cur, nxt; int ui = 0;
    if (!S.next(0, cur)) return;
    f32x4 acc[2][2][4][2];
#pragma unroll
    for (int a = 0; a < 2; ++a)
#pragma unroll
        for (int b = 0; b < 2; ++b)
#pragma unroll
            for (int m = 0; m < 4; ++m)
#pragma unroll
                for (int n = 0; n < 2; ++n) acc[a][b][m][n] = (f32x4){0.f, 0.f, 0.f, 0.f};
    bf16x8 At[4][2], B0[2][2], B1[2][2];
    const char* cA = (const char*)g.A + (size_t)cur.pm * tstepA; const char* cB = (const char*)g.Bt + (size_t)cur.pn * tstepB;
    PG8_STAGE(PG8_SB(0, 0), cB, voffB); PG8_STAGE(PG8_SB(0, 1), cB + hstepB, voffB); PG8_STAGE(PG8_SA(0, 0), cA, voffA); PG8_STAGE(PG8_SA(0, 1), cA + hstepA, voffA);
    if (wr == 1) PG8_BAR;
    PG8_WAIT_V(2); PG8_BAR;
    PG8_STAGE(PG8_SB(1, 0), cB + kstepB, voffB); PG8_STAGE(PG8_SA(1, 0), cA + kstepA, voffA); PG8_STAGE(PG8_SB(1, 1), cB + hstepB + kstepB, voffB);
    PG8_WAIT_V(6); PG8_BAR;
    for (;;) {
        const bool has_next = S.next(ui + 1, nxt);
        const char* nA = has_next ? (const char*)g.A + (size_t)nxt.pm * tstepA : cA; const char* nB = has_next ? (const char*)g.Bt + (size_t)nxt.pn * tstepB : cB;
        for (int t = 0; t < nt; t += 2) {
            const bool last = (t == nt - 2);
            const char* a1 = cA + (size_t)(t + 1) * kstepA;
            const char* a2 = last ? nA : cA + (size_t)(t + 2) * kstepA; const char* b2 = last ? nB : cB + (size_t)(t + 2) * kstepB;
            const char* a3 = a2 + kstepA; const char* b3 = b2 + kstepB;
            PG8_LDB(B0, 0, 0); PG8_LDB(B1, 0, 1); PG8_SCHED; PG8_LDA(At, 0, 0); PG8_STAGE(PG8_SA(1, 1), a1 + hstepA, voffA);
            PG8_WAIT_V(8); PG8_WAIT_L(0); PG8_BAR; PG8_MMA(0, 0, At, B0); PG8_MMA(0, 1, At, B1); PG8_BAR; PG8_SCHED;
            PG8_LDA(At, 0, 1); PG8_STAGE(PG8_SB(0, 0), b2, voffB); PG8_STAGE(PG8_SB(0, 1), b2 + hstepB, voffB); PG8_STAGE(PG8_SA(0, 0), a2, voffA);
            PG8_WAIT_V(8); PG8_WAIT_L(0); PG8_BAR; PG8_MMA(1, 0, At, B0); PG8_MMA(1, 1, At, B1); PG8_BAR; PG8_SCHED;
            PG8_LDB(B0, 1, 0); PG8_LDB(B1, 1, 1); PG8_SCHED; PG8_LDA(At, 1, 0); PG8_STAGE(PG8_SA(0, 1), a2 + hstepA, voffA);
            PG8_WAIT_V(8); PG8_WAIT_L(0); PG8_BAR; PG8_MMA(0, 0, At, B0); PG8_MMA(0, 1, At, B1); PG8_BAR; PG8_SCHED;
            PG8_LDA(At, 1, 1); PG8_STAGE(PG8_SB(1, 0), b3, voffB); PG8_STAGE(PG8_SB(1, 1), b3 + hstepB, voffB); PG8_STAGE(PG8_SA(1, 0), a3, voffA);
            PG8_WAIT_V(8); PG8_WAIT_L(0); PG8_BAR; PG8_MMA(1, 0, At, B0); PG8_MMA(1, 1, At, B1); PG8_BAR; PG8_SCHED;
        }
        if constexpr (ALIGN_EPI) { if (wr == 0) PG8_BAR; }
        if constexpr (!Epi::AFTER_DRAIN) { E(acc, cur, ui, wr, wc, fr, fq); }
        if (!has_next) break;
#pragma unroll
        for (int a = 0; a < 2; ++a)
#pragma unroll
            for (int b = 0; b < 2; ++b)
#pragma unroll
                for (int m = 0; m < 4; ++m)
#pragma unroll
                    for (int n = 0; n < 2; ++n) acc[a][b][m][n] = (f32x4){0.f, 0.f, 0.f, 0.f};
        cur = nxt; cA = nA; cB = nB; ++ui;
        if constexpr (ALIGN_EPI) { if (wr == 1) PG8_BAR; }
    }
    PG8_WAIT_V(0);
    if constexpr (!ALIGN_EPI) { if (wr == 0) PG8_BAR; }
    PG8_BAR;
    if constexpr (Epi::AFTER_DRAIN) { E.fused(acc, cur, wr, wc, fr, fq, lds, wid, lane); }
#undef PG8_SA
#undef PG8_SB
#undef PG8_STAGE
#undef PG8_LDA
#undef PG8_LDB
#undef PG8_MMA
#undef PG8_WAIT_V
#undef PG8_WAIT_L
#undef PG8_BAR
#undef PG8_SCHED
}
}

#define XB_TMO      128
#define XB_XCNT(j)  (256  + 64 * (j))
#define XB_XSUB(j)  (1280 + 64 * (j))
#define XB_XGEN(j)  (2304 + 64 * (j))
#define XB_TOP      3328
#define XB_TOPGEN   3392
#define XCD_BAR_WORDS 3456
#define XB_SPIN_CAP (1u << 20)
__device__ __forceinline__ unsigned xb_ld(unsigned* p)              { return __hip_atomic_load(p, __ATOMIC_RELAXED, __HIP_MEMORY_SCOPE_AGENT); }
__device__ __forceinline__ unsigned xb_add(unsigned* p, unsigned v) { return __hip_atomic_fetch_add(p, v, __ATOMIC_RELAXED, __HIP_MEMORY_SCOPE_AGENT); }
__device__ __forceinline__ unsigned xb_xcc_id() { return (unsigned)__builtin_amdgcn_s_getreg((3 << 11) | 20) & 0xFu; }
#define XB_SPIN(cond, bar) do { unsigned _sp = 0; while (cond) { __builtin_amdgcn_s_sleep(1); \
    if ((++_sp & 255u) == 0u) { if (xb_ld(&(bar)[XB_TMO])) break; if (_sp > XB_SPIN_CAP) { atomicAdd(&(bar)[XB_TMO], 1u); break; } } } } while (0)
__device__ __forceinline__ void xcd_barrier_complete(unsigned* bar, unsigned x, unsigned G, unsigned& nloc, unsigned& nx) {
    unsigned sum, cnt, mine, sp = 0u;
    for (;;) {
        sum = 0u; cnt = 0u; mine = 0u;
#pragma unroll
        for (unsigned j = 0; j < 16; ++j) { const unsigned c = xb_ld(&bar[XB_XCNT(j)]); sum += c; cnt += (c > 0u) ? 1u : 0u; mine = (j == x) ? c : mine; }
        if (sum == G) break;
        __builtin_amdgcn_s_sleep(1);
        if ((++sp & 255u) == 0u) { if (xb_ld(&bar[XB_TMO])) break; if (sp > XB_SPIN_CAP) { atomicAdd(&bar[XB_TMO], 1u); break; } }
    }
    nloc = mine > 0u ? mine : 1u; nx = cnt > 0u ? cnt : 1u;
}
__device__ __forceinline__ void xcd_barrier(unsigned* bar, volatile LAS unsigned* st, bool leader_thread, unsigned G) {
    asm volatile("s_waitcnt vmcnt(0)" ::: "memory");
    __syncthreads();
    if (leader_thread) {
        const unsigned x = xb_xcc_id();
        __builtin_amdgcn_s_waitcnt(0);
        unsigned nloc = st[0], nx = st[1];
        if (nloc == 0u) { xcd_barrier_complete(bar, x, G, nloc, nx); st[0] = nloc; st[1] = nx; }
        const unsigned old = xb_add(&bar[XB_XSUB(x)], 1u);
        const unsigned gen = old / nloc;
        if (old + 1u == (gen + 1u) * nloc) {
            __builtin_amdgcn_fence(__ATOMIC_RELEASE, "agent");
            asm volatile("s_waitcnt vmcnt(0)" ::: "memory");
            const unsigned og = xb_add(&bar[XB_TOP], 1u);
            const unsigned tg = og / nx;
            if (og + 1u == (tg + 1u) * nx) xb_add(&bar[XB_TOPGEN], 1u);
            else XB_SPIN(xb_ld(&bar[XB_TOPGEN]) == tg, bar);
            __builtin_amdgcn_fence(__ATOMIC_ACQUIRE, "agent");
            xb_add(&bar[XB_XGEN(x)], 1u);
            asm volatile("s_waitcnt vmcnt(0)" ::: "memory");
        } else {
            XB_SPIN(xb_ld(&bar[XB_XGEN(x)]) == gen, bar);
            __builtin_amdgcn_fence(__ATOMIC_ACQUIRE, "agent");
            asm volatile("s_waitcnt vmcnt(0)" ::: "memory");
        }
    }
    __syncthreads();
}

struct Args {
    const float* x; const float* p; const float* w_in; const float* w_out; const float* cmp_pos; const float* cmp_w1; const float* cmp_w2; const float* hg_lb;
    const float* g_pre_mix; const float* g_post_mix; const float* g_pre_mlp; const float* g_post_mlp; const float* w_up; const float* w_down; const float* g_ple;
    const float* w_ple_gate; const float* w_ple_proj;
    float* out; unsigned char* ws; int ph_lo, ph_hi;
};

struct Frame {
    LAS unsigned char* lds;
    int tid, lane, wave, G, bid;
    unsigned char* ws;
};

template <class T> __device__ __forceinline__ T* uptr(T* p) {
    const unsigned long long v = (unsigned long long)p; const unsigned lo = __builtin_amdgcn_readfirstlane((unsigned)v), hi = __builtin_amdgcn_readfirstlane((unsigned)(v >> 32));
    return (T*)(__attribute__((address_space(1))) T*)(((unsigned long long)hi << 32) | lo);
}
__device__ __forceinline__ Frame make_frame(LAS unsigned char* lds, Args& A) {
    Frame G; G.lds = lds;
    int lane; asm volatile("v_mbcnt_lo_u32_b32 %0, -1, 0\n\tv_mbcnt_hi_u32_b32 %0, -1, %0" : "=v"(lane));
    const unsigned hw = (unsigned)__builtin_amdgcn_s_getreg((5 << 11) | 4) & 63u;
    unsigned aoff = LDS_ARGS; asm volatile("" : "+v"(aoff));
    int wave = (int)((const LAS unsigned*)(lds + aoff + (LDS_WTAB - LDS_ARGS)))[hw];
    wave = __builtin_amdgcn_readfirstlane(wave);
    asm volatile("" : "+s"(wave));
    G.lane = lane; G.wave = wave; G.tid = wave * 64 + lane;
    int bid = blockIdx.x, gg = gridDim.x; asm volatile("" : "+s"(bid), "+s"(gg));
    G.bid = bid; G.G = gg;
    const LAS Args* la = (const LAS Args*)(lds + aoff);
    A.x = uptr(la->x); A.p = uptr(la->p); A.w_in = uptr(la->w_in); A.w_out = uptr(la->w_out); A.cmp_pos = uptr(la->cmp_pos); A.cmp_w1 = uptr(la->cmp_w1); A.cmp_w2 = uptr(la->cmp_w2);
    A.hg_lb = uptr(la->hg_lb); A.g_pre_mix = uptr(la->g_pre_mix); A.g_post_mix = uptr(la->g_post_mix); A.g_pre_mlp = uptr(la->g_pre_mlp); A.g_post_mlp = uptr(la->g_post_mlp);
    A.w_up = uptr(la->w_up); A.w_down = uptr(la->w_down); A.g_ple = uptr(la->g_ple); A.w_ple_gate = uptr(la->w_ple_gate); A.w_ple_proj = uptr(la->w_ple_proj);
    A.out = uptr(la->out); A.ws = uptr(la->ws); A.ph_lo = 0; A.ph_hi = 0;
    G.ws = A.ws;
    return G;
}
template <class Sched> __device__ __forceinline__ void fill_rstd(const Frame& F, const float* ss, const Sched& S) {
    LAS float* tab = (LAS float*)(F.lds + LDS_RSTD);
    const int half = F.tid >> 8, r = F.tid & 255;
#pragma unroll 1
    for (int i0 = 0; i0 < 8; i0 += 2) {
        pg8::Unit u; if (!S.next(i0 + half, u)) continue;
        tab[(i0 + half) * 256 + r] = pg8::row_rstd16(ss, (long)u.pm * 256 + r);
    }
    __syncthreads();
}
__device__ __forceinline__ void transpose_item(const float* W, int ldw, int col0, int k0, bf16_t* WT, int ldk, int drow0, const float* gsc, int lane) {
    float v[64];
    const float* src = W + (size_t)k0 * ldw + col0 + lane;
#pragma unroll
    for (int k = 0; k < 64; ++k) v[k] = src[(size_t)k * ldw];
    if (gsc) {
#pragma unroll
        for (int k = 0; k < 64; ++k) v[k] *= gsc[k0 + k];
    }
    bf16_t* dst = WT + ((size_t)(k0 >> 6) * ldk + (size_t)(drow0 + lane)) * 64;
#pragma unroll
    for (int c = 0; c < 8; ++c) { u32x4 o; o.x = pk2(v[8 * c], v[8 * c + 1]); o.y = pk2(v[8 * c + 2], v[8 * c + 3]); o.z = pk2(v[8 * c + 4], v[8 * c + 5]); o.w = pk2(v[8 * c + 6], v[8 * c + 7]); *(u32x4*)(dst + 8 * c) = o; }
}

__device__ __forceinline__ void phase_prologue(const Frame& F, const Args& a) {
    const int gw = F.bid * 8 + F.wave, NGW = F.G * 8;
    {
        constexpr int I_IN1 = 16 * 18, I_IN2 = 16 * 34, I_OUT = 16 * 16, I_UP = 16 * 64, I_DN = 64 * 16, I_G = 16 * 16, I_PJ = 4 * 16, I_C1 = 32 * 4;
        constexpr int I_LAYER = I_IN1 + I_IN2 + I_OUT + I_UP + I_DN + I_G + I_PJ + 2 * I_C1;
        for (int it = gw; it < DEPTH * I_LAYER; it += NGW) {
            const int l = it / I_LAYER; int r = it % I_LAYER;
            const float* W; int ldw, col0, K, NR; bf16_t* WT; int drow0; const float* gsc = nullptr;
            if (r < I_IN1) { W = a.w_in + (size_t)l * DM * IN_TOTAL; ldw = IN_TOTAL; col0 = 0; K = DM; NR = NPROJ; WT = (bf16_t*)(F.ws + WS_WIN) + (size_t)l * NPROJ * DM; drow0 = 0; gsc = a.g_pre_mix + l * DM; }
            else if ((r -= I_IN1) < I_IN2) { W = a.w_in + (size_t)l * DM * IN_TOTAL; ldw = IN_TOTAL; col0 = 1170; K = DM; NR = NPROJ; WT = (bf16_t*)(F.ws + WS_WIN) + (size_t)l * NPROJ * DM; drow0 = 1152; gsc = a.g_pre_mix + l * DM; }
            else if ((r -= I_IN2) < I_OUT) { W = a.w_out + (size_t)l * DM * DM; ldw = DM; col0 = 0; K = DM; NR = DM; WT = (bf16_t*)(F.ws + WS_WOUT) + (size_t)l * DM * DM; drow0 = 0; }
            else if ((r -= I_OUT) < I_UP) { W = a.w_up + (size_t)l * DM * FF; ldw = FF; col0 = 0; K = DM; NR = FF; WT = (bf16_t*)(F.ws + WS_WUP) + (size_t)l * FF * DM; drow0 = 0; gsc = a.g_pre_mlp + l * DM; }
            else if ((r -= I_UP) < I_DN) { W = a.w_down + (size_t)l * FF * DM; ldw = DM; col0 = 0; K = FF; NR = DM; WT = (bf16_t*)(F.ws + WS_WDN) + (size_t)l * DM * FF; drow0 = 0; }
            else if ((r -= I_DN) < I_G) { W = a.w_ple_gate + (size_t)l * DM * DM; ldw = DM; col0 = 0; K = DM; NR = DM; WT = (bf16_t*)(F.ws + WS_WG) + (size_t)l * DM * DM; drow0 = 0; gsc = a.g_ple + l * DM; }
            else if ((r -= I_G) < I_PJ) { W = a.w_ple_proj + (size_t)l * PLE * DM; ldw = DM; col0 = 0; K = PLE; NR = DM; WT = (bf16_t*)(F.ws + WS_WPJ) + (size_t)l * DM * PLE; drow0 = 0; }
            else { r -= I_PJ; const int kv = r / I_C1; r -= kv * I_C1; W = a.cmp_w1 + (size_t)(l * 2 + kv) * 2048 * 256; ldw = 256; col0 = 0; K = 2048; NR = 256; WT = (bf16_t*)(F.ws + WS_W1T) + (size_t)(l * 2 + kv) * 256 * 2048; drow0 = 0; }
            const int nk = K / 64, nb = r / nk, kb = r % nk;
            transpose_item(W, ldw, col0 + 64 * nb, 64 * kb, WT, NR, drow0 + 64 * nb, gsc, F.lane);
        }
    }
    for (int l = 0; l < DEPTH; ++l) {
        bf16_t* WIN = (bf16_t*)(F.ws + WS_WIN) + (size_t)l * NPROJ * DM;
        const float* win = a.w_in + (size_t)l * DM * IN_TOTAL; const float* gs = a.g_pre_mix + l * DM;
        for (int idx = F.bid * 512 + F.tid; idx < 256 * DM; idx += F.G * 512) {
            const int r = idx >> 10, k = idx & 1023;
            float v = 0.f; if (r < 18) v = win[(size_t)k * IN_TOTAL + 1152 + r] * gs[k];
            WIN[((size_t)(k >> 6) * NPROJ + 3328 + r) * 64 + (k & 63)] = (bf16_t)f2bf(v);
        }
    }
    {
        bf16_t* HBB = (bf16_t*)a.out; float* SSB = (float*)(F.ws + WS_SSB);
        for (int m = gw * 2; m < MTOK; m += NGW * 2) {
            const f32x4* xr = (const f32x4*)(a.x + (size_t)m * DM) + F.lane;
            f32x4 v[8]; float s0 = 0.f, s1 = 0.f;
#pragma unroll
            for (int j = 0; j < 8; ++j) v[j] = xr[64 * j];
#pragma unroll
            for (int j = 0; j < 4; ++j) { s0 += (v[j].x * v[j].x + v[j].y * v[j].y) + (v[j].z * v[j].z + v[j].w * v[j].w); s1 += (v[j + 4].x * v[j + 4].x + v[j + 4].y * v[j + 4].y) + (v[j + 4].z * v[j + 4].z + v[j + 4].w * v[j + 4].w); }
            s0 = wave_sum(s0); s1 = wave_sum(s1);
            unsigned long long* o8 = (unsigned long long*)(HBB + (size_t)m * DM) + F.lane;
#pragma unroll
            for (int j = 0; j < 8; ++j) o8[64 * j] = (unsigned long long)pk2(v[j].x, v[j].y) | ((unsigned long long)pk2(v[j].z, v[j].w) << 32);
            if (F.lane < 32) SSB[(size_t)m * 16 + F.lane] = (F.lane == 0) ? s0 : ((F.lane == 16) ? s1 : 0.f);
        }
    }
    {
        float* part = (float*)(F.ws + WS_B1P);
        for (int it = gw; it < 4 * 16 * 4; it += NGW) {
            const int jb = it & 3, c = (it >> 2) & 15, lk = it >> 6;
            const float* pos = a.cmp_pos + (size_t)lk * 2048; const float* w1 = a.cmp_w1 + (size_t)lk * 2048 * 256;
            const int j = jb * 64 + F.lane; float s = 0.f;
#pragma unroll 32
            for (int k = c * 128; k < c * 128 + 128; ++k) s += pos[k] * w1[(size_t)k * 256 + j];
            part[(size_t)(lk * 16 + c) * 256 + j] = s;
        }
    }
}

__device__ __forceinline__ void reduce_bias1(const Frame& F) {
    if (F.bid != 0) return;
    const float* part = (const float*)(F.ws + WS_B1P); float* fin = (float*)(F.ws + WS_B1P + 65536);
    for (int idx = F.tid; idx < 4 * 256; idx += 512) { const int lk = idx >> 8, j = idx & 255; float s = 0.f;
        for (int c = 0; c < 16; ++c) s += part[(size_t)(lk * 16 + c) * 256 + j];
        fin[idx] = s; }
}

__device__ __forceinline__ void convert_p(const Frame& F, const Args& a, int l) {
    const float* src = a.p + (size_t)l * MTOK * PLE; bf16_t* PB = (bf16_t*)(F.ws + WS_PB);
    const size_t n8 = (size_t)MTOK * PLE / 8;
    for (size_t i = (size_t)F.bid * 512 + F.tid; i < n8; i += (size_t)F.G * 512) {
        const f32x4 v0 = *(const f32x4*)(src + i * 8), v1 = *(const f32x4*)(src + i * 8 + 4);
        u32x4 w; w.x = pk2(v0.x, v0.y); w.y = pk2(v0.z, v0.w); w.z = pk2(v1.x, v1.y); w.w = pk2(v1.z, v1.w);
        *(u32x4*)(PB + i * 8) = w;
    }
}

__device__ __forceinline__ void load64(const bf16_t* p, float (&v)[64], float sc) {
    const u32x4* p4 = (const u32x4*)p;
#pragma unroll
    for (int i = 0; i < 8; ++i) { const u32x4 w = p4[i];
        v[8 * i + 0] = bf_lo(w.x) * sc; v[8 * i + 1] = bf_hi(w.x) * sc; v[8 * i + 2] = bf_lo(w.y) * sc; v[8 * i + 3] = bf_hi(w.y) * sc;
        v[8 * i + 4] = bf_lo(w.z) * sc; v[8 * i + 5] = bf_hi(w.z) * sc; v[8 * i + 6] = bf_lo(w.w) * sc; v[8 * i + 7] = bf_hi(w.w) * sc; }
}
__device__ __forceinline__ void stage_bf16(LAS float* dst, const bf16_t* src, int ld, int tid) {
    const int r = tid >> 3, c = tid & 7;
    const u32x4 w = *(const u32x4*)(src + (size_t)r * ld + c * 8);
    const f32x4 v0 = {bf_lo(w.x), bf_hi(w.x), bf_lo(w.y), bf_hi(w.y)}, v1 = {bf_lo(w.z), bf_hi(w.z), bf_lo(w.w), bf_hi(w.w)};
    *(LAS f32x4*)(dst + r * 64 + c * 8) = v0; *(LAS f32x4*)(dst + r * 64 + c * 8 + 4) = v1;
}
__device__ __forceinline__ void stage_f32(LAS float* dst, const float* src, int tid) {
    const int r = tid >> 3, c = tid & 7;
    const f32x4 v0 = *(const f32x4*)(src + r * 64 + c * 8), v1 = *(const f32x4*)(src + r * 64 + c * 8 + 4);
    *(LAS f32x4*)(dst + r * 64 + c * 8) = v0; *(LAS f32x4*)(dst + r * 64 + c * 8 + 4) = v1;
}
__device__ __forceinline__ float dot64(const LAS float* kr, const float (&q)[64]) {
    float s0 = 0.f, s1 = 0.f, s2 = 0.f, s3 = 0.f;
#pragma unroll
    for (int d = 0; d < 64; d += 4) { const f32x4 kv = *(const LAS f32x4*)(kr + d); s0 += q[d] * kv.x; s1 += q[d + 1] * kv.y; s2 += q[d + 2] * kv.z; s3 += q[d + 3] * kv.w; }
    return (s0 + s1) + (s2 + s3);
}
template <class FN>
__device__ __forceinline__ void attend64(const LAS float* Kt, const LAS float* Vt, const float (&q)[64], float (&o)[64], float& m, float& l, FN fn) {
#pragma unroll 1
    for (int j = 0; j < 64; ++j) {
        float bias; if (!fn(j, bias)) continue;
        const float s = dot64(Kt + j * 64, q) + bias;
        if (s > m) { const float c = __expf(m - s); l *= c;
#pragma unroll
            for (int d = 0; d < 64; ++d) o[d] *= c;
            m = s; }
        const float pr = __expf(s - m); l += pr;
#pragma unroll
        for (int d = 0; d < 64; d += 4) { const f32x4 vv = *(const LAS f32x4*)(Vt + j * 64 + d); o[d] += pr * vv.x; o[d + 1] += pr * vv.y; o[d + 2] += pr * vv.z; o[d + 3] += pr * vv.w; }
    }
}
__device__ __forceinline__ float nsa_slope(int h) {
    const int idx = (h >> 1) * 4 + 2 + (h & 1);
    return exp2f(-2.0f * (float)(idx + 1) / 3.0f);
}
__device__ __forceinline__ float dil_slope(int h) {
    const int idx = (h >> 1) * 4 + (h & 1);
    return exp2f(-2.0f * (float)(idx + 1) / 3.0f);
}

namespace att {
typedef short bf16x8 __attribute__((ext_vector_type(8)));
typedef short v4i16 __attribute__((ext_vector_type(4)));
typedef __bf16 bf16x2_t __attribute__((ext_vector_type(2)));
constexpr float NEG = -1e30f, MFLOOR = -1e20f, LOG2E = 1.4426950408889634f, LN2 = 0.6931471805599453f;
constexpr int TILE_BYTES = 8192;
__device__ __forceinline__ int k_off(int row, int ch) { return row * 128 + ((ch ^ ((row >> 1) & 7)) << 4); }
__device__ __forceinline__ int v_off(int row, int byte) { return row * 128 + (byte ^ (((row >> 1) & 3) << 5)); }
__device__ __forceinline__ unsigned cvtpk(float lo, float hi) { f32x2 v = {lo, hi}; bf16x2_t b = __builtin_convertvector(v, bf16x2_t); return __builtin_bit_cast(unsigned, b); }

template <int NH> struct State { f32x4 O[NH][4]; float m[NH], l[NH]; };
template <int NH> __device__ __forceinline__ void state_reset(State<NH>& st, float m0 = MFLOOR) {
#pragma unroll
    for (int g = 0; g < NH; ++g) { st.m[g] = m0; st.l[g] = 0.f;
#pragma unroll
        for (int nt = 0; nt < 4; ++nt) st.O[g][nt] = (f32x4){0.f, 0.f, 0.f, 0.f}; }
}
struct Lane { int c, grp; int kb0, kb1; int vb[4]; };
__device__ __forceinline__ Lane make_lane(int lane) {
    Lane L; L.c = lane & 15; L.grp = lane >> 4;
    L.kb0 = k_off(L.c, L.grp); L.kb1 = k_off(L.c, 4 + L.grp);
    const int i = L.c, sw = ((L.grp & 1) << 1) | (i >> 3);
#pragma unroll
    for (int nt = 0; nt < 4; ++nt) L.vb[nt] = (4 * L.grp + (i >> 2)) * 128 + ((32 * nt + 8 * (i & 3)) ^ (sw << 5));
    return L;
}
struct StageRegs { u32x4 k, v; };
__device__ __forceinline__ void stage_load(StageRegs& r, const bf16_t* srcK, const bf16_t* srcV, long ld, int tid) {
    const int R = tid >> 3, ch = tid & 7;
    r.k = *(const u32x4*)(srcK + (size_t)R * ld + ch * 8); r.v = *(const u32x4*)(srcV + (size_t)R * ld + ch * 8);
}
__device__ __forceinline__ void stage_store(const StageRegs& r, LAS unsigned char* Kt, LAS unsigned char* Vt, int tid) {
    const int R = tid >> 3, ch = tid & 7;
    *(LAS u32x4*)(Kt + k_off(R, ch)) = r.k; *(LAS u32x4*)(Vt + v_off(R, ch * 16)) = r.v;
}
template <int NH> __device__ __forceinline__ void scores(const LAS unsigned char* Kt, const Lane& L, const bf16x8 (&qf)[NH][2], const float (&slope)[NH], float brel, f32x4 (&S)[NH][4]) {
#pragma unroll
    for (int g = 0; g < NH; ++g) { const float sb = slope[g] * brel;
#pragma unroll
        for (int kt = 0; kt < 4; ++kt)
#pragma unroll
            for (int r = 0; r < 4; ++r) S[g][kt][r] = __builtin_fmaf(slope[g], (float)(16 * kt + r), sb); }
#pragma unroll
    for (int kt = 0; kt < 4; ++kt) {
        const bf16x8 k0 = *(const LAS bf16x8*)(Kt + L.kb0 + kt * 2048), k1 = *(const LAS bf16x8*)(Kt + L.kb1 + kt * 2048);
#pragma unroll
        for (int g = 0; g < NH; ++g) {
            S[g][kt] = __builtin_amdgcn_mfma_f32_16x16x32_bf16(k0, qf[g][0], S[g][kt], 0, 0, 0);
            S[g][kt] = __builtin_amdgcn_mfma_f32_16x16x32_bf16(k1, qf[g][1], S[g][kt], 0, 0, 0);
        }
    }
}
template <int NH> __device__ __forceinline__ void scores_lds(const LAS unsigned char* Kt, const Lane& L, const LAS unsigned char* qlds, int lane, const float (&slope)[NH], float brel, f32x4 (&S)[NH][4]) {
    bf16x8 kf[4][2];
#pragma unroll
    for (int kt = 0; kt < 4; ++kt) { kf[kt][0] = *(const LAS bf16x8*)(Kt + L.kb0 + kt * 2048); kf[kt][1] = *(const LAS bf16x8*)(Kt + L.kb1 + kt * 2048); }
#pragma unroll
    for (int g = 0; g < NH; ++g) {
        const bf16x8 q0 = *(const LAS bf16x8*)(qlds + ((g * 2 + 0) * 64 + lane) * 16), q1 = *(const LAS bf16x8*)(qlds + ((g * 2 + 1) * 64 + lane) * 16);
        const float sb = slope[g] * brel;
#pragma unroll
        for (int kt = 0; kt < 4; ++kt) {
#pragma unroll
            for (int r = 0; r < 4; ++r) S[g][kt][r] = __builtin_fmaf(slope[g], (float)(16 * kt + r), sb);
            S[g][kt] = __builtin_amdgcn_mfma_f32_16x16x32_bf16(kf[kt][0], q0, S[g][kt], 0, 0, 0);
            S[g][kt] = __builtin_amdgcn_mfma_f32_16x16x32_bf16(kf[kt][1], q1, S[g][kt], 0, 0, 0);
        }
    }
}
template <int NH> __device__ __forceinline__ void mask(f32x4 (&S)[NH][4], int drel, int dlo, bool row_on) {
#pragma unroll
    for (int kt = 0; kt < 4; ++kt)
#pragma unroll
        for (int r = 0; r < 4; ++r) { const int dl = drel + 16 * kt + r; const bool ok = row_on && dl <= 0 && dl >= dlo;
#pragma unroll
            for (int g = 0; g < NH; ++g) S[g][kt][r] = ok ? S[g][kt][r] : NEG; }
}
template <int NH> __device__ __forceinline__ void online(f32x4 (&S)[NH][4], State<NH>& st) {
#pragma unroll
    for (int g = 0; g < NH; ++g) {
        float mx = fmaxf(fmaxf(S[g][0][0], S[g][0][1]), fmaxf(S[g][0][2], S[g][0][3]));
#pragma unroll
        for (int kt = 1; kt < 4; ++kt) mx = fmaxf(mx, fmaxf(fmaxf(S[g][kt][0], S[g][kt][1]), fmaxf(S[g][kt][2], S[g][kt][3])));
        mx = fmaxf(mx, x16f(mx)); mx = fmaxf(mx, x32f(mx));
        const float mnew = fmaxf(st.m[g], mx);
        const float alpha = __builtin_amdgcn_exp2f(st.m[g] - mnew);
        st.m[g] = mnew; st.l[g] *= alpha;
#pragma unroll
        for (int nt = 0; nt < 4; ++nt) st.O[g][nt] = st.O[g][nt] * alpha;
        float ls = 0.f;
#pragma unroll
        for (int kt = 0; kt < 4; ++kt)
#pragma unroll
            for (int r = 0; r < 4; ++r) { const float pr = __builtin_amdgcn_exp2f(S[g][kt][r] - mnew); S[g][kt][r] = pr; ls += pr; }
        st.l[g] += ls;
    }
}
template <int NH> __device__ __forceinline__ void pv(const LAS unsigned char* Vt, const Lane& L, const f32x4 (&P)[NH][4], State<NH>& st) {
#pragma unroll
    for (int s2 = 0; s2 < 2; ++s2) {
        bf16x8 pf[NH];
#pragma unroll
        for (int g = 0; g < NH; ++g) { u32x4 w; w.x = cvtpk(P[g][2 * s2][0], P[g][2 * s2][1]); w.y = cvtpk(P[g][2 * s2][2], P[g][2 * s2][3]);
            w.z = cvtpk(P[g][2 * s2 + 1][0], P[g][2 * s2 + 1][1]); w.w = cvtpk(P[g][2 * s2 + 1][2], P[g][2 * s2 + 1][3]); pf[g] = __builtin_bit_cast(bf16x8, w); }
#pragma unroll
        for (int nt = 0; nt < 4; ++nt) {
            const v4i16 lo = __builtin_amdgcn_ds_read_tr16_b64_v4i16((LAS v4i16*)(Vt + L.vb[nt] + 4096 * s2));
            const v4i16 hi = __builtin_amdgcn_ds_read_tr16_b64_v4i16((LAS v4i16*)(Vt + L.vb[nt] + 4096 * s2 + 2048));
            const bf16x8 vf = {lo[0], lo[1], lo[2], lo[3], hi[0], hi[1], hi[2], hi[3]};
#pragma unroll
            for (int g = 0; g < NH; ++g) st.O[g][nt] = __builtin_amdgcn_mfma_f32_16x16x32_bf16(vf, pf[g], st.O[g][nt], 0, 0, 0);
        }
    }
}
constexpr float BIGD = 1e30f, RTHR = 8.0f;
template <int NH, int MODE> __device__ __forceinline__ void tile_qk(const LAS unsigned char* Kt, const Lane& L, const LAS unsigned char* qlds, int lane,
        const float (&slope)[NH], float brel, int drel, int dlo, bool row_on, bool need_mask, const State<NH>& st, f32x4 (&S)[NH][4]) {
    {
        f32x4 dm[4];
#pragma unroll
        for (int kt = 0; kt < 4; ++kt)
#pragma unroll
            for (int r = 0; r < 4; ++r) dm[kt][r] = brel + (float)(16 * kt + r);
        if (need_mask) {
#pragma unroll
            for (int kt = 0; kt < 4; ++kt)
#pragma unroll
                for (int r = 0; r < 4; ++r) { const int dl = drel + 16 * kt + r; dm[kt][r] = (row_on && dl <= 0 && dl >= dlo) ? dm[kt][r] : -BIGD; }
        }
        bf16x8 kf[4][2];
#pragma unroll
        for (int kt = 0; kt < 4; ++kt) { kf[kt][0] = *(const LAS bf16x8*)(Kt + L.kb0 + kt * 2048); kf[kt][1] = *(const LAS bf16x8*)(Kt + L.kb1 + kt * 2048); }
        __builtin_amdgcn_s_setprio(1);
#pragma unroll
        for (int g = 0; g < NH; ++g) {
            const bf16x8 q0 = *(const LAS bf16x8*)(qlds + ((g * 2 + 0) * 64 + lane) * 16), q1 = *(const LAS bf16x8*)(qlds + ((g * 2 + 1) * 64 + lane) * 16);
            float mref = st.m[g]; asm volatile("" : "+v"(mref));
#pragma unroll
            for (int kt = 0; kt < 4; ++kt) {
                S[g][kt] = (MODE == 0) ? dm[kt] * slope[g] - mref : dm[kt] * slope[g];
                S[g][kt] = __builtin_amdgcn_mfma_f32_16x16x32_bf16(kf[kt][0], q0, S[g][kt], 0, 0, 0);
                S[g][kt] = __builtin_amdgcn_mfma_f32_16x16x32_bf16(kf[kt][1], q1, S[g][kt], 0, 0, 0);
            }
        }
        __builtin_amdgcn_s_setprio(0);
    }
}
template <int NH> __device__ __forceinline__ void tile_qk_r(const LAS unsigned char* Kt, const Lane& L, const bf16x8 (&qf)[NH][2],
        const float (&slope)[NH], float brel, int drel, int dlo, bool row_on, bool need_mask, const State<NH>& st, f32x4 (&S)[NH][4]) {
    f32x4 dm[4];
#pragma unroll
    for (int kt = 0; kt < 4; ++kt)
#pragma unroll
        for (int r = 0; r < 4; ++r) dm[kt][r] = brel + (float)(16 * kt + r);
    if (need_mask) {
#pragma unroll
        for (int kt = 0; kt < 4; ++kt)
#pragma unroll
            for (int r = 0; r < 4; ++r) { const int dl = drel + 16 * kt + r; dm[kt][r] = (row_on && dl <= 0 && dl >= dlo) ? dm[kt][r] : -BIGD; }
    }
    bf16x8 kf[4][2];
#pragma unroll
    for (int kt = 0; kt < 4; ++kt) { kf[kt][0] = *(const LAS bf16x8*)(Kt + L.kb0 + kt * 2048); kf[kt][1] = *(const LAS bf16x8*)(Kt + L.kb1 + kt * 2048); }
#pragma unroll
    for (int g = 0; g < NH; ++g) {
        float mref = st.m[g]; asm volatile("" : "+v"(mref));
#pragma unroll
        for (int kt = 0; kt < 4; ++kt) {
            S[g][kt] = dm[kt] * slope[g] - mref;
            S[g][kt] = __builtin_amdgcn_mfma_f32_16x16x32_bf16(kf[kt][0], qf[g][0], S[g][kt], 0, 0, 0);
            S[g][kt] = __builtin_amdgcn_mfma_f32_16x16x32_bf16(kf[kt][1], qf[g][1], S[g][kt], 0, 0, 0);
        }
    }
}
template <int NH, int MODE> __device__ __forceinline__ void tile_sv(const LAS unsigned char* Vt, const Lane& L, f32x4 (&S)[NH][4], State<NH>& st,
        const float (&mfix)[NH], const float (&ilfix)[NH], float (&impm)[4], float (&impn)[4]) {
    bf16x8 pf[NH][2];
#pragma unroll
    for (int g = 0; g < NH; ++g) {
        if (MODE == 2) {
#pragma unroll
            for (int kt = 0; kt < 4; ++kt) {
#pragma unroll
                for (int r = 0; r < 4; ++r) S[g][kt][r] = __builtin_amdgcn_exp2f(S[g][kt][r] - mfix[g]) * ilfix[g];
                impm[kt] += (S[g][kt][0] + S[g][kt][1]) + (S[g][kt][2] + S[g][kt][3]); impn[kt] += S[g][kt][3];
            }
        } else if (MODE == 0) {
            float mg = st.m[g], lg = st.l[g];
            float ls = 0.f; u32x4 w0, w1;
#define TH_EXPPACK(dl_) do { float p_[4][4]; ls = 0.f; \
                _Pragma("unroll") for (int kt = 0; kt < 4; ++kt) _Pragma("unroll") for (int r = 0; r < 4; ++r) { p_[kt][r] = __builtin_amdgcn_exp2f(S[g][kt][r] - (dl_)); ls += p_[kt][r]; } \
                w0.x = cvtpk(p_[0][0], p_[0][1]); w0.y = cvtpk(p_[0][2], p_[0][3]); w0.z = cvtpk(p_[1][0], p_[1][1]); w0.w = cvtpk(p_[1][2], p_[1][3]); \
                w1.x = cvtpk(p_[2][0], p_[2][1]); w1.y = cvtpk(p_[2][2], p_[2][3]); w1.z = cvtpk(p_[3][0], p_[3][1]); w1.w = cvtpk(p_[3][2], p_[3][3]); } while (0)
            {   float p_[4][4];
#pragma unroll
                for (int kt = 0; kt < 4; ++kt)
#pragma unroll
                    for (int r = 0; r < 4; ++r) { p_[kt][r] = __builtin_amdgcn_exp2f(S[g][kt][r]); ls += p_[kt][r]; }
                w0.x = cvtpk(p_[0][0], p_[0][1]); w0.y = cvtpk(p_[0][2], p_[0][3]); w0.z = cvtpk(p_[1][0], p_[1][1]); w0.w = cvtpk(p_[1][2], p_[1][3]);
                w1.x = cvtpk(p_[2][0], p_[2][1]); w1.y = cvtpk(p_[2][2], p_[2][3]); w1.z = cvtpk(p_[3][0], p_[3][1]); w1.w = cvtpk(p_[3][2], p_[3][3]); }
            if (__builtin_expect(__any(!(ls < 4096.f)), 0)) {
                float mx = __builtin_fmaxf(__builtin_fmaxf(S[g][0][0], S[g][0][1]), S[g][0][2]);
                mx = __builtin_fmaxf(__builtin_fmaxf(mx, S[g][0][3]), S[g][1][0]); mx = __builtin_fmaxf(__builtin_fmaxf(mx, S[g][1][1]), S[g][1][2]);
                mx = __builtin_fmaxf(__builtin_fmaxf(mx, S[g][1][3]), S[g][2][0]); mx = __builtin_fmaxf(__builtin_fmaxf(mx, S[g][2][1]), S[g][2][2]);
                mx = __builtin_fmaxf(__builtin_fmaxf(mx, S[g][2][3]), S[g][3][0]); mx = __builtin_fmaxf(__builtin_fmaxf(mx, S[g][3][1]), S[g][3][2]);
                mx = __builtin_fmaxf(mx, S[g][3][3]);
                mx = fmaxf(mx, x16f(mx)); mx = fmaxf(mx, x32f(mx));
                const float dl = fmaxf(mx, 0.f);
                const float alpha = __builtin_amdgcn_exp2f(-dl);
                mg += dl; lg *= alpha;
#pragma unroll
                for (int nt = 0; nt < 4; ++nt) st.O[g][nt] = st.O[g][nt] * alpha;
                TH_EXPPACK(dl);
            }
#undef TH_EXPPACK
            st.m[g] = mg; st.l[g] = lg + ls;
            pf[g][0] = __builtin_bit_cast(bf16x8, w0); pf[g][1] = __builtin_bit_cast(bf16x8, w1);
        } else {
            float mx = fmaxf(fmaxf(S[g][0][0], S[g][0][1]), fmaxf(S[g][0][2], S[g][0][3]));
#pragma unroll
            for (int kt = 1; kt < 4; ++kt) mx = fmaxf(mx, fmaxf(fmaxf(S[g][kt][0], S[g][kt][1]), fmaxf(S[g][kt][2], S[g][kt][3])));
            mx = fmaxf(mx, x16f(mx)); mx = fmaxf(mx, x32f(mx));
            const float mnew = fmaxf(st.m[g], mx);
            const float alpha = __builtin_amdgcn_exp2f(st.m[g] - mnew);
            st.m[g] = mnew; st.l[g] *= alpha;
            float ls = 0.f;
#pragma unroll
            for (int kt = 0; kt < 4; ++kt)
#pragma unroll
                for (int r = 0; r < 4; ++r) { const float pr = __builtin_amdgcn_exp2f(S[g][kt][r] - mnew); S[g][kt][r] = pr; ls += pr; }
            st.l[g] += ls;
        }
        if (MODE == 2) {
#pragma unroll
            for (int s2 = 0; s2 < 2; ++s2) {
                u32x4 wv; wv.x = cvtpk(S[g][2 * s2][0], S[g][2 * s2][1]); wv.y = cvtpk(S[g][2 * s2][2], S[g][2 * s2][3]); wv.z = cvtpk(S[g][2 * s2 + 1][0], S[g][2 * s2 + 1][1]); wv.w = cvtpk(S[g][2 * s2 + 1][2], S[g][2 * s2 + 1][3]);
                pf[g][s2] = __builtin_bit_cast(bf16x8, wv);
            }
        }
    }
    if (MODE != 1) {
        typedef int v2i __attribute__((ext_vector_type(2))); typedef int v4i __attribute__((ext_vector_type(4)));
        const unsigned vbase_ = (unsigned)(unsigned long)Vt;
        const unsigned va0 = vbase_ + L.vb[0], va1 = vbase_ + L.vb[1], va2 = vbase_ + L.vb[2], va3 = vbase_ + L.vb[3];
        v2i lo0, hi0, lo1, hi1;
#define TRRD(lo_, hi_, a_, o0_, o1_) asm volatile("ds_read_b64_tr_b16 %0, %2 offset:" #o0_ "\n\tds_read_b64_tr_b16 %1, %2 offset:" #o1_ : "=&v"(lo_), "=&v"(hi_) : "v"(a_) : "memory")
#define TRWAIT(n_, lo_, hi_) asm volatile("s_waitcnt lgkmcnt(" #n_ ")" : "+v"(lo_), "+v"(hi_))
#define TRPV(lo_, hi_, nt_, s2_) do { const v4i v4_ = {lo_[0], lo_[1], hi_[0], hi_[1]}; const bf16x8 vf_ = __builtin_bit_cast(bf16x8, v4_); \
            _Pragma("unroll") for (int g = 0; g < NH; ++g) st.O[g][nt_] = __builtin_amdgcn_mfma_f32_16x16x32_bf16(vf_, pf[g][s2_], st.O[g][nt_], 0, 0, 0); } while (0)
        __builtin_amdgcn_s_setprio(1);
        TRRD(lo0, hi0, va0, 0, 2048);
        TRRD(lo1, hi1, va1, 0, 2048);    TRWAIT(2, lo0, hi0); TRPV(lo0, hi0, 0, 0);
        TRRD(lo0, hi0, va2, 0, 2048);    TRWAIT(2, lo1, hi1); TRPV(lo1, hi1, 1, 0);
        TRRD(lo1, hi1, va3, 0, 2048);    TRWAIT(2, lo0, hi0); TRPV(lo0, hi0, 2, 0);
        TRRD(lo0, hi0, va0, 4096, 6144); TRWAIT(2, lo1, hi1); TRPV(lo1, hi1, 3, 0);
        TRRD(lo1, hi1, va1, 4096, 6144); TRWAIT(2, lo0, hi0); TRPV(lo0, hi0, 0, 1);
        TRRD(lo0, hi0, va2, 4096, 6144); TRWAIT(2, lo1, hi1); TRPV(lo1, hi1, 1, 1);
        TRRD(lo1, hi1, va3, 4096, 6144); TRWAIT(2, lo0, hi0); TRPV(lo0, hi0, 2, 1);
        TRWAIT(0, lo1, hi1); TRPV(lo1, hi1, 3, 1);
        __builtin_amdgcn_s_setprio(0);
#undef TRRD
#undef TRWAIT
#undef TRPV
    }
}
template <int NH, int MODE> __device__ __forceinline__ void tile_heads(const LAS unsigned char* Kt, const LAS unsigned char* Vt, const Lane& L, const LAS unsigned char* qlds, int lane,
        const float (&slope)[NH], float brel, int drel, int dlo, bool row_on, bool need_mask, State<NH>& st, const float (&mfix)[NH], const float (&ilfix)[NH], float (&impm)[4], float (&impn)[4]) {
    f32x4 S[NH][4];
    tile_qk<NH, MODE>(Kt, L, qlds, lane, slope, brel, drel, dlo, row_on, need_mask, st, S);
    tile_sv<NH, MODE>(Vt, L, S, st, mfix, ilfix, impm, impn);
}
__device__ __forceinline__ void scale_q(const u32x4 (&qw)[2], float sc, bf16x8 (&qf)[2]) {
#pragma unroll
    for (int ks = 0; ks < 2; ++ks) { const u32x4 w = qw[ks]; u32x4 o;
        o.x = cvtpk(bf_lo(w.x) * sc, bf_hi(w.x) * sc); o.y = cvtpk(bf_lo(w.y) * sc, bf_hi(w.y) * sc); o.z = cvtpk(bf_lo(w.z) * sc, bf_hi(w.z) * sc); o.w = cvtpk(bf_lo(w.w) * sc, bf_hi(w.w) * sc);
        qf[ks] = __builtin_bit_cast(bf16x8, o); }
}
__device__ __forceinline__ void load_q(const bf16_t* qrow, int grp, float sc, bf16x8 (&qf)[2]) {
#pragma unroll
    for (int ks = 0; ks < 2; ++ks) { const u32x4 w = *(const u32x4*)(qrow + 32 * ks + 8 * grp); u32x4 o;
        o.x = cvtpk(bf_lo(w.x) * sc, bf_hi(w.x) * sc); o.y = cvtpk(bf_lo(w.y) * sc, bf_hi(w.y) * sc); o.z = cvtpk(bf_lo(w.z) * sc, bf_hi(w.z) * sc); o.w = cvtpk(bf_lo(w.w) * sc, bf_hi(w.w) * sc);
        qf[ks] = __builtin_bit_cast(bf16x8, o); }
}
}

struct DilUnit { int dd, rho, jb, hd, b, T0, nT; };
__device__ __forceinline__ DilUnit dil_decode(int unit) {
    DilUnit U; const int g3 = unit >> 9, rem = unit & 511; U.b = rem >> 5; const int hh = (rem >> 4) & 1;
    if (g3 == 0) { U.dd = 1; U.rho = 0; U.jb = rem & 15; } else if (g3 == 1) { U.dd = 4; U.rho = (rem >> 2) & 3; U.jb = rem & 3; } else { U.dd = 16; U.rho = rem & 15; U.jb = 0; }
    U.hd = 2 * g3 + hh;
    const int tau0 = 128 * U.jb; U.T0 = (tau0 >= 128) ? (tau0 >> 6) - 2 : 0; U.nT = (tau0 >> 6) + 2 - U.T0;
    return U;
}
struct DilStage { u32x4 k[4], v[4], q[2]; };
__device__ __forceinline__ void dil_load(DilStage& sr, const bf16_t* PROJ, const DilUnit& U, int tid) {
    const int R = tid >> 3, ch = tid & 7; const long ld = (long)U.dd * 64;
    const bf16_t* kb = PROJ + pj_off((long)U.b * SEQ + U.rho, C_DK + U.hd * 64) + ch * 8; const bf16_t* vb = PROJ + pj_off((long)U.b * SEQ + U.rho, C_DV + U.hd * 64) + ch * 8;
#pragma unroll
    for (int i = 0; i < 4; ++i) if (i < U.nT) { const size_t off = (size_t)(64 * (U.T0 + i) + R) * ld; sr.k[i] = *(const u32x4*)(kb + off); sr.v[i] = *(const u32x4*)(vb + off); }
    {
        const int lane = tid & 63, w = tid >> 6; const long qrow = (long)U.b * SEQ + U.rho + (long)U.dd * (128 * U.jb + 16 * w + (lane & 15));
        const bf16_t* qp = PROJ + pj_off(qrow, C_DQ + U.hd * 64) + 8 * (lane >> 4);
        sr.q[0] = *(const u32x4*)(qp); sr.q[1] = *(const u32x4*)(qp + 32); }
}
__device__ __forceinline__ void dil_store(const DilStage& sr, LAS unsigned char* buf, const DilUnit& U, int tid) {
    const int R = tid >> 3, ch = tid & 7;
#pragma unroll
    for (int i = 0; i < 4; ++i) if (i < U.nT) { *(LAS u32x4*)(buf + i * 2 * att::TILE_BYTES + att::k_off(R, ch)) = sr.k[i]; *(LAS u32x4*)(buf + (i * 2 + 1) * att::TILE_BYTES + att::v_off(R, ch * 16)) = sr.v[i]; }
}
__device__ __forceinline__ void dil_compute(const Frame& F, const DilUnit& U, const LAS unsigned char* buf, const u32x4 (&qw)[2]) {
    const int lane = F.lane, w = F.wave;
    const bf16_t* PROJ = (const bf16_t*)(F.ws + WS_PROJ); bf16_t* MIX = (bf16_t*)(F.ws + WS_MIX); float* LSE = (float*)(F.ws + WS_LSE);
    const att::Lane L = att::make_lane(lane);
    const int tauw = 128 * U.jb + 16 * w, tau = tauw + L.c;
    const long row = (long)U.b * SEQ + U.rho + (long)U.dd * tau;
    att::bf16x8 qf[1][2];
    att::scale_q(qw, 0.125f * att::LOG2E, qf[0]);
    const float slope[1] = {dil_slope(U.hd) * (float)U.dd * att::LOG2E};
    float m0 = 0.f; asm volatile("" : "+v"(m0));
    att::State<1> st; att::state_reset(st, m0);
    float dmy1[1] = {0.f}, dmy4[4] = {0.f, 0.f, 0.f, 0.f};
#pragma unroll 1
    for (int i = 0; i < U.nT; ++i) {
        const int T = U.T0 + i;
        const LAS unsigned char* Kt = buf + i * 2 * att::TILE_BYTES; const LAS unsigned char* Vt = Kt + att::TILE_BYTES;
        const bool skip = (64 * T > tauw + 15) || (64 * T + 63 < tauw - 128);
        if (!skip) {
            const bool need_mask = !(64 * T + 63 <= tauw && 64 * T >= tauw + 15 - 128);
            const int drel = 64 * T + 4 * L.grp - tau;
            f32x4 S[1][4];
            att::tile_qk_r<1>(Kt, L, qf, slope, (float)drel, drel, -128, true, need_mask, st, S);
            att::tile_sv<1, 0>(Vt, L, S, st, dmy1, dmy1, dmy4, dmy4);
        }
    }
    float lt = st.l[0]; lt += x16f(lt); lt += x32f(lt);
    const float il = rcpf_(lt);
    bf16_t* orow = MIX + pj_off(row, 384 + U.hd * 64) + 4 * L.grp;
#pragma unroll
    for (int nt = 0; nt < 4; ++nt) { const f32x4 o = st.O[0][nt] * il; u32x2 wv; wv.x = att::cvtpk(o[0], o[1]); wv.y = att::cvtpk(o[2], o[3]); *(u32x2*)(orow + 16 * nt) = wv; }
    if (L.grp == 0) LSE[(size_t)row * 8 + U.hd] = (st.m[0] + __log2f(lt)) * att::LN2;
}
__device__ __forceinline__ void dil_units(const Frame& F, int first, int stride) {
    const bf16_t* PROJ = (const bf16_t*)(F.ws + WS_PROJ);
    if (2 * first >= 1536) return;
    DilStage sr;
    int u = 2 * first;
    DilUnit U = dil_decode(u);
    dil_load(sr, PROJ, U, F.tid); dil_store(sr, F.lds, U, F.tid);
    u32x4 qc[2] = {sr.q[0], sr.q[1]};
    int cur = 0;
#pragma unroll 1
    for (;;) {
        const int un = (u & 1) ? (u - 1 + 2 * stride) : (u + 1);
        const bool has_next = un < 1536;
        DilUnit Un = U;
        if (has_next) { Un = dil_decode(un); dil_load(sr, PROJ, Un, F.tid); }
        __syncthreads();
        dil_compute(F, U, F.lds + cur * 65536, qc);
        if (has_next) { dil_store(sr, F.lds + (cur ^ 1) * 65536, Un, F.tid); qc[0] = sr.q[0]; qc[1] = sr.q[1]; }
        cur ^= 1; U = Un;
        if (!has_next) break;
        u = un;
    }
    __syncthreads();
}
__device__ __forceinline__ void dil_fixup(const Frame& F) {
    bf16_t* MIX = (bf16_t*)(F.ws + WS_MIX); const float* LSE = (const float*)(F.ws + WS_LSE);
    const int st = F.G * 512;
    for (int idx0 = F.bid * 512 + F.tid; idx0 < MTOK * 48; idx0 += 4 * st) {
        float l0[4], l1[4], l2[4]; u32x4 wv[4];
#pragma unroll
        for (int k = 0; k < 4; ++k) { const int idx = (idx0 + k * st < MTOK * 48) ? idx0 + k * st : idx0; const int ch = idx & 7, hd = (idx >> 3) % 6, row = idx / 48, hh = hd & 1;
            l0[k] = LSE[(size_t)row * 8 + hh]; l1[k] = LSE[(size_t)row * 8 + 2 + hh]; l2[k] = LSE[(size_t)row * 8 + 4 + hh];
            wv[k] = *(const u32x4*)(MIX + pj_off(row, 384 + hd * 64) + ch * 8); }
#pragma unroll
        for (int k = 0; k < 4; ++k) { const int idx = idx0 + k * st; if (idx < MTOK * 48) { const int ch = idx & 7, hd = (idx >> 3) % 6, row = idx / 48, g3 = hd >> 1;
            const float mx = fmaxf(l0[k], fmaxf(l1[k], l2[k]));
            const float e0 = __expf(l0[k] - mx), e1 = __expf(l1[k] - mx), e2 = __expf(l2[k] - mx);
            const float al = ((g3 == 0) ? e0 : ((g3 == 1) ? e1 : e2)) * rcpf_((e0 + e1) + e2);
            const u32x4 w = wv[k]; u32x4 o;
            o.x = pk2(bf_lo(w.x) * al, bf_hi(w.x) * al); o.y = pk2(bf_lo(w.y) * al, bf_hi(w.y) * al); o.z = pk2(bf_lo(w.z) * al, bf_hi(w.z) * al); o.w = pk2(bf_lo(w.w) * al, bf_hi(w.w) * al);
            *(u32x4*)(MIX + pj_off(row, 384 + hd * 64) + ch * 8) = o; } }
    }
}

struct NsaCtx { int tid, lane, w, t, tw; long row; att::Lane L; float slope[3]; };
__device__ __forceinline__ NsaCtx nsa_ctx(const Frame& F, int b, int kvh, int jb) {
    NsaCtx C; int tid = F.tid, lane = F.lane, w = F.wave;
    asm volatile("" : "+v"(tid), "+v"(lane)); asm volatile("" : "+s"(w));
    C.tid = tid; C.lane = lane; C.w = w; C.L = att::make_lane(lane);
    C.tw = 128 * jb + 16 * w; C.t = C.tw + C.L.c; C.row = (long)b * SEQ + C.t;
#pragma unroll
    for (int g = 0; g < 3; ++g) C.slope[g] = nsa_slope(kvh * 3 + g) * att::LOG2E;
    return C;
}
#define NSA_FIN_ADD(first_, g_, nt_, v_) do { const f32x4 v__ = (v_); u32x2* p__ = (u32x2*)(MIXo + pj_off(C.row, (kvh * 3 + (g_)) * 64) + 4 * L.grp + 16 * (nt_)); u32x2 f__ = (u32x2){0u, 0u}; if (!(first_)) f__ = *p__; u32x2 o__; \
        o__.x = att::cvtpk(bf_lo(f__.x) + v__[0], bf_hi(f__.x) + v__[1]); o__.y = att::cvtpk(bf_lo(f__.y) + v__[2], bf_hi(f__.y) + v__[3]); *p__ = o__; } while (0)
__device__ __forceinline__ float nsa_gate(const bf16_t* PROJ, long row, int kvh, int g, int br) { return sigmoidf_(bf_lo((unsigned)PROJ[pj_off(row, C_GATE) + (kvh * 3 + g) * 3 + br])); }

__device__ __forceinline__ LAS unsigned char* nsa_fin_pad(LAS unsigned char* lds, int w) {
    const int off = (w < 2) ? (49152 + w * 6144) : ((w < 4) ? (115968 + (w - 2) * 6144) : (139264 + (w - 4) * 6144));
    return lds + off;
}
__device__ __forceinline__ unsigned nsa_cmp_topk(const Frame& F, int b, int kvh, int jb) {
    bf16_t* MIXo = (bf16_t*)(F.ws + WS_MIX);
    const NsaCtx C = nsa_ctx(F, b, kvh, jb);
    const att::Lane& L = C.L; const int lane = C.lane, tid = C.tid, w = C.w, t = C.t, tw = C.tw;
    const bf16_t* PROJ = (const bf16_t*)(F.ws + WS_PROJ);
    const bf16_t* KCMP = (const bf16_t*)(F.ws + WS_KCMP) + (size_t)(b * 2 + kvh) * 128 * 64; const bf16_t* VCMP = (const bf16_t*)(F.ws + WS_VCMP) + (size_t)(b * 2 + kvh) * 128 * 64;
    LAS unsigned char* cbuf = F.lds;
    LAS float* impM = (LAS float*)(F.lds + 32768) + w * 1056;
    LAS float* impN = impM + 528;
    LAS unsigned* uni = (LAS unsigned*)(F.lds + 32768 + 8 * 4224);
    LAS unsigned char* qlds = F.lds + 32768 + 8 * 4224 + 256 + w * 6144;
    unsigned graw0[3];
#pragma unroll
    for (int g = 0; g < 3; ++g) graw0[g] = (unsigned)PROJ[pj_off(C.row, C_GATE) + (kvh * 3 + g) * 3 + 0];
    float slopec[3];
    {
        u32x4 qw[3][2];
#pragma unroll
        for (int g = 0; g < 3; ++g) { const bf16_t* qrow = PROJ + pj_off(C.row, C_NQ + (kvh * 3 + g) * 64) + 8 * L.grp; qw[g][0] = *(const u32x4*)(qrow); qw[g][1] = *(const u32x4*)(qrow + 32); }
        att::StageRegs s0, s1;
        att::stage_load(s0, KCMP, VCMP, 64, tid); att::stage_load(s1, KCMP + 4096, VCMP + 4096, 64, tid);
#pragma unroll
        for (int g = 0; g < 3; ++g) {
            slopec[g] = 16.0f * C.slope[g];
            att::bf16x8 qf[2]; att::scale_q(qw[g], 0.125f * att::LOG2E, qf);
            *(LAS att::bf16x8*)(qlds + ((g * 2 + 0) * 64 + lane) * 16) = qf[0]; *(LAS att::bf16x8*)(qlds + ((g * 2 + 1) * 64 + lane) * 16) = qf[1];
        }
        att::stage_store(s0, cbuf, cbuf + att::TILE_BYTES, tid); att::stage_store(s1, cbuf + 2 * att::TILE_BYTES, cbuf + 3 * att::TILE_BYTES, tid);
        for (int i2 = lane; i2 < 1056; i2 += 64) impM[i2] = 0.f;
    }
    __syncthreads();
    const int nmax = (t >= 31) ? ((t - 31) >> 4) : -1, nmaxw = (tw >= 31) ? ((tw - 31) >> 4) : -1, nmaxw_hi = (tw + 15 >= 31) ? ((tw + 15 - 31) >> 4) : -1;
    const float tcf = ((float)t - 15.5f) * (1.0f / 16.0f);
    att::State<3> st; att::state_reset(st);
    {
        f32x4 S[2][3][4];
#pragma unroll
        for (int T = 0; T < 2; ++T) {
            const LAS unsigned char* Kt = cbuf + T * 2 * att::TILE_BYTES;
            const float brel = (float)(64 * T + 4 * L.grp) - tcf; const int drel = 64 * T + 4 * L.grp - nmax;
            f32x4 dm[4];
#pragma unroll
            for (int kt = 0; kt < 4; ++kt)
#pragma unroll
                for (int r = 0; r < 4; ++r) dm[kt][r] = (drel + 16 * kt + r <= 0) ? brel + (float)(16 * kt + r) : -att::BIGD;
            att::bf16x8 kf[4][2];
#pragma unroll
            for (int kt = 0; kt < 4; ++kt) { kf[kt][0] = *(const LAS att::bf16x8*)(Kt + L.kb0 + kt * 2048); kf[kt][1] = *(const LAS att::bf16x8*)(Kt + L.kb1 + kt * 2048); }
#pragma unroll
            for (int g = 0; g < 3; ++g) {
                const att::bf16x8 q0 = *(const LAS att::bf16x8*)(qlds + ((g * 2 + 0) * 64 + lane) * 16), q1 = *(const LAS att::bf16x8*)(qlds + ((g * 2 + 1) * 64 + lane) * 16);
#pragma unroll
                for (int kt = 0; kt < 4; ++kt) {
                    S[T][g][kt] = dm[kt] * slopec[g];
                    S[T][g][kt] = __builtin_amdgcn_mfma_f32_16x16x32_bf16(kf[kt][0], q0, S[T][g][kt], 0, 0, 0);
                    S[T][g][kt] = __builtin_amdgcn_mfma_f32_16x16x32_bf16(kf[kt][1], q1, S[T][g][kt], 0, 0, 0);
                }
            }
        }
        att::bf16x8 pf[3][2][2];
        float impm[2][4], impn[2][4];
#pragma unroll
        for (int T = 0; T < 2; ++T)
#pragma unroll
            for (int kt = 0; kt < 4; ++kt) { impm[T][kt] = 0.f; impn[T][kt] = 0.f; }
#pragma unroll
        for (int g = 0; g < 3; ++g) {
            float mx = att::MFLOOR;
#pragma unroll
            for (int T = 0; T < 2; ++T)
#pragma unroll
                for (int kt = 0; kt < 4; ++kt) mx = fmaxf(mx, fmaxf(fmaxf(S[T][g][kt][0], S[T][g][kt][1]), fmaxf(S[T][g][kt][2], S[T][g][kt][3])));
            mx = fmaxf(mx, x16f(mx)); mx = fmaxf(mx, x32f(mx));
            float ls = 0.f;
#pragma unroll
            for (int T = 0; T < 2; ++T)
#pragma unroll
                for (int kt = 0; kt < 4; ++kt)
#pragma unroll
                    for (int r = 0; r < 4; ++r) { const float e = __builtin_amdgcn_exp2f(S[T][g][kt][r] - mx); S[T][g][kt][r] = e; ls += e; }
            ls += x16f(ls); ls += x32f(ls);
            const float il = (ls > 0.f) ? rcpf_(ls) : 0.f;
#pragma unroll
            for (int T = 0; T < 2; ++T) {
#pragma unroll
                for (int kt = 0; kt < 4; ++kt) { S[T][g][kt] = S[T][g][kt] * il; impm[T][kt] += (S[T][g][kt][0] + S[T][g][kt][1]) + (S[T][g][kt][2] + S[T][g][kt][3]); impn[T][kt] += S[T][g][kt][3]; }
#pragma unroll
                for (int s2 = 0; s2 < 2; ++s2) { u32x4 wv; wv.x = att::cvtpk(S[T][g][2 * s2][0], S[T][g][2 * s2][1]); wv.y = att::cvtpk(S[T][g][2 * s2][2], S[T][g][2 * s2][3]);
                    wv.z = att::cvtpk(S[T][g][2 * s2 + 1][0], S[T][g][2 * s2 + 1][1]); wv.w = att::cvtpk(S[T][g][2 * s2 + 1][2], S[T][g][2 * s2 + 1][3]); pf[g][T][s2] = __builtin_bit_cast(att::bf16x8, wv); }
            }
        }
#pragma unroll
        for (int T = 0; T < 2; ++T)
#pragma unroll
            for (int kt = 0; kt < 4; ++kt) { const int mb = 16 * T + 4 * kt + L.grp; impM[L.c * 33 + mb] = impm[T][kt]; impN[L.c * 33 + mb + 1] = impn[T][kt]; }
#pragma unroll
        for (int T = 0; T < 2; ++T) {
            const LAS unsigned char* Vt = cbuf + T * 2 * att::TILE_BYTES + att::TILE_BYTES;
#pragma unroll
            for (int s2 = 0; s2 < 2; ++s2)
#pragma unroll
                for (int nt = 0; nt < 4; ++nt) {
                    const att::v4i16 lo = __builtin_amdgcn_ds_read_tr16_b64_v4i16((LAS att::v4i16*)(Vt + L.vb[nt] + 4096 * s2));
                    const att::v4i16 hi = __builtin_amdgcn_ds_read_tr16_b64_v4i16((LAS att::v4i16*)(Vt + L.vb[nt] + 4096 * s2 + 2048));
                    const att::bf16x8 vf = {lo[0], lo[1], lo[2], lo[3], hi[0], hi[1], hi[2], hi[3]};
#pragma unroll
                    for (int g = 0; g < 3; ++g) st.O[g][nt] = __builtin_amdgcn_mfma_f32_16x16x32_bf16(vf, pf[g][T][s2], st.O[g][nt], 0, 0, 0);
                }
        }
    }
    u32x2 fin0[3][4];
#pragma unroll
    for (int g = 0; g < 3; ++g) { const float gt = sigmoidf_(bf_lo(graw0[g]));
#pragma unroll
        for (int nt = 0; nt < 4; ++nt) { const f32x4 v = st.O[g][nt] * gt; fin0[g][nt].x = att::cvtpk(v[0], v[1]); fin0[g][nt].y = att::cvtpk(v[2], v[3]); } }
    asm volatile("s_waitcnt lgkmcnt(0)" ::: "memory");
    const int cur = t >> 6, hi = cur - 2;
    unsigned mk = 0u;
    {
        float wv[32]; wv[0] = -1.0f;
#pragma unroll
        for (int m2 = 1; m2 < 32; ++m2) { const float w2 = impM[L.c * 33 + m2] + impN[L.c * 33 + m2]; wv[m2] = (m2 <= hi) ? w2 : -1.0f; }
#pragma unroll
        for (int jj = 0; jj < 8; ++jj) {
            const float v = (L.grp == 0) ? wv[4 * jj] : ((L.grp == 1) ? wv[4 * jj + 1] : ((L.grp == 2) ? wv[4 * jj + 2] : wv[4 * jj + 3]));
            int rank = 0;
#pragma unroll
            for (int m2 = 1; m2 < 32; ++m2) {
                const int d = m2 - 4 * jj; bool cnd;
                if (d < 0) cnd = wv[m2] >= v; else if (d >= 3) cnd = wv[m2] > v; else cnd = (wv[m2] > v) || (wv[m2] == v && L.grp > d);
                rank += cnd ? 1 : 0;
            }
            const int mm = L.grp + 4 * jj;
            if (mm >= 1 && mm <= hi && rank < 5) mk |= 1u << mm;
        }
    }
    mk |= x16u(mk); mk |= x32u(mk);
    mk |= 1u | (1u << cur); if (cur >= 1) mk |= 1u << (cur - 1);
    unsigned um = row_or16(mk);
    if (lane == 0) uni[w] = um;
    __syncthreads();
    {   LAS u32x2* fp = (LAS u32x2*)nsa_fin_pad(F.lds, w);
#pragma unroll
        for (int g = 0; g < 3; ++g)
#pragma unroll
            for (int nt = 0; nt < 4; ++nt) fp[(g * 4 + nt) * 64 + lane] = fin0[g][nt];
    }
    return mk;
}
template <int BR, bool DISCARD = false> __device__ __forceinline__ void nsa_branch(const Frame& F, int b, int kvh, int jb, unsigned selmask) {
    bf16_t* MIXo = (bf16_t*)(F.ws + WS_MIX);
    const NsaCtx C = nsa_ctx(F, b, kvh, jb);
    const att::Lane& L = C.L; const int lane = C.lane, w = C.w, t = C.t, tw = C.tw;
    const bf16_t* PROJ = (const bf16_t*)(F.ws + WS_PROJ);
    const LAS unsigned* uni = (const LAS unsigned*)(F.lds + 32768 + 8 * 4224);
    const LAS unsigned char* qlds = F.lds + 32768 + 8 * 4224 + 256 + w * 6144;
    const int R = 8 * w + (lane >> 3), pch = lane & 7;
    const bf16_t* ksrc = PROJ + pj_off((long)b * SEQ + R, (BR == 1 ? C_KS : C_KW) + kvh * 64) + 8 * (pch ^ ((R >> 1) & 7));
    const bf16_t* vsrc = PROJ + pj_off((long)b * SEQ + R, (BR == 1 ? C_VS : C_VW) + kvh * 64) + 8 * (pch ^ (((R >> 1) & 3) << 1));
#define NSA_DMA(T_, slot_) do { const size_t to_ = (size_t)(64 * (T_)) * 64; LAS unsigned* d_ = (LAS unsigned*)(F.lds + (slot_) * 16384 + w * 1024); \
        __builtin_amdgcn_global_load_lds((const unsigned*)(ksrc + to_), d_, 16, 0, 0); __builtin_amdgcn_global_load_lds((const unsigned*)(vsrc + to_), (LAS unsigned*)((LAS unsigned char*)d_ + 8192), 16, 0, 0); } while (0)
    float dummy3[3] = {0.f, 0.f, 0.f}, dummy4[4] = {0.f, 0.f, 0.f, 0.f};
    float m0 = 0.f; asm volatile("" : "+v"(m0));
    att::State<3> st; att::state_reset(st, m0);
    unsigned rem = 0u; int Tlast = 0, T0, T1, T2;
    if (BR == 1) { unsigned um = 0u;
#pragma unroll
        for (int i2 = 0; i2 < 8; ++i2) um |= uni[i2];
        rem = __builtin_amdgcn_readfirstlane(um); }
#define NSA_NEXT(dst_, prev_) do { if (BR == 1) { if (rem != 0u) { dst_ = __builtin_ctz(rem); rem &= rem - 1; } else dst_ = -1; } else { dst_ = ((prev_) >= 0 && (prev_) < Tlast) ? (prev_) + 1 : -1; } } while (0)
    if (BR == 1) { T0 = __builtin_ctz(rem); rem &= rem - 1; } else { T0 = (2 * jb >= 8) ? 2 * jb - 8 : 0; Tlast = 2 * jb + 1; }
    NSA_NEXT(T1, T0); NSA_NEXT(T2, T1);
    asm volatile("s_waitcnt lgkmcnt(0)" ::: "memory"); __builtin_amdgcn_s_barrier();
    NSA_DMA(T0, 0);
    if (T1 >= 0) { NSA_DMA(T1, 1); asm volatile("s_waitcnt vmcnt(2)" ::: "memory"); } else { asm volatile("s_waitcnt vmcnt(0)" ::: "memory"); }
    __builtin_amdgcn_s_barrier();
    unsigned graw[3];
#pragma unroll
    for (int g = 0; g < 3; ++g) graw[g] = (unsigned)PROJ[pj_off(C.row, C_GATE) + (kvh * 3 + g) * 3 + BR];
    int slot = 0;
#pragma unroll 1
    for (;;) {
        if (T2 >= 0) { const int s2_ = (slot >= 1) ? slot - 1 : 2; NSA_DMA(T2, s2_); }
        const LAS unsigned char* Kt = F.lds + slot * 16384; const LAS unsigned char* Vt = Kt + att::TILE_BYTES;
        const int T = T0, drel = 64 * T + 4 * L.grp - t;
        if (BR == 1) {
            const bool row_on = (selmask >> T) & 1u;
            if (__any(row_on)) att::tile_heads<3, 0>(Kt, Vt, L, qlds, lane, C.slope, (float)drel, drel, -1000000, row_on, !(__all(row_on) && 64 * T + 63 <= tw), st, dummy3, dummy3, dummy4, dummy4);
        } else {
            const bool skip = (64 * T > tw + 15) || (64 * T + 63 < tw - 511);
            if (!skip) att::tile_heads<3, 0>(Kt, Vt, L, qlds, lane, C.slope, (float)drel, drel, -511, true, !(64 * T + 63 <= tw && 64 * T >= tw + 15 - 511), st, dummy3, dummy3, dummy4, dummy4);
        }
        if (T2 >= 0) { asm volatile("s_waitcnt vmcnt(2) lgkmcnt(0)" ::: "memory"); } else { asm volatile("s_waitcnt vmcnt(0) lgkmcnt(0)" ::: "memory"); }
        __builtin_amdgcn_s_barrier();
        if (T1 < 0) break;
        T0 = T1; T1 = T2; NSA_NEXT(T2, T1); slot = (slot == 2) ? 0 : slot + 1;
    }
#undef NSA_DMA
#undef NSA_NEXT
    LAS u32x2* fp = (LAS u32x2*)nsa_fin_pad(F.lds, w);
    u32x2 fold[3][4];
#pragma unroll
    for (int g = 0; g < 3; ++g)
#pragma unroll
        for (int nt = 0; nt < 4; ++nt) fold[g][nt] = DISCARD ? (u32x2){0u, 0u} : fp[(g * 4 + nt) * 64 + lane];
#pragma unroll
    for (int g = 0; g < 3; ++g) { float lt = st.l[g]; lt += x16f(lt); lt += x32f(lt); const float sc = (lt > 0.f) ? sigmoidf_(bf_lo(graw[g])) * rcpf_(lt) : 0.f;
#pragma unroll
        for (int nt = 0; nt < 4; ++nt) { const f32x4 v = st.O[g][nt] * sc;
            if (DISCARD) { asm volatile("" :: "v"(v[0]), "v"(v[1]), "v"(v[2]), "v"(v[3])); }
            else { u32x2 o; o.x = att::cvtpk(bf_lo(fold[g][nt].x) + v[0], bf_hi(fold[g][nt].x) + v[1]); o.y = att::cvtpk(bf_lo(fold[g][nt].y) + v[2], bf_hi(fold[g][nt].y) + v[3]);
                   if (BR == 2) *(u32x2*)(MIXo + pj_off(C.row, (kvh * 3 + g) * 64) + 4 * L.grp + 16 * nt) = o; else fp[(g * 4 + nt) * 64 + lane] = o; } } }
}
__device__ __forceinline__ void nsa_unit2(const Frame& F, int b, int kvh, int jb) {
    unsigned selmask = nsa_cmp_topk(F, b, kvh, jb);
#if REP_CMP > 1
    selmask = nsa_cmp_topk(F, b, kvh, jb);
#endif
#if REP_SEL > 1
    nsa_branch<1, true>(F, b, kvh, jb, selmask);
#endif
#if REP_WIN > 1
    nsa_branch<2, true>(F, b, kvh, jb, selmask);
#endif
    nsa_branch<1>(F, b, kvh, jb, selmask);
    nsa_branch<2>(F, b, kvh, jb, selmask);
}
#undef NSA_FIN_ADD

__device__ __forceinline__ void hgrn_local(const Frame& F, const Args& a, int l, int u) {
    typedef short bf16x8 __attribute__((ext_vector_type(8)));
    typedef short v4i16 __attribute__((ext_vector_type(4)));
    const int c = u & 31, bh = u >> 5, b = bh >> 2, h = bh & 3, lane = F.lane, l15 = lane & 15, grp = lane >> 4;
    const bf16_t* PROJ = (const bf16_t*)(F.ws + WS_PROJ);
    bf16_t* OLOC = (bf16_t*)(F.ws + WS_OLOC); bf16_t* QE = (bf16_t*)(F.ws + WS_QE); bf16_t* HU = (bf16_t*)(F.ws + WS_HU); float* HD = (float*)(F.ws + WS_HD);
    LAS unsigned char* QS = F.lds + F.wave * 16384;
    LAS unsigned char* KS = QS + 2048;
    LAS unsigned char* VV = QS + 4096;
    LAS float* GF = (LAS float*)(QS + 6144);
    float lb = 0.f;
    if (l == 1) lb = sigmoidf_(a.hg_lb[256 + h * 64 + lane] - a.hg_lb[h * 64 + lane]);
    const float omlb = 1.0f - lb;
    f32x4 Sacc[4][4];
#pragma unroll
    for (int dt = 0; dt < 4; ++dt)
#pragma unroll
        for (int et = 0; et < 4; ++et) Sacc[dt][et] = (f32x4){0.f, 0.f, 0.f, 0.f};
    float e0 = 1.0f;
    const long row0 = (long)b * SEQ + c * 64;
    const int qs_w = (lane >> 3), qs_wb = (lane & 7) * 2;
    const int tr_row = 4 * grp + (l15 >> 2), tr_col = 8 * (l15 & 3);
    LAS unsigned char* RQ = QS + 6400;
    LAS unsigned char* RF = QS + 8448;
    LAS unsigned char* OST = QS + 6400;
    LAS unsigned char* QEST = QS + 10752;
    const int wrow = lane >> 3, wch = lane & 7;
    const bf16_t* ginq = PROJ + pj_off(row0 + wrow, C_HQ + h * 64) + wch * 8; const bf16_t* ginf = PROJ + pj_off(row0 + wrow, C_HF + h * 64) + wch * 8; const bf16_t* gini = PROJ + pj_off(row0 + wrow, C_HI + h * 64) + wch * 8;
    u32x4 rq[2], rf[2], rv[2];
#pragma unroll
    for (int i = 0; i < 2; ++i) { const size_t ro = (size_t)(8 * i) * 64; rq[i] = *(const u32x4*)(ginq + ro); rf[i] = *(const u32x4*)(ginf + ro); rv[i] = *(const u32x4*)(gini + ro); }
#pragma unroll 1
    for (int I = 0; I < 4; ++I) {
        asm volatile("s_waitcnt lgkmcnt(0)" ::: "memory");
#pragma unroll
        for (int i = 0; i < 2; ++i) { *(LAS u32x4*)(RQ + (wrow + 8 * i) * 128 + wch * 16) = rq[i]; *(LAS u32x4*)(RF + (wrow + 8 * i) * 128 + wch * 16) = rf[i]; *(LAS u32x4*)(VV + att::v_off(wrow + 8 * i, wch * 16)) = rv[i]; }
        {
            const int In = (I < 3) ? I + 1 : I;
#pragma unroll
            for (int i = 0; i < 2; ++i) { const size_t ro = (size_t)(16 * In + 8 * i) * 64; rq[i] = *(const u32x4*)(ginq + ro); rf[i] = *(const u32x4*)(ginf + ro); rv[i] = *(const u32x4*)(gini + ro); }
        }
        asm volatile("s_waitcnt lgkmcnt(0)" ::: "memory");
        float ex = 1.0f;
#pragma unroll
        for (int t = 0; t < 16; ++t) {
            const float qv = bf_lo((unsigned)*(const LAS bf16_t*)(RQ + t * 128 + lane * 2)), fv = bf_lo((unsigned)*(const LAS bf16_t*)(RF + t * 128 + lane * 2));
            const float sg = sigmoidf_(fv);
            const float f = lb + omlb * sg, kk = omlb * (1.0f - sg);
            ex = fmaxf(ex * f, 1e-35f);
            const float qs = qv * ex;
            *(LAS bf16_t*)(QS + att::k_off(t, qs_w) + qs_wb) = (bf16_t)f2bf(qs);
            *(LAS bf16_t*)(KS + att::v_off(t, lane * 2)) = (bf16_t)f2bf(kk * rcpf_(ex));
            *(LAS bf16_t*)(QEST + t * 128 + lane * 2) = (bf16_t)f2bf(qs * e0);
        }
        GF[lane] = ex; e0 *= ex;
        asm volatile("s_waitcnt lgkmcnt(0)" ::: "memory");
#pragma unroll
        for (int i = 0; i < 2; ++i) *(u32x4*)(QE + (size_t)(row0 + I * 16 + wrow + 8 * i) * 256 + h * 64 + wch * 8) = *(const LAS u32x4*)(QEST + (wrow + 8 * i) * 128 + wch * 16);
        f32x4 Oacc[4];
#pragma unroll
        for (int et = 0; et < 4; ++et) Oacc[et] = (f32x4){0.f, 0.f, 0.f, 0.f};
#pragma unroll
        for (int ks = 0; ks < 2; ++ks) {
            const u32x2 lo = *(const LAS u32x2*)(QS + att::k_off(l15, 4 * ks + (grp >> 1)) + 8 * (grp & 1));
            const u32x2 hi = *(const LAS u32x2*)(QS + att::k_off(l15, 4 * ks + 2 + (grp >> 1)) + 8 * (grp & 1));
            u32x4 aw; aw.x = lo.x; aw.y = lo.y; aw.z = hi.x; aw.w = hi.y;
            const bf16x8 af = __builtin_bit_cast(bf16x8, aw);
#pragma unroll
            for (int et = 0; et < 4; ++et) {
                u32x4 bw; bw.x = att::cvtpk(Sacc[2 * ks][et][0], Sacc[2 * ks][et][1]); bw.y = att::cvtpk(Sacc[2 * ks][et][2], Sacc[2 * ks][et][3]);
                bw.z = att::cvtpk(Sacc[2 * ks + 1][et][0], Sacc[2 * ks + 1][et][1]); bw.w = att::cvtpk(Sacc[2 * ks + 1][et][2], Sacc[2 * ks + 1][et][3]);
                Oacc[et] = __builtin_amdgcn_mfma_f32_16x16x32_bf16(af, __builtin_bit_cast(bf16x8, bw), Oacc[et], 0, 0, 0);
            }
        }
        f32x4 AT = (f32x4){0.f, 0.f, 0.f, 0.f};
#pragma unroll
        for (int ks = 0; ks < 2; ++ks) {
            const bf16x8 ka = *(const LAS bf16x8*)(KS + att::v_off(l15, (4 * ks + grp) * 16));
            const bf16x8 qb = *(const LAS bf16x8*)(QS + att::k_off(l15, 4 * ks + grp));
            AT = __builtin_amdgcn_mfma_f32_16x16x32_bf16(ka, qb, AT, 0, 0, 0);
        }
#pragma unroll
        for (int r = 0; r < 4; ++r) AT[r] = (4 * grp + r <= l15) ? AT[r] : 0.f;
        u32x4 atw; atw.x = att::cvtpk(AT[0], AT[1]); atw.y = att::cvtpk(AT[2], AT[3]); atw.z = 0u; atw.w = 0u;
        const bf16x8 atf = __builtin_bit_cast(bf16x8, atw);
        bf16x8 vf[4];
#pragma unroll
        for (int et = 0; et < 4; ++et) { const v4i16 tv = __builtin_amdgcn_ds_read_tr16_b64_v4i16((LAS v4i16*)(VV + att::v_off(tr_row, 32 * et + tr_col)));
            vf[et] = (bf16x8){tv[0], tv[1], tv[2], tv[3], 0, 0, 0, 0}; }
#pragma unroll
        for (int et = 0; et < 4; ++et) Oacc[et] = __builtin_amdgcn_mfma_f32_16x16x32_bf16(atf, vf[et], Oacc[et], 0, 0, 0);
#pragma unroll
        for (int et = 0; et < 4; ++et)
#pragma unroll
            for (int r = 0; r < 4; ++r) *(LAS float*)(OST + (4 * grp + r) * 272 + (16 * et + l15) * 4) = Oacc[et][r];
        asm volatile("s_waitcnt lgkmcnt(0)" ::: "memory");
#pragma unroll
        for (int i = 0; i < 4; ++i) { const f32x4 ov = *(const LAS f32x4*)(OST + (grp + 4 * i) * 272 + l15 * 16); u32x2 ow; ow.x = att::cvtpk(ov[0], ov[1]); ow.y = att::cvtpk(ov[2], ov[3]);
            *(u32x2*)(OLOC + (size_t)(row0 + I * 16 + grp + 4 * i) * 256 + h * 64 + 4 * l15) = ow; }
#pragma unroll
        for (int dt = 0; dt < 4; ++dt) {
            const v4i16 tk = __builtin_amdgcn_ds_read_tr16_b64_v4i16((LAS v4i16*)(KS + att::v_off(tr_row, 32 * dt + tr_col)));
            const bf16x8 kf = (bf16x8){tk[0], tk[1], tk[2], tk[3], 0, 0, 0, 0};
            const f32x4 g4 = *(const LAS f32x4*)(GF + 16 * dt + 4 * grp);
#pragma unroll
            for (int et = 0; et < 4; ++et) { Sacc[dt][et] = __builtin_amdgcn_mfma_f32_16x16x32_bf16(kf, vf[et], Sacc[dt][et], 0, 0, 0); Sacc[dt][et] = Sacc[dt][et] * g4; }
        }
    }
#pragma unroll
    for (int dt = 0; dt < 4; ++dt)
#pragma unroll
        for (int et = 0; et < 4; ++et) { u32x2 w2; w2.x = att::cvtpk(Sacc[dt][et][0], Sacc[dt][et][1]); w2.y = att::cvtpk(Sacc[dt][et][2], Sacc[dt][et][3]); *(u32x2*)(HU + (size_t)u * 4096 + (16 * et + l15) * 64 + 16 * dt + 4 * grp) = w2; }
    HD[(size_t)u * 64 + lane] = e0;
    asm volatile("s_waitcnt lgkmcnt(0)" ::: "memory");
}
__device__ __forceinline__ void hgrn_scan(const Frame& F) {
    const bf16_t* HU = (const bf16_t*)(F.ws + WS_HU); const float* HD = (const float*)(F.ws + WS_HD); bf16_t* HUS = (bf16_t*)(F.ws + WS_HUS);
    for (int idx = F.bid * 512 + F.tid; idx < 64 * 4096; idx += F.G * 512) {
        const int bh = idx >> 12, ed = idx & 4095, d = ed & 63;
        float S = 0.f;
        float uv[32], dv[32];
#pragma unroll
        for (int c = 0; c < 32; ++c) { uv[c] = bf_lo((unsigned)HU[(size_t)(bh * 32 + c) * 4096 + ed]); dv[c] = HD[(size_t)(bh * 32 + c) * 64 + d]; }
#pragma unroll
        for (int c = 0; c < 32; ++c) { HUS[(size_t)(bh * 32 + c) * 4096 + ed] = (bf16_t)f2bf(S); S = dv[c] * S + uv[c]; }
    }
}
__device__ __forceinline__ void hgrn_final(const Frame& F, int u) {
    typedef short bf16x8 __attribute__((ext_vector_type(8)));
    const int c = u & 31, bh = u >> 5, b = bh >> 2, h = bh & 3, lane = F.lane, l15 = lane & 15, grp = lane >> 4;
    const bf16_t* PROJ = (const bf16_t*)(F.ws + WS_PROJ); bf16_t* MIX = (bf16_t*)(F.ws + WS_MIX);
    const bf16_t* OLOC = (const bf16_t*)(F.ws + WS_OLOC); const bf16_t* QE = (const bf16_t*)(F.ws + WS_QE); const bf16_t* HUS = (const bf16_t*)(F.ws + WS_HUS);
    const long row0 = (long)b * SEQ + c * 64;
    bf16x8 af[4][2];
#pragma unroll
    for (int et = 0; et < 4; ++et)
#pragma unroll
        for (int ks = 0; ks < 2; ++ks) af[et][ks] = *(const bf16x8*)(HUS + (size_t)u * 4096 + (16 * et + l15) * 64 + 32 * ks + 8 * grp);
#pragma unroll 1
    for (int tt = 0; tt < 4; ++tt) {
        const long row = row0 + 16 * tt + l15;
        const bf16x8 b0 = *(const bf16x8*)(QE + (size_t)row * 256 + h * 64 + 8 * grp), b1 = *(const bf16x8*)(QE + (size_t)row * 256 + h * 64 + 32 + 8 * grp);
        f32x4 acc[4]; float sq = 0.f;
#pragma unroll
        for (int et = 0; et < 4; ++et) {
            { const u32x2 ow = *(const u32x2*)(OLOC + (size_t)row * 256 + h * 64 + 16 * et + 4 * grp); acc[et] = (f32x4){bf_lo(ow.x), bf_hi(ow.x), bf_lo(ow.y), bf_hi(ow.y)}; }
            acc[et] = __builtin_amdgcn_mfma_f32_16x16x32_bf16(af[et][0], b0, acc[et], 0, 0, 0);
            acc[et] = __builtin_amdgcn_mfma_f32_16x16x32_bf16(af[et][1], b1, acc[et], 0, 0, 0);
        }
#pragma unroll
        for (int et = 0; et < 4; ++et) sq += (acc[et][0] * acc[et][0] + acc[et][1] * acc[et][1]) + (acc[et][2] * acc[et][2] + acc[et][3] * acc[et][3]);
        sq += x16f(sq); sq += x32f(sq);
        const float rs = rsqrtf(sq * (1.0f / 64.0f) + EPS);
#pragma unroll
        for (int et = 0; et < 4; ++et) {
            const u32x2 gw = *(const u32x2*)(PROJ + pj_off(row, C_HG + h * 64) + 16 * et + 4 * grp);
            const float g0 = bf_lo(gw.x), g1 = bf_hi(gw.x), g2 = bf_lo(gw.y), g3 = bf_hi(gw.y);
            u32x2 o; o.x = pk2(acc[et][0] * rs * (g0 * sigmoidf_(g0)), acc[et][1] * rs * (g1 * sigmoidf_(g1))); o.y = pk2(acc[et][2] * rs * (g2 * sigmoidf_(g2)), acc[et][3] * rs * (g3 * sigmoidf_(g3)));
            *(u32x2*)(MIX + pj_off(row, 768 + h * 64) + 16 * et + 4 * grp) = o;
        }
    }
}

__device__ __forceinline__ void phase_cmp2(const Frame& F, const Args& a, int l) {
    const int kv = F.bid >> 7, rbase = (F.bid & 127) * 32, lane = F.lane;
    LAS float* w2s = (LAS float*)F.lds;
    LAS float* hids = (LAS float*)(F.lds + 65536) + F.wave * 256;
    const float* bias = (const float*)(F.ws + WS_B1P + 65536) + (l * 2 + kv) * 256;
    const f32x4 bv = *(const f32x4*)(bias + 4 * lane);
    bf16_t* dstb = (bf16_t*)(F.ws + (kv == 0 ? WS_KCMP : WS_VCMP));
    f32x4 hs4[4];
#pragma unroll
    for (int rr = 0; rr < 4; ++rr) { const int rowi = rbase + F.wave * 4 + rr; f32x4 t4 = bv;
#pragma unroll
        for (int ks = 0; ks < 2; ++ks) t4 = t4 + *(const f32x4*)((const float*)(F.ws + ws_slab(kv, ks)) + (size_t)rowi * 256 + 4 * lane);
        hs4[rr] = t4; }
    { const float* w2 = a.cmp_w2 + (size_t)(l * 2 + kv) * 256 * 64;
#pragma unroll
      for (int i = 0; i < 8; ++i) *(LAS f32x4*)(w2s + (F.tid + 512 * i) * 4) = *(const f32x4*)(w2 + (F.tid + 512 * i) * 4); }
    __syncthreads();
#pragma unroll
    for (int rr = 0; rr < 4; ++rr) {
        const int rowi = rbase + F.wave * 4 + rr;
        f32x4 hsum = hs4[rr];
#pragma unroll
        for (int e = 0; e < 4; ++e) hsum[e] = hsum[e] * sigmoidf_(hsum[e]);
        asm volatile("s_waitcnt lgkmcnt(0)" ::: "memory");
        *(LAS f32x4*)(hids + 4 * lane) = hsum;
        asm volatile("s_waitcnt lgkmcnt(0)" ::: "memory");
        float s0 = 0.f, s1 = 0.f;
#pragma unroll 8
        for (int j = 0; j < 256; j += 4) { const f32x4 h4 = *(const LAS f32x4*)(hids + j);
            s0 += h4.x * w2s[(j + 0) * 64 + lane] + h4.z * w2s[(j + 2) * 64 + lane]; s1 += h4.y * w2s[(j + 1) * 64 + lane] + h4.w * w2s[(j + 3) * 64 + lane]; }
        dstb[(size_t)rowi * 64 + lane] = ((rowi & 127) == 127) ? (bf16_t)0 : (bf16_t)f2bf(s0 + s1);
    }
    __syncthreads();
}

constexpr int NPH = 1 + 8 * DEPTH;

template <int KF> __device__ __forceinline__ constexpr bool kf_on(int kind) { return KF < 0 || kind == KF || (kind >= 10 && kind / 10 == KF) || (KF >= 10 && KF / 10 == kind); }
template <int KF> __device__ __forceinline__ void mega_body(const Args& args_in) {
    extern __shared__ __attribute__((aligned(16))) unsigned char lds_raw[];
    LAS unsigned char* const lds = (LAS unsigned char*)lds_raw;
    {
        const int tid0 = threadIdx.x;
        const unsigned hw0 = (unsigned)__builtin_amdgcn_s_getreg((5 << 11) | 4) & 63u;
        if ((tid0 & 63) == 0) ((LAS unsigned*)(lds + LDS_WTAB))[hw0] = (unsigned)(tid0 >> 6);
        if (tid0 == 0) { ((LAS unsigned*)(lds + LDS_XBST))[0] = 0u; ((LAS unsigned*)(lds + LDS_XBST))[1] = 0u;
#if MK_ONE_LAUNCH
            (void)xb_add((unsigned*)(args_in.ws + WS_CTL) + CW_BAR + XB_XCNT(xb_xcc_id()), 1u);
#endif
        }
        if (tid0 == 0) { LAS Args* la = (LAS Args*)(lds + LDS_ARGS);
            la->x = args_in.x; la->p = args_in.p; la->w_in = args_in.w_in; la->w_out = args_in.w_out; la->cmp_pos = args_in.cmp_pos; la->cmp_w1 = args_in.cmp_w1; la->cmp_w2 = args_in.cmp_w2; la->hg_lb = args_in.hg_lb;
            la->g_pre_mix = args_in.g_pre_mix; la->g_post_mix = args_in.g_post_mix; la->g_pre_mlp = args_in.g_pre_mlp; la->g_post_mlp = args_in.g_post_mlp; la->w_up = args_in.w_up; la->w_down = args_in.w_down;
            la->g_ple = args_in.g_ple; la->w_ple_gate = args_in.w_ple_gate; la->w_ple_proj = args_in.w_ple_proj; la->out = args_in.out; la->ws = args_in.ws; }
        __syncthreads();
    }
#if MK_ONE_LAUNCH
    const int lo = 0, hi = NPH;
#else
    const int lo = args_in.ph_lo, hi = args_in.ph_hi;
#endif
#define PHASE_KIND_FILTER(kind) kf_on<KF>(kind)
#define INK(kind, k) (PHASE_KIND_FILTER(kind) && lo <= (k) && (k) < hi)
#define IN(k) (lo <= (k) && (k) < hi)
#define SEAM(k) do { if (IN(k) && IN((k) + 1)) { if ((k) == 0) { cg::this_grid().sync(); } else { Args a_; const Frame Fb = make_frame(lds, a_); \
        xcd_barrier((unsigned*)(Fb.ws + WS_CTL) + CW_BAR, (volatile LAS unsigned*)(lds + LDS_XBST), Fb.tid == 0, (unsigned)Fb.G); } } } while (0)
#define PHASE_BEGIN Args args; const Frame F = make_frame(lds, args); \
    unsigned* const ctl = (unsigned*)(F.ws + WS_CTL); bf16_t* const PROJ = (bf16_t*)(F.ws + WS_PROJ); bf16_t* const MIX = (bf16_t*)(F.ws + WS_MIX); bf16_t* const HBA = (bf16_t*)(F.ws + WS_HBA); bf16_t* const HBB = (bf16_t*)args.out; \
    bf16_t* const U = (bf16_t*)(F.ws + WS_U); bf16_t* const PP = (bf16_t*)(F.ws + WS_PP); bf16_t* const PB = (bf16_t*)(F.ws + WS_PB); float* const SSA = (float*)(F.ws + WS_SSA); float* const SSB = (float*)(F.ws + WS_SSB); float* const XBUF = (float*)(F.ws + WS_XBUF); \
    (void)ctl; (void)PROJ; (void)MIX; (void)HBA; (void)HBB; (void)U; (void)PP; (void)PB; (void)SSA; (void)SSB; (void)XBUF;

    for (int rep_ = 0; rep_ < REP_P0; ++rep_) if (INK(0, 0)) { PHASE_BEGIN phase_prologue(F, args); }
    SEAM(0);

#pragma unroll 1
    for (int l = 0; l < DEPTH; ++l) {
        const int pb = 1 + 8 * l;
        for (int rep_ = 0; rep_ < REP_G1; ++rep_) if (INK(1, pb + 0)) { PHASE_BEGIN
            if (l == 0) reduce_bias1(F);
            pg8::Gemm g = pg8::make_gemm(HBB, (const bf16_t*)(F.ws + WS_WIN) + (size_t)l * NPROJ * DM, DM, NPROJ);
            pg8::StaticOrder S; S.init(MTOK, NPROJ, F.G, F.bid);
            fill_rstd(F, SSB, S);
            pg8::EpiBf<1, 1> E{PROJ, NPROJ, (const LAS float*)(F.lds + LDS_RSTD), nullptr};
            pg8::gemm_phase<pg8::EpiBf<1, 1>, pg8::StaticOrder, true>(F.lds, g, S, E);
        }
        SEAM(pb + 0);
        for (int rep_ = 0; rep_ < REP_P2; ++rep_) if (INK(2, pb + 1)) { PHASE_BEGIN
            for (int r2_ = 0; r2_ < REP_HL; ++r2_) if (PHASE_KIND_FILTER(21)) { hgrn_local(F, args, l, F.bid * 8 + F.wave); __syncthreads(); }
            for (int r2_ = 0; r2_ < REP_CG; ++r2_) if (F.bid < 64 && PHASE_KIND_FILTER(20)) {
                const int ks = F.bid & 1, bb = (F.bid >> 1) & 15, kv = F.bid >> 5;
                pg8::Gemm g; g.A = PROJ + pj_off(16 * ks, (kv == 0 ? C_KC : C_VC)); g.Bt = (const bf16_t*)(F.ws + WS_W1T) + (size_t)(l * 2 + kv) * 256 * 2048 + (size_t)(16 * ks) * 256 * 64; g.K = 1024; g.ldb = 64; g.b_kstep = 256 * 64 * 2; g.b_hstep = (long)pg8::HALF * 64 * 2; g.b_tstep = 2 * g.b_hstep;
                asm volatile("" : "+s"(g.K));
                g.lda = 16 * 64; g.a_kstep = 64 * 2; g.a_hstep = (long)MTOK * 64 * 2; g.a_tstep = (long)SEQ * 64 * 2;
                pg8::OneFixed S; S.u0.pm = bb; S.u0.pn = 0; S.valid = true;
                pg8::EpiF32P E{(float*)(F.ws + ws_slab(kv, ks)), 256};
                pg8::gemm_phase<pg8::EpiF32P, pg8::OneFixed, false>(F.lds, g, S, E);
                __syncthreads();
            }
            if (F.bid >= 64) {
                for (int r2_ = 0; r2_ < REP_DL; ++r2_) if (PHASE_KIND_FILTER(22)) dil_units(F, F.bid - 64, 192);
            }
        }
        SEAM(pb + 1);
        if (INK(3, pb + 2)) { PHASE_BEGIN for (int r2_ = 0; r2_ < REP_C2; ++r2_) phase_cmp2(F, args, l); for (int r2_ = 0; r2_ < REP_SC; ++r2_) hgrn_scan(F); }
        SEAM(pb + 2);
        for (int rep_ = 0; rep_ < REP_P4; ++rep_) if (INK(4, pb + 3)) { PHASE_BEGIN
            for (int r2_ = 0; r2_ < REP_HF; ++r2_) { hgrn_final(F, F.bid * 8 + F.wave); __syncthreads(); }
            {
                unsigned* qhead = ctl + CW_NSAQ + 64 * l;
                LAS unsigned* qw = (LAS unsigned*)(F.lds + LDS_QW);
                bool first_unit = true;
#pragma unroll 1
                for (;;) {
                    __syncthreads();
                    if (F.tid == 0) *qw = first_unit ? (unsigned)F.bid : (unsigned)F.G + __hip_atomic_fetch_add(qhead, 1u, __ATOMIC_RELAXED, __HIP_MEMORY_SCOPE_AGENT);
                    first_unit = false;
                    __syncthreads();
                    const unsigned idx = (unsigned)__builtin_amdgcn_readfirstlane((int)*qw);
                    if (idx >= 512u) break;
                    const int jb = 15 - (int)(idx >> 5), kvh = (int)(idx & 1u), bb = (int)((idx >> 1) & 15u);
                    nsa_unit2(F, bb, kvh, jb);
                }
            }
            convert_p(F, args, l);
            dil_fixup(F);
        }
        SEAM(pb + 3);
        if (INK(5, pb + 4)) { PHASE_BEGIN
            pg8::Gemm g = pg8::make_gemm(MIX, (const bf16_t*)(F.ws + WS_WOUT) + (size_t)l * DM * DM, DM, DM);
            g.lda = 64; g.a_kstep = (long)MTOK * 64 * 2; g.a_hstep = (long)pg8::HALF * 64 * 2; g.a_tstep = 2 * g.a_hstep;
            pg8::StaticOrder S; S.init(MTOK, DM, F.G, F.bid);
            pg8::EpiPost E{HBB, HBA, args.g_post_mix + l * DM, SSA, XBUF, ctl + CW_CNT + ((l * 2 + 0) * 128) * 64, ctl + CW_TMO, F.lds + LDS_RSTD};
            pg8::gemm_phase<pg8::EpiPost, pg8::StaticOrder, true>(F.lds, g, S, E);
        }
        SEAM(pb + 4);
        for (int rep_ = 0; rep_ < REP_G3; ++rep_) if (INK(6, pb + 5)) { PHASE_BEGIN
            if (PHASE_KIND_FILTER(60)) {
                pg8::Gemm g = pg8::make_gemm(HBA, (const bf16_t*)(F.ws + WS_WUP) + (size_t)l * FF * DM, DM, FF);
                pg8::StaticOrder S; S.init(MTOK, FF, F.G, F.bid);
                fill_rstd(F, SSA, S);
                pg8::EpiBf<2, 1> E{U, FF, (const LAS float*)(F.lds + LDS_RSTD), nullptr};
                pg8::gemm_phase<pg8::EpiBf<2, 1>, pg8::StaticOrder, true>(F.lds, g, S, E);
            }
        }
        SEAM(pb + 5);
        if (INK(7, pb + 6)) { PHASE_BEGIN
            pg8::Gemm g = pg8::make_gemm(U, (const bf16_t*)(F.ws + WS_WDN) + (size_t)l * DM * FF, FF, DM);
            g.lda = 64; g.a_kstep = (long)MTOK * 64 * 2; g.a_hstep = (long)pg8::HALF * 64 * 2; g.a_tstep = 2 * g.a_hstep;
            pg8::StaticOrder S; S.init(MTOK, DM, F.G, F.bid);
            pg8::EpiPost E{HBA, HBA, args.g_post_mlp + l * DM, SSA, XBUF, ctl + CW_CNT + ((l * 2 + 1) * 128) * 64, ctl + CW_TMO, F.lds + LDS_RSTD};
            pg8::gemm_phase<pg8::EpiPost, pg8::StaticOrder, true>(F.lds, g, S, E);
        }
        SEAM(pb + 6);
        if (INK(8, pb + 7)) { PHASE_BEGIN
            {
                pg8::Gemm gp = pg8::make_gemm(PB, (const bf16_t*)(F.ws + WS_WPJ) + (size_t)l * DM * PLE, PLE, DM);
                pg8::StaticOrder Sp; Sp.init(MTOK, DM, F.G, F.bid);
                pg8::EpiBf<0> Ep{PP, DM, nullptr, nullptr};
                pg8::gemm_phase<pg8::EpiBf<0>, pg8::StaticOrder, true>(F.lds, gp, Sp, Ep);
                asm volatile("s_waitcnt vmcnt(0)" ::: "memory");
                __syncthreads();
            }
            pg8::Gemm g = pg8::make_gemm(HBA, (const bf16_t*)(F.ws + WS_WG) + (size_t)l * DM * DM, DM, DM);
            pg8::StaticOrder S; S.init(MTOK, DM, F.G, F.bid);
            fill_rstd(F, SSA, S);
            pg8::EpiPle E{(const LAS float*)(F.lds + LDS_RSTD), PP, HBA, (l == DEPTH - 1) ? args.out : (float*)nullptr, HBB, SSB};
            pg8::gemm_phase<pg8::EpiPle, pg8::StaticOrder, true>(F.lds, g, S, E);
        }
        SEAM(pb + 7);
    }
#undef IN
#undef SEAM
#undef INK
#undef PHASE_KIND_FILTER
#undef PHASE_BEGIN
}
template <int KF> __global__ void __launch_bounds__(512, 2) mega_k(Args args) { mega_body<KF>(args); }

template <int KF> static bool setup_kernel() {
    return hipFuncSetAttribute((const void*)mega_k<KF>, hipFuncAttributeMaxDynamicSharedMemorySize, LDS_BYTES) == hipSuccess;
}
template <int KF> static void launch_phase(int grid, const Args& a, hipStream_t stream) {
    hipLaunchKernelGGL(mega_k<KF>, dim3(grid), dim3(512), LDS_BYTES, stream, a);
}
extern "C" void kernel_launch(void* const* d_in, const int* in_sizes, int n_in, void* d_out, int out_size, void* d_ws, size_t ws_size, hipStream_t stream) {
    static int grid = 0;
    if (grid == 0) {
        if (n_in != 17 || in_sizes[0] != MTOK * DM || out_size != MTOK * DM || ws_size < WS_END) {
            fprintf(stderr, "kernel_launch: unexpected problem (n_in %d, in0 %d, out %d, ws %zu)\n", n_in, n_in > 0 ? in_sizes[0] : -1, out_size, ws_size); grid = -1; return; }
        int dev = 0, cus = 0, per_cu = 0;
        (void)hipGetDevice(&dev); (void)hipDeviceGetAttribute(&cus, hipDeviceAttributeMultiprocessorCount, dev);
        bool ok = true;
#if MK_ONE_LAUNCH
        ok = setup_kernel<-1>();
        if (hipOccupancyMaxActiveBlocksPerMultiprocessor(&per_cu, (const void*)mega_k<-1>, 512, LDS_BYTES) != hipSuccess || per_cu < 1) { fprintf(stderr, "kernel_launch: occupancy query says %d\n", per_cu); }
#else
        ok = setup_kernel<0>() && setup_kernel<1>() && setup_kernel<20>() && setup_kernel<21>() && setup_kernel<22>() && setup_kernel<3>() && setup_kernel<4>() && setup_kernel<5>() && setup_kernel<6>() && setup_kernel<7>() && setup_kernel<8>();
#endif
        if (!ok) { fprintf(stderr, "kernel_launch: hipFuncSetAttribute failed\n"); grid = -1; return; }
        (void)hipGetLastError();
        grid = cus;
        if (grid != 256) fprintf(stderr, "kernel_launch: %d CUs; this kernel is built for 256\n", grid);
    }
    if (grid < 0) return;
    (void)hipMemsetAsync((char*)d_ws + WS_CTL, 0, CTL_BYTES, stream);
    Args a{};
    a.x = (const float*)d_in[0]; a.p = (const float*)d_in[1]; a.w_in = (const float*)d_in[2]; a.w_out = (const float*)d_in[3]; a.cmp_pos = (const float*)d_in[4];
    a.cmp_w1 = (const float*)d_in[5]; a.cmp_w2 = (const float*)d_in[6]; a.hg_lb = (const float*)d_in[7]; a.g_pre_mix = (const float*)d_in[8]; a.g_post_mix = (const float*)d_in[9];
    a.g_pre_mlp = (const float*)d_in[10]; a.g_post_mlp = (const float*)d_in[11]; a.w_up = (const float*)d_in[12]; a.w_down = (const float*)d_in[13]; a.g_ple = (const float*)d_in[14];
    a.w_ple_gate = (const float*)d_in[15]; a.w_ple_proj = (const float*)d_in[16];
    a.out = (float*)d_out; a.ws = (unsigned char*)d_ws;
#if MK_ONE_LAUNCH
    a.ph_lo = 0; a.ph_hi = NPH;
    void* kargs[] = {&a};
    hipError_t e = hipLaunchCooperativeKernel((const void*)mega_k<-1>, dim3(grid), dim3(512), kargs, LDS_BYTES, stream);
    if (e != hipSuccess) fprintf(stderr, "kernel_launch: cooperative launch failed: %s\n", hipGetErrorString(e));
#else
    for (int ph = 0; ph < NPH; ++ph) {
        a.ph_lo = ph; a.ph_hi = ph + 1;
        const int kind = (ph == 0) ? 0 : ((ph - 1) % 8) + 1;
        switch (kind) {
            case 0: launch_phase<0>(grid, a, stream); break;
            case 1: launch_phase<1>(grid, a, stream); break;
            case 2: launch_phase<20>(grid, a, stream); launch_phase<21>(grid, a, stream); launch_phase<22>(grid, a, stream); break;
            case 3: launch_phase<3>(grid, a, stream); break;
            case 4: launch_phase<4>(grid, a, stream); break;
            case 5: launch_phase<5>(grid, a, stream); break;
            case 6: launch_phase<6>(grid, a, stream); break;
            case 7: launch_phase<7>(grid, a, stream); break;
            default: launch_phase<8>(grid, a, stream); break;
        }
    }
#endif
}
```
